# Optimizing an MI355X kernel written in HIP

```python
import math
import jax, jax.numpy as jnp
from jax import lax
import numpy as np

D_MODEL = 1024
BATCH = 4
SEQ = 4096
DEPTH = 2
DEC_BATCH = 128
DEC_SEQ = 1
PAST_LEN = 2048
PAGE_SIZE = 128

HEAD_DIM = 64
N_NSA_HEADS = (D_MODEL // 2) // HEAD_DIM
N_NSA_KV = N_NSA_HEADS // 4
NSA_GROUP = N_NSA_HEADS // N_NSA_KV
N_GDN_HEADS = (D_MODEL // 2) // HEAD_DIM
NSA_WIDTH = N_NSA_HEADS * HEAD_DIM
GDN_WIDTH = N_GDN_HEADS * HEAD_DIM
MIX_WIDTH = NSA_WIDTH + GDN_WIDTH
KV_WIDTH = N_NSA_KV * HEAD_DIM
GDN_QKV = 3 * GDN_WIDTH
CMP_BLOCK = 32
SLC_BLOCK = 64
TOP_N = 16
N_LOCAL = 2
WINDOW = 512
Q_BLOCK = 128
GDN_CHUNK = 64
GDN_CONV = 4
FFN_CONV = 3
D_FF = ((8 * D_MODEL // 3 + 127) // 128) * 128
PLE_DIM = 256
LN_EPS = 1e-5
RMS_EPS = 1e-6
DN_ALPHA = (2 * DEPTH) ** 0.25
DN_BETA = (8 * DEPTH) ** -0.25
NEG = -1e30

C_Q = 0
C_KV = C_Q + NSA_WIDTH
C_WIN = C_KV + 4 * KV_WIDTH
C_GATE = C_WIN + 2 * KV_WIDTH
C_GQKV = C_GATE + 3 * N_NSA_HEADS
C_GA = C_GQKV + GDN_QKV
C_GB = C_GA + N_GDN_HEADS
C_GZ = C_GB + N_GDN_HEADS
IN_WIDTH = C_GZ + GDN_WIDTH
V_COLS = ((C_KV + KV_WIDTH, C_KV + 2 * KV_WIDTH), (C_KV + 3 * KV_WIDTH, C_WIN),
          (C_WIN + KV_WIDTH, C_GATE), (C_GQKV + 2 * GDN_WIDTH, C_GA))

kernel_name = "nsa_gdn_hybrid_decoder_step"


def alibi_slopes():
    return 2.0 ** (-8.0 * jnp.arange(1, N_NSA_HEADS + 1, dtype=jnp.float32) / N_NSA_HEADS)


def layer_norm(x, g, b):
    xf = x.astype(jnp.float32)
    mu = xf.mean(-1, keepdims=True)
    var = jnp.square(xf - mu).mean(-1, keepdims=True)
    return ((xf - mu) * lax.rsqrt(var + LN_EPS) * g.astype(jnp.float32) + b.astype(jnp.float32)).astype(x.dtype)


def causal_dwconv(x, buf, w):
    xp = jnp.concatenate([buf.astype(x.dtype), x], axis=1)
    y = lax.conv_general_dilated(xp, w[:, None, :].astype(x.dtype), window_strides=(1,), padding='VALID',
                                 dimension_numbers=('NWC', 'WIO', 'NWC'), feature_group_count=x.shape[-1])
    return y, xp[:, -(w.shape[0] - 1):]


def compress_blocks(rows, pe, phi):
    B, Lp, Hk, D = rows.shape
    blk = rows.reshape(B, Lp // CMP_BLOCK, CMP_BLOCK, Hk, D) + pe[None, None, :, None, :]
    return jnp.einsum('bnhd,de->bnhe', blk.mean(axis=2), phi)


def nsa_block(q, q_pos, kc, vc, ks_blk, vs_blk):
    B, Tq, H, D = q.shape
    Nc, Ns = kc.shape[1], ks_blk.shape[2]
    qg = q.reshape(B, Tq, N_NSA_KV, NSA_GROUP, D)
    sl = alibi_slopes().reshape(N_NSA_KV, NSA_GROUP)
    scale = D ** -0.5
    qpf = q_pos.astype(jnp.float32)
    c_end = jnp.arange(Nc) * CMP_BLOCK + (CMP_BLOCK - 1)
    c_mid = jnp.arange(Nc, dtype=jnp.float32) * CMP_BLOCK + (CMP_BLOCK - 1) / 2
    c_mask = c_end[None, :] <= q_pos[:, None]
    s = jnp.einsum('btngd,bcnd->bngtc', qg, kc).astype(jnp.float32) * scale
    s = s - sl[None, :, :, None, None] * (qpf[:, None] - c_mid[None, :])[None, None, None]
    p = jax.nn.softmax(jnp.where(c_mask, s, NEG), axis=-1) * c_mask
    o_cmp = jnp.einsum('bngtc,bcnd->btngd', p.astype(vc.dtype), vc)
    imp = p.sum(axis=2).reshape(B, N_NSA_KV, Tq, Ns, SLC_BLOCK // CMP_BLOCK).sum(-1)
    blk = jnp.arange(Ns)
    cur = q_pos // SLC_BLOCK
    future = blk[None, :] > cur[:, None]
    forced = (blk[None, :] == 0) | (((cur[:, None] - blk[None, :]) < N_LOCAL) & ~future)
    score = jnp.where(future, -jnp.inf, jnp.where(forced, jnp.inf, imp))
    k_eff = min(TOP_N, Ns)
    _, idx = lax.top_k(score, k_eff)
    b_i = jnp.arange(B)[:, None, None, None]
    h_i = jnp.arange(N_NSA_KV)[None, :, None, None]
    kg = ks_blk[b_i, h_i, idx]
    vg = vs_blk[b_i, h_i, idx]
    tok = idx[..., None] * SLC_BLOCK + jnp.arange(SLC_BLOCK)
    dist = q_pos[None, None, :, None, None] - tok
    valid = dist >= 0
    s2 = jnp.einsum('btngd,bntksd->bngtks', qg, kg).astype(jnp.float32) * scale
    s2 = s2 - sl[None, :, :, None, None, None] * dist.astype(jnp.float32)[:, :, None]
    s2 = jnp.where(valid[:, :, None], s2, NEG).reshape(B, N_NSA_KV, NSA_GROUP, Tq, k_eff * SLC_BLOCK)
    p2 = jax.nn.softmax(s2, axis=-1).reshape(B, N_NSA_KV, NSA_GROUP, Tq, k_eff, SLC_BLOCK)
    o_slc = jnp.einsum('bngtks,bntksd->btngd', p2.astype(vg.dtype), vg)
    return o_cmp.reshape(B, Tq, H, D), o_slc.reshape(B, Tq, H, D)


def window_attend(q, q_pos, k, v, k_pos):
    B, NB, Tb, H, D = q.shape
    qg = q.reshape(B, NB, Tb, N_NSA_KV, NSA_GROUP, D)
    sl = alibi_slopes().reshape(N_NSA_KV, NSA_GROUP)
    s = jnp.einsum('bjtngd,bjsnd->bjngts', qg, k).astype(jnp.float32) * (D ** -0.5)
    dist = q_pos[:, :, None] - k_pos[:, None, :]
    mask = (dist >= 0) & (dist < WINDOW) & (k_pos[:, None, :] >= 0)
    s = s - sl[None, None, :, :, None, None] * dist.astype(jnp.float32)[None, :, None, None]
    p = jax.nn.softmax(jnp.where(mask[None, :, None, None], s, NEG), axis=-1)
    o = jnp.einsum('bjngts,bjsnd->bjtngd', p.astype(v.dtype), v)
    return o.reshape(B, NB, Tb, H, D)


def gated_delta_chunked(q, k, v, g, beta, S0):
    B, T, H, D = q.shape
    C = GDN_CHUNK
    Tp = -(-T // C) * C

    def prep(a):
        a = jnp.pad(a, [(0, 0), (0, Tp - T)] + [(0, 0)] * (a.ndim - 2))
        a = a.reshape((B, Tp // C, C) + a.shape[2:])
        return jnp.moveaxis(jnp.moveaxis(a, 3, 2), 1, 0)

    q, k, v, g, beta = prep(q), prep(k), prep(v), prep(g), prep(beta)
    gc = jnp.cumsum(g, axis=-1)
    ar = jnp.arange(C)
    diff = gc[..., :, None] - gc[..., None, :]
    dec_strict = jnp.exp(jnp.where(ar[:, None] > ar[None, :], diff, -jnp.inf))
    dec_incl = jnp.exp(jnp.where(ar[:, None] >= ar[None, :], diff, -jnp.inf))
    kb = k * beta[..., None]
    A = jnp.einsum('nbhid,nbhjd->nbhij', kb, k) * dec_strict + jnp.eye(C, dtype=jnp.float32)
    rhs = jnp.concatenate([v * beta[..., None], kb * jnp.exp(gc)[..., None]], axis=-1)
    X = lax.linalg.triangular_solve(A, rhs, left_side=True, lower=True)
    val, kcd = X[..., :D], X[..., D:]
    inner = jnp.einsum('nbhid,nbhjd->nbhij', q, k) * dec_incl
    qg = q * jnp.exp(gc)[..., None]
    glast = gc[..., -1]
    kend = k * jnp.exp(glast[..., None] - gc)[..., None]

    def step(S, xs):
        val_c, kcd_c, inner_c, qg_c, kend_c, gl = xs
        vn = val_c - jnp.einsum('bhcd,bhde->bhce', kcd_c, S)
        o = jnp.einsum('bhcd,bhde->bhce', qg_c, S) + jnp.einsum('bhij,bhje->bhie', inner_c, vn)
        S = S * jnp.exp(gl)[..., None, None] + jnp.einsum('bhcd,bhce->bhde', kend_c, vn)
        return S, o

    S, o = lax.scan(step, S0, (val, kcd, inner, qg, kend, glast))
    o = jnp.moveaxis(jnp.moveaxis(o, 0, 1), 2, 3).reshape(B, Tp, H, D)[:, :T]
    return o, S


def l2norm(x):
    return x * lax.rsqrt(jnp.sum(x * x, axis=-1, keepdims=True) + RMS_EPS)


def trunk_layer(x, p, kv_past, win_buf, gdn_state, gdn_buf, ffn_buf,
                w_in, nsa_pe, nsa_phi, gdn_conv_w, gdn_A_log, gdn_dt_bias, gdn_norm_w, w_out,
                ln_g, ln_b, ffn_w_up, ffn_conv_w, ffn_w_down, ple_w_proj, ple_w_gate):
    B, T, _ = x.shape
    H, Hk, D = N_NSA_HEADS, N_NSA_KV, HEAD_DIM
    f32 = jnp.float32
    past = 0 if kv_past is None else kv_past.shape[1]
    q_pos = past + jnp.arange(T, dtype=jnp.int32)
    h = x @ w_in
    q = h[..., C_Q:C_KV].reshape(B, T, H, D)
    kv_new = h[..., C_KV:C_WIN].reshape(B, T, 4, Hk, D)
    win_new = h[..., C_WIN:C_GATE].reshape(B, T, 2, Hk, D)
    gates = jax.nn.sigmoid(h[..., C_GATE:C_GQKV]).reshape(B, T, H, 3)
    kv_all = kv_new if kv_past is None else jnp.concatenate([kv_past.astype(kv_new.dtype), kv_new], axis=1)
    L = kv_all.shape[1]
    Lp = -(-L // SLC_BLOCK) * SLC_BLOCK
    kv_all = jnp.pad(kv_all, ((0, 0), (0, Lp - L), (0, 0), (0, 0), (0, 0)))
    kc = compress_blocks(kv_all[:, :, 0], nsa_pe[0], nsa_phi[0])
    vc = compress_blocks(kv_all[:, :, 1], nsa_pe[1], nsa_phi[1])
    sel = kv_all[:, :, 2:4].reshape(B, Lp // SLC_BLOCK, SLC_BLOCK, 2, Hk, D).transpose(3, 0, 4, 1, 2, 5)
    ks_blk, vs_blk = sel[0], sel[1]
    if T > Q_BLOCK and T % Q_BLOCK == 0:
        nb = T // Q_BLOCK
        o_cmp, o_slc = lax.map(lambda a: nsa_block(a[0], a[1], kc, vc, ks_blk, vs_blk),
                               (q.reshape(B, nb, Q_BLOCK, H, D).swapaxes(0, 1), q_pos.reshape(nb, Q_BLOCK)))
        o_cmp = o_cmp.swapaxes(0, 1).reshape(B, T, H, D)
        o_slc = o_slc.swapaxes(0, 1).reshape(B, T, H, D)
    else:
        o_cmp, o_slc = nsa_block(q, q_pos, kc, vc, ks_blk, vs_blk)
    if win_buf is None:
        nb = T // Q_BLOCK
        nw = WINDOW // Q_BLOCK + 1
        wp = jnp.pad(win_new, ((0, 0), (WINDOW, 0), (0, 0), (0, 0), (0, 0))).reshape(B, nb + nw - 1, Q_BLOCK, 2, Hk, D)
        wk = jnp.stack([wp[:, i:i + nb] for i in range(nw)], axis=2).reshape(B, nb, nw * Q_BLOCK, 2, Hk, D)
        k_pos = jnp.arange(nb)[:, None] * Q_BLOCK - WINDOW + jnp.arange(nw * Q_BLOCK)[None, :]
        o_win = window_attend(q.reshape(B, nb, Q_BLOCK, H, D), q_pos.reshape(nb, Q_BLOCK),
                              wk[:, :, :, 0], wk[:, :, :, 1], k_pos)
        new_win = win_new[:, -min(WINDOW, T):]
    else:
        wb = win_buf.shape[1]
        wk = jnp.concatenate([win_buf.astype(win_new.dtype), win_new], axis=1)
        k_pos = past - wb + jnp.arange(wb + T)
        o_win = window_attend(q[:, None], q_pos[None], wk[:, None, :, 0], wk[:, None, :, 1], k_pos[None])
        new_win = wk[:, -wb:]
    o_win = o_win.reshape(B, T, H, D)
    o_nsa = gates[..., 0:1] * o_cmp + gates[..., 1:2] * o_slc + gates[..., 2:3] * o_win
    if gdn_buf is None:
        gdn_buf = jnp.zeros((B, GDN_CONV - 1, GDN_QKV), x.dtype)
        gdn_state = jnp.zeros((B, N_GDN_HEADS, HEAD_DIM, HEAD_DIM), f32)
    qkv, new_gbuf = causal_dwconv(h[..., C_GQKV:C_GA], gdn_buf, gdn_conv_w)
    qkv = jax.nn.silu(qkv.astype(f32)).reshape(B, T, 3, N_GDN_HEADS, HEAD_DIM)
    gq = l2norm(qkv[:, :, 0]) * (HEAD_DIM ** -0.5)
    gk = l2norm(qkv[:, :, 1])
    gv = qkv[:, :, 2]
    g = -jnp.exp(gdn_A_log.astype(f32)) * jax.nn.softplus(h[..., C_GA:C_GB].astype(f32) + gdn_dt_bias.astype(f32))
    beta = jax.nn.sigmoid(h[..., C_GB:C_GZ].astype(f32))
    o_g, S = gated_delta_chunked(gq, gk, gv, g, beta, gdn_state.astype(f32))
    z = h[..., C_GZ:IN_WIDTH].astype(f32).reshape(B, T, N_GDN_HEADS, HEAD_DIM)
    o_g = o_g * lax.rsqrt(jnp.mean(o_g * o_g, axis=-1, keepdims=True) + RMS_EPS) * gdn_norm_w.astype(f32) * jax.nn.silu(z)
    mix = jnp.concatenate([o_nsa.reshape(B, T, NSA_WIDTH), o_g.reshape(B, T, GDN_WIDTH).astype(x.dtype)], axis=-1)
    x = layer_norm(DN_ALPHA * x + mix @ w_out, ln_g[0], ln_b[0])
    if ffn_buf is None:
        ffn_buf = jnp.zeros((B, FFN_CONV - 1, D_FF), x.dtype)
    up = x @ ffn_w_up
    hg, new_fbuf = causal_dwconv(up[..., :D_FF], ffn_buf, ffn_conv_w)
    ffn = (jax.nn.gelu(hg, approximate=False) * up[..., D_FF:]) @ ffn_w_down
    x = layer_norm(DN_ALPHA * x + ffn, ln_g[1], ln_b[1])
    ple = jax.nn.sigmoid(x @ ple_w_gate) * (p.astype(x.dtype) @ ple_w_proj)
    x = layer_norm(DN_ALPHA * x + ple, ln_g[2], ln_b[2])
    return x, (kv_new, new_win, S, new_gbuf, new_fbuf)


def setup_inputs(seed: int = 0) -> dict:
    key = jax.random.key(seed)
    ks = jax.random.split(key, 26)
    f32 = jnp.float32

    def nrm(k, shape, s=1.0):
        return jax.random.normal(k, shape, f32) * s

    n_pages = PAST_LEN // PAGE_SIZE
    n_used = DEC_BATCH * n_pages
    n_pool = (5 * n_used + 3) // 4
    wb = min(WINDOW, PAST_LEN)
    col_scale = jnp.ones((IN_WIDTH,), f32)
    for lo, hi in V_COLS:
        col_scale = col_scale.at[lo:hi].set(DN_BETA)
    page_table = jax.random.permutation(ks[5], n_pool)[:n_used].reshape(DEC_BATCH, n_pages).astype(jnp.int32)
    dt = jnp.exp(jax.random.uniform(ks[12], (DEPTH, N_GDN_HEADS), f32, math.log(1e-3), math.log(1e-1)))
    return {
        "x_prompt": nrm(ks[0], (BATCH, SEQ, D_MODEL)),
        "x_sample": nrm(ks[1], (DEC_BATCH, DEC_SEQ, D_MODEL)),
        "cache_nsa_kv": nrm(ks[2], (DEPTH, n_pool, PAGE_SIZE, 4, N_NSA_KV, HEAD_DIM)),
        "state_nsa_win": nrm(ks[3], (DEPTH, DEC_BATCH, wb, 2, N_NSA_KV, HEAD_DIM)),
        "state_gdn": nrm(ks[4], (DEPTH, DEC_BATCH, N_GDN_HEADS, HEAD_DIM, HEAD_DIM), 0.1),
        "state_gdn_conv": nrm(ks[6], (DEPTH, DEC_BATCH, GDN_CONV - 1, GDN_QKV)),
        "state_ffn_conv": nrm(ks[7], (DEPTH, DEC_BATCH, FFN_CONV - 1, D_FF), 0.5),
        "page_table": page_table,
        "p_prompt": nrm(ks[8], (DEPTH, BATCH, SEQ, PLE_DIM)),
        "p_sample": nrm(ks[9], (DEPTH, DEC_BATCH, DEC_SEQ, PLE_DIM)),
        "w_in": nrm(ks[10], (DEPTH, D_MODEL, IN_WIDTH), D_MODEL ** -0.5) * col_scale,
        "nsa_pe": nrm(ks[11], (DEPTH, 2, CMP_BLOCK, HEAD_DIM), 0.02),
        "nsa_phi": nrm(ks[13], (DEPTH, 2, HEAD_DIM, HEAD_DIM), (CMP_BLOCK / HEAD_DIM) ** 0.5),
        "gdn_conv_w": nrm(ks[14], (DEPTH, GDN_CONV, GDN_QKV), GDN_CONV ** -0.5),
        "gdn_A_log": jnp.log(jax.random.uniform(ks[15], (DEPTH, N_GDN_HEADS), f32, 1.0, 16.0)),
        "gdn_dt_bias": dt + jnp.log(-jnp.expm1(-dt)),
        "gdn_norm_w": 1.0 + nrm(ks[16], (DEPTH, HEAD_DIM), 0.02),
        "w_out": nrm(ks[17], (DEPTH, MIX_WIDTH, D_MODEL), MIX_WIDTH ** -0.5 * DN_BETA),
        "ln_g": 1.0 + nrm(ks[18], (DEPTH, 3, D_MODEL), 0.02),
        "ln_b": nrm(ks[19], (DEPTH, 3, D_MODEL), 0.02),
        "ffn_w_up": nrm(ks[20], (DEPTH, D_MODEL, 2 * D_FF), D_MODEL ** -0.5 * DN_BETA),
        "ffn_conv_w": nrm(ks[21], (DEPTH, FFN_CONV, D_FF), FFN_CONV ** -0.5),
        "ffn_w_down": nrm(ks[22], (DEPTH, D_FF, D_MODEL), D_FF ** -0.5 * DN_BETA),
        "ple_w_proj": nrm(ks[23], (DEPTH, PLE_DIM, D_MODEL), PLE_DIM ** -0.5 * DN_BETA),
        "ple_w_gate": nrm(ks[24], (DEPTH, D_MODEL, D_MODEL), D_MODEL ** -0.5),
    }


def reference(x_prompt, x_sample, cache_nsa_kv, state_nsa_win, state_gdn, state_gdn_conv, state_ffn_conv,
              page_table, p_prompt, p_sample, w_in, nsa_pe, nsa_phi, gdn_conv_w, gdn_A_log, gdn_dt_bias,
              gdn_norm_w, w_out, ln_g, ln_b, ffn_w_up, ffn_conv_w, ffn_w_down, ple_w_proj, ple_w_gate):
    dec_b, n_pages = page_table.shape
    past_len = n_pages * cache_nsa_kv.shape[2]
    xp, xs = x_prompt, x_sample
    st_p, st_s = [], []
    for l in range(DEPTH):
        prm = (w_in[l], nsa_pe[l], nsa_phi[l], gdn_conv_w[l], gdn_A_log[l], gdn_dt_bias[l], gdn_norm_w[l],
               w_out[l], ln_g[l], ln_b[l], ffn_w_up[l], ffn_conv_w[l], ffn_w_down[l], ple_w_proj[l], ple_w_gate[l])
        xp, sp = trunk_layer(xp, p_prompt[l], None, None, None, None, None, *prm)
        kv_past = cache_nsa_kv[l][page_table].reshape(dec_b, past_len, 4, N_NSA_KV, HEAD_DIM)
        xs, ss = trunk_layer(xs, p_sample[l], kv_past, state_nsa_win[l], state_gdn[l], state_gdn_conv[l],
                             state_ffn_conv[l], *prm)
        st_p.append(sp)
        st_s.append(ss)
    kv_rows_prompt = jnp.stack([s[0] for s in st_p])
    kv_rows_sample = jnp.stack([s[0] for s in st_s])
    win_prompt = jnp.stack([s[1] for s in st_p])
    win_sample = jnp.stack([s[1] for s in st_s])
    gdn_state_prompt = jnp.stack([s[2] for s in st_p])
    gdn_state_sample = jnp.stack([s[2] for s in st_s])
    gdn_conv_prompt = jnp.stack([s[3] for s in st_p])
    gdn_conv_sample = jnp.stack([s[3] for s in st_s])
    ffn_conv_prompt = jnp.stack([s[4] for s in st_p])
    ffn_conv_sample = jnp.stack([s[4] for s in st_s])
    return (xp, xs, kv_rows_prompt, kv_rows_sample, win_prompt, win_sample, gdn_state_prompt, gdn_state_sample,
            gdn_conv_prompt, gdn_conv_sample, ffn_conv_prompt, ffn_conv_sample)
```

```cpp
#include <hip/hip_runtime.h>
#include <cstdio>
#include <cstdint>
namespace pg8 {
#define PG8_LAS __attribute__((address_space(3)))
typedef unsigned short bf16_t;
typedef short bf16x8 __attribute__((ext_vector_type(8)));
typedef float f32x4 __attribute__((ext_vector_type(4)));
typedef unsigned u32x4 __attribute__((ext_vector_type(4)));
constexpr int BM = 256, BK = 64, HALF = 128, HTB = HALF * BK * 2  , STAGE_BYTES = 8 * HTB, NXCD = 8, WGM = 8;

__host__ __device__ __forceinline__ int lds_byte(int r, int c) { const int st = (r >> 4) * 2 + (c >> 5), rr = r & 15, cc = c & 31, ob = rr * 64 + cc * 2; return st * 1024 + (ob ^ (((ob >> 9) & 1) << 5)); }
__host__ __device__ __forceinline__ void stage_rc(int b, int& R, int& C) { const int st = b / 1024, sb = b % 1024, swz = sb ^ (((sb >> 9) & 1) << 5); R = (st >> 1) * 16 + swz / 64; C = (st & 1) * 32 + (swz % 64) / 2; }
__host__ __device__ __forceinline__ int perm32(int rho) { const int n = rho >> 4, i = rho & 15; return 8 * (i >> 2) + 4 * n + (i & 3); }

struct Unit { int pm, pn; };
struct Gemm { const bf16_t* A; const bf16_t* Bt; int M, N, K; };

struct StaticOrder {
    int nM, nN, nwg, G, c;
    __host__ __device__ void init(int M, int N, int G_, int c_) { nM = M / BM; nN = N / BM; nwg = nM * nN; G = G_; c = c_; }
    __host__ __device__ bool next(int i, Unit& u) const {
        const long L = (long)i * G + c; if (L >= nwg) return false;
        int wgid = (int)L; { const int q = nwg / NXCD, r = nwg % NXCD, xcd = wgid % NXCD, off = wgid / NXCD; wgid = (xcd < r ? xcd * (q + 1) : r * (q + 1) + (xcd - r) * q) + off; }
        const int nig = WGM * nN, gid = wgid / nig, fm = gid * WGM, gsz = (nM - fm) < WGM ? (nM - fm) : WGM;
        u.pm = fm + ((wgid % nig) % gsz); u.pn = (wgid % nig) / gsz; return true;
    }
    __device__ __forceinline__ void a_ready(const Unit&) const {}
    __device__ __forceinline__ void done(const Unit&) const {}
};

__device__ __forceinline__ unsigned cvt_pk_bf16(float lo, float hi) { unsigned r; asm volatile("v_cvt_pk_bf16_f32 %0, %1, %2" : "=v"(r) : "v"(lo), "v"(hi)); return r; }
typedef float f32x2 __attribute__((ext_vector_type(2)));
__device__ __forceinline__ f32x2 gelu_pk(f32x2 v) {
    const f32x2 av = __builtin_elementwise_abs(v), d = av * 0.2316418882f + 1.0f;
    f32x2 t; t.x = __builtin_amdgcn_rcpf(d.x); t.y = __builtin_amdgcn_rcpf(d.y);
    f32x2 q = t * 0.5307027145f + (-0.7265760135f); q = q * t + 0.7107068705f; q = q * t + (-0.142248368f); q = q * t + 0.127414796f; q = q * t;
    const f32x2 s = (v * v) * (-0.72134752044f);
    f32x2 e; e.x = __builtin_amdgcn_exp2f(s.x); e.y = __builtin_amdgcn_exp2f(s.y);
    const f32x2 m = v * (q * e), r = v - m;
    f32x2 o; o.x = v.x < 0.f ? m.x : r.x; o.y = v.y < 0.f ? m.y : r.y; return o;
}

template <int ACT  > struct EpiBf16 {
    static constexpr bool PERM = true, AFTER_DRAIN = false; static_assert(ACT == 0 || ACT == 1, "EpiBf16: ACT is 0 (none) or 1 (gelu_pk)");
    bf16_t* O; int ldc; const float* bias; int split_cols; size_t split_stride; float scale0;
    __device__ __forceinline__ void operator()(const f32x4 (&acc)[2][2][4][2], const Unit& u, int wr, int wc, int fr, int fq) const {
        const int row0 = u.pm * BM + wr * 64 + fr; int colt = u.pn * BM; bf16_t* base = O;
        float sc = 1.f; if (split_cols) { const int t = colt / split_cols; base += (size_t)t * split_stride; colt -= t * split_cols; if (t == 0) sc = scale0; }
        const int col0 = colt + wc * 32 + 8 * fq, bcol0 = u.pn * BM + wc * 32 + 8 * fq;
        f32x4 bv[2][2];
#pragma unroll
        for (int bj = 0; bj < 2; ++bj)
#pragma unroll
            for (int n = 0; n < 2; ++n) bv[bj][n] = bias ? *(const f32x4*)(bias + bcol0 + bj * HALF + 4 * n) : (f32x4){0.f, 0.f, 0.f, 0.f};
#pragma unroll
        for (int ai = 0; ai < 2; ++ai)
#pragma unroll
            for (int m = 0; m < 4; ++m) { bf16_t* rowp = base + (size_t)(row0 + ai * HALF + m * 16) * ldc + col0;
#pragma unroll
                for (int bj = 0; bj < 2; ++bj) { f32x4 v0 = acc[ai][bj][m][0] + bv[bj][0], v1 = acc[ai][bj][m][1] + bv[bj][1];
                    if (ACT == 1) { f32x2 a = gelu_pk((f32x2){v0[0], v0[1]}), b = gelu_pk((f32x2){v0[2], v0[3]}), c = gelu_pk((f32x2){v1[0], v1[1]}), d = gelu_pk((f32x2){v1[2], v1[3]});
                        v0 = (f32x4){a.x, a.y, b.x, b.y}; v1 = (f32x4){c.x, c.y, d.x, d.y}; }
                    v0 = v0 * sc; v1 = v1 * sc; u32x4 w; w.x = cvt_pk_bf16(v0[0], v0[1]); w.y = cvt_pk_bf16(v0[2], v0[3]); w.z = cvt_pk_bf16(v1[0], v1[1]); w.w = cvt_pk_bf16(v1[2], v1[3]);
                    *(u32x4*)(rowp + bj * HALF) = w; } }
    }
};
template <class Epi, class Sched, bool ALIGN_EPI = false, bool SP2 = false>
__device__ __forceinline__ void gemm_phase(PG8_LAS unsigned char* lds, const Gemm g, const Sched& S, const Epi& E, int wave_idx  ) {
    int tid_ = (int)__builtin_amdgcn_mbcnt_hi(~0u, __builtin_amdgcn_mbcnt_lo(~0u, 0u)); asm volatile("" : "+v"(tid_)); tid_ += 64 * wave_idx;
    const int tid = tid_, wid = wave_idx, lane = tid & 63, wr = wid >> 2, wc = wid & 3, fr = lane & 15, fq = lane >> 4;
    const int K = g.K, nt = K / BK;
    unsigned voffA[2], voffB[2];
#pragma unroll
    for (int i = 0; i < 2; ++i) { int R, C; stage_rc(tid * 16 + i * 8192, R, C); const int Rb = Epi::PERM ? ((R & ~31) + perm32(R & 31)) : R;
        voffA[i] = (unsigned)(R * K + C) * 2u; voffB[i] = (unsigned)(Rb * K + C) * 2u; }
    const size_t kstep = (size_t)(BK * 2);
    const size_t hstep = (size_t)HALF * K * 2;
    const size_t tstep = 2 * hstep;
    const unsigned ldsw = (unsigned)wid * 1024u;
    const int aoff = lds_byte(wr * 64 + fr, fq * 8), boff = lds_byte(wc * 32 + fr, fq * 8);
#define PG8_SA(b, h) (((b) * 2 + (h)) * HTB)
#define PG8_SB(b, h) ((4 + (b) * 2 + (h)) * HTB)
#define PG8_STAGE(bufoff, gbase, voff) do { _Pragma("unroll") for (int _i = 0; _i < 2; ++_i) \
        __builtin_amdgcn_global_load_lds((const unsigned*)((const char*)(gbase) + (voff)[_i]), (PG8_LAS unsigned*)(lds + (bufoff) + ldsw + _i * 8192), 16, 0, 0); } while (0)
#define PG8_LDA(dst, b, h) do { _Pragma("unroll") for (int m = 0; m < 4; ++m) _Pragma("unroll") for (int k = 0; k < 2; ++k) dst[m][k] = *(const PG8_LAS bf16x8*)(lds + PG8_SA(b, h) + aoff + m * 2048 + k * 1024); } while (0)
#define PG8_LDB(dst, b, h) do { _Pragma("unroll") for (int n = 0; n < 2; ++n) _Pragma("unroll") for (int k = 0; k < 2; ++k) dst[n][k] = *(const PG8_LAS bf16x8*)(lds + PG8_SB(b, h) + boff + n * 2048 + k * 1024); } while (0)
#define PG8_MMA(ai, bj, At, Bt) do { __builtin_amdgcn_s_setprio(1); _Pragma("unroll") for (int m = 0; m < 4; ++m) _Pragma("unroll") for (int n = 0; n < 2; ++n) _Pragma("unroll") for (int k = 0; k < 2; ++k) \
        acc[ai][bj][m][n] = __builtin_amdgcn_mfma_f32_16x16x32_bf16(Bt[n][k], At[m][k], acc[ai][bj][m][n], 0, 0, 0); __builtin_amdgcn_s_setprio(0); } while (0)
#define PG8_WAIT_V(n) asm volatile("s_waitcnt vmcnt(" #n ")" ::: "memory")
#define PG8_WAIT_L(n) asm volatile("s_waitcnt lgkmcnt(" #n ")" ::: "memory")
#define PG8_BAR __builtin_amdgcn_s_barrier()
#define PG8_SCHED __builtin_amdgcn_sched_barrier(0)
    Unit cur, nxt; int ui = 0;
    if (!S.next(0, cur)) return;
    f32x4 acc[2][2][4][2];
#pragma unroll
    for (int a = 0; a < 2; ++a)
#pragma unroll
        for (int b = 0; b < 2; ++b)
#pragma unroll
            for (int m = 0; m < 4; ++m)
#pragma unroll
                for (int n = 0; n < 2; ++n) acc[a][b][m][n] = (f32x4){0.f, 0.f, 0.f, 0.f};
    bf16x8 At[4][2], B0[2][2], B1[2][2];
    const char* cA = (const char*)g.A + (size_t)cur.pm * tstep; const char* cB = (const char*)g.Bt + (size_t)cur.pn * tstep;
    S.a_ready(cur);
    if constexpr (SP2) {
        PG8_STAGE(PG8_SB(0, 0), cB, voffB); PG8_STAGE(PG8_SB(0, 1), cB + hstep, voffB); PG8_STAGE(PG8_SA(0, 0), cA, voffA); PG8_STAGE(PG8_SA(0, 1), cA + hstep, voffA);
        if (wr == 1) PG8_BAR;
        PG8_WAIT_V(2); PG8_BAR;
        PG8_STAGE(PG8_SB(1, 0), cB + kstep, voffB); PG8_STAGE(PG8_SA(1, 0), cA + kstep, voffA); PG8_STAGE(PG8_SB(1, 1), cB + hstep + kstep, voffB);
        PG8_WAIT_V(6); PG8_BAR;
    } else {
        PG8_STAGE(PG8_SB(0, 0), cB, voffB); PG8_STAGE(PG8_SA(0, 0), cA, voffA); PG8_STAGE(PG8_SB(0, 1), cB + hstep, voffB); PG8_STAGE(PG8_SA(0, 1), cA + hstep, voffA);
        if (wr == 1) PG8_BAR;
        PG8_WAIT_V(4); PG8_BAR;
        PG8_STAGE(PG8_SB(1, 0), cB + kstep, voffB); PG8_STAGE(PG8_SA(1, 0), cA + kstep, voffA); PG8_STAGE(PG8_SB(1, 1), cB + hstep + kstep, voffB);
        PG8_WAIT_V(6); PG8_BAR;
    }
    for (;;) {
        const bool has_next = S.next(ui + 1, nxt);
        const char* nA = has_next ? (const char*)g.A + (size_t)nxt.pm * tstep : cA; const char* nB = has_next ? (const char*)g.Bt + (size_t)nxt.pn * tstep : cB;
        for (int t = 0; t < nt; t += 2) {
            const bool last = (t == nt - 2);
            const char* a1 = cA + (size_t)(t + 1) * kstep;
            const char* a2 = last ? nA : cA + (size_t)(t + 2) * kstep; const char* b2 = last ? nB : cB + (size_t)(t + 2) * kstep;
            const char* a3 = a2 + kstep; const char* b3 = b2 + kstep;
            if (last && has_next) S.a_ready(nxt);
            if constexpr (SP2) {
            PG8_LDB(B0, 0, 0); PG8_LDB(B1, 0, 1); PG8_SCHED; PG8_LDA(At, 0, 0); PG8_STAGE(PG8_SA(1, 1), a1 + hstep, voffA);
            PG8_WAIT_V(8); PG8_WAIT_L(0); PG8_BAR; PG8_MMA(0, 0, At, B0); PG8_MMA(0, 1, At, B1); PG8_BAR; PG8_SCHED;
            PG8_LDA(At, 0, 1); PG8_STAGE(PG8_SB(0, 0), b2, voffB); PG8_STAGE(PG8_SB(0, 1), b2 + hstep, voffB); PG8_STAGE(PG8_SA(0, 0), a2, voffA);
            PG8_WAIT_V(8); PG8_WAIT_L(0); PG8_BAR; PG8_MMA(1, 0, At, B0); PG8_MMA(1, 1, At, B1); PG8_BAR; PG8_SCHED;
            PG8_LDB(B0, 1, 0); PG8_LDB(B1, 1, 1); PG8_SCHED; PG8_LDA(At, 1, 0); PG8_STAGE(PG8_SA(0, 1), a2 + hstep, voffA);
            PG8_WAIT_V(8); PG8_WAIT_L(0); PG8_BAR; PG8_MMA(0, 0, At, B0); PG8_MMA(0, 1, At, B1); PG8_BAR; PG8_SCHED;
            PG8_LDA(At, 1, 1); PG8_STAGE(PG8_SB(1, 0), b3, voffB); PG8_STAGE(PG8_SB(1, 1), b3 + hstep, voffB); PG8_STAGE(PG8_SA(1, 0), a3, voffA);
            PG8_WAIT_V(8); PG8_WAIT_L(0); PG8_BAR; PG8_MMA(1, 0, At, B0); PG8_MMA(1, 1, At, B1); PG8_BAR; PG8_SCHED;
            } else {
            PG8_LDB(B0, 0, 0); PG8_SCHED; PG8_LDA(At, 0, 0); PG8_STAGE(PG8_SA(1, 1), a1 + hstep, voffA);
            PG8_WAIT_L(8); PG8_BAR; PG8_WAIT_L(0); PG8_MMA(0, 0, At, B0); PG8_BAR; PG8_SCHED;
            PG8_LDB(B1, 0, 1); PG8_STAGE(PG8_SB(0, 0), b2, voffB);
            PG8_BAR; PG8_WAIT_L(0); PG8_MMA(0, 1, At, B1); PG8_BAR;
            PG8_LDA(At, 0, 1); PG8_STAGE(PG8_SA(0, 0), a2, voffA);
            PG8_BAR; PG8_WAIT_L(0); PG8_MMA(1, 0, At, B0); PG8_BAR; PG8_SCHED;
            PG8_STAGE(PG8_SB(0, 1), b2 + hstep, voffB);
            PG8_WAIT_V(6); PG8_BAR; PG8_MMA(1, 1, At, B1); PG8_BAR;
            PG8_LDB(B0, 1, 0); PG8_SCHED; PG8_LDA(At, 1, 0); PG8_STAGE(PG8_SA(0, 1), a2 + hstep, voffA);
            PG8_WAIT_L(8); PG8_BAR; PG8_WAIT_L(0); PG8_MMA(0, 0, At, B0); PG8_BAR; PG8_SCHED;
            PG8_LDB(B1, 1, 1); PG8_STAGE(PG8_SB(1, 0), b3, voffB);
            PG8_BAR; PG8_WAIT_L(0); PG8_MMA(0, 1, At, B1); PG8_BAR;
            PG8_LDA(At, 1, 1); PG8_STAGE(PG8_SA(1, 0), a3, voffA);
            PG8_BAR; PG8_WAIT_L(0); PG8_MMA(1, 0, At, B0); PG8_BAR; PG8_SCHED;
            PG8_STAGE(PG8_SB(1, 1), b3 + hstep, voffB);
            PG8_WAIT_V(6); PG8_BAR; PG8_MMA(1, 1, At, B1); PG8_BAR;
            }
        }
        if constexpr (ALIGN_EPI) { if (wr == 0) PG8_BAR; }
        if constexpr (!Epi::AFTER_DRAIN) { E(acc, cur, wr, wc, fr, fq); S.done(cur); }
        if (!has_next) break;
#pragma unroll
        for (int a = 0; a < 2; ++a)
#pragma unroll
            for (int b = 0; b < 2; ++b)
#pragma unroll
                for (int m = 0; m < 4; ++m)
#pragma unroll
                    for (int n = 0; n < 2; ++n) acc[a][b][m][n] = (f32x4){0.f, 0.f, 0.f, 0.f};
        cur = nxt; cA = nA; cB = nB; ++ui;
        if constexpr (ALIGN_EPI) { if (wr == 1) PG8_BAR; }
    }
    PG8_WAIT_V(0);
    if constexpr (!ALIGN_EPI) { if (wr == 0) PG8_BAR; }
    PG8_BAR;
    if constexpr (Epi::AFTER_DRAIN) { E.fused(acc, cur, wr, wc, fr, fq, lds, wid, lane); S.done(cur); }
#undef PG8_SA
#undef PG8_SB
#undef PG8_STAGE
#undef PG8_LDA
#undef PG8_LDB
#undef PG8_MMA
#undef PG8_WAIT_V
#undef PG8_WAIT_L
#undef PG8_BAR
#undef PG8_SCHED
}
}

#ifndef MK_MULTI
#define MK_MULTI 1
#endif
#define LAS __attribute__((address_space(3)))
typedef unsigned short bf16;
typedef float f32x4 __attribute__((ext_vector_type(4)));
typedef unsigned u32x4 __attribute__((ext_vector_type(4)));
typedef unsigned u32x2 __attribute__((ext_vector_type(2)));

constexpr int DM = 1024, NBATCH = 4, SEQ = 4096, MPR = NBATCH * SEQ, DB = 128, MTOT = MPR + DB, MPAD = 16640;
constexpr int PASTL = 2048, NPOOL = 2560, NPG = 16;
constexpr int INW = 3368, HW = 3584, DFF = 2816, UPW = 5632, PLED = 256;
constexpr int HQ = 0, HKV = 512, HWIN = 1024, HGQKV = 1280, HGZ = 2816, HSM = 3328;
constexpr int GQKV = 1536;
constexpr float LN_EPS = 1e-5f, RMS_EPS = 1e-6f, NEGV = -1e30f;
constexpr float DN_ALPHA = 1.41421356237309515f;

constexpr size_t O_YP = 0, O_YS = O_YP + (size_t)MPR * DM, O_KVP = O_YS + (size_t)DB * DM, O_KVS = O_KVP + (size_t)2 * MPR * 512,
                 O_WINP = O_KVS + (size_t)2 * DB * 512, O_WINS = O_WINP + (size_t)2 * 4 * 512 * 256, O_GSP = O_WINS + (size_t)2 * DB * 512 * 256,
                 O_GSS = O_GSP + (size_t)2 * 4 * 8 * 4096, O_GCP = O_GSS + (size_t)2 * DB * 8 * 4096, O_GCS = O_GCP + (size_t)2 * 4 * 3 * GQKV,
                 O_FCP = O_GCS + (size_t)2 * DB * 3 * GQKV, O_FCS = O_FCP + (size_t)2 * 4 * 2 * DFF, O_END = O_FCS + (size_t)2 * DB * 2 * DFF;

constexpr size_t MiB = 1u << 20;
constexpr size_t alup(size_t x) { return (x + MiB - 1) & ~(MiB - 1); }
constexpr size_t WS_CTL = 0, CTL_BYTES = 1 * MiB;
constexpr size_t WS_WIN = WS_CTL + CTL_BYTES;
constexpr size_t WS_WOUT = WS_WIN + alup((size_t)2 * HW * DM * 2);
constexpr size_t WS_WUP = WS_WOUT + alup((size_t)2 * DM * DM * 2);
constexpr size_t WS_WDN = WS_WUP + alup((size_t)2 * UPW * DM * 2);
constexpr size_t WS_WGT = WS_WDN + alup((size_t)2 * DM * DFF * 2);
constexpr size_t WS_WPJ = WS_WGT + alup((size_t)2 * DM * DM * 2);
constexpr size_t WS_XF = WS_WPJ + alup((size_t)2 * DM * PLED * 2);
constexpr size_t WS_XB = WS_XF + alup((size_t)MPAD * DM * 4);
constexpr size_t WS_T1 = WS_XB + alup((size_t)MPAD * DM * 2);
constexpr size_t WS_H = WS_T1 + alup((size_t)MPAD * DM * 4);
constexpr size_t WS_HS = WS_H + alup((size_t)MPAD * HW * 2);
constexpr size_t WS_PB = WS_HS + alup((size_t)MPAD * 64 * 4);
constexpr size_t WS_PP = WS_PB + alup((size_t)2 * MPAD * PLED * 2);
constexpr size_t WS_MIX = WS_PP + alup((size_t)2 * MPAD * DM * 4);
constexpr size_t WS_UP = WS_MIX + alup((size_t)MPAD * DM * 2);
constexpr size_t WS_ACT = WS_UP + alup((size_t)MPAD * UPW * 2);
constexpr size_t WS_GQ = WS_ACT + alup((size_t)MPAD * DFF * 2);
constexpr size_t WS_GK = WS_GQ + alup((size_t)MTOT * 512 * 4);
constexpr size_t WS_GV = WS_GK + alup((size_t)MTOT * 512 * 4);
constexpr size_t WS_GG = WS_GV + alup((size_t)MTOT * 512 * 4);
constexpr size_t WS_GB = WS_GG + alup((size_t)MTOT * 8 * 4);
constexpr size_t WS_KCP = WS_GB + alup((size_t)MTOT * 8 * 4);
constexpr size_t WS_VCP = WS_KCP + alup((size_t)4 * 128 * 128 * 4);
constexpr size_t WS_KCS = WS_VCP + alup((size_t)4 * 128 * 128 * 4);
constexpr size_t WS_VCS = WS_KCS + alup((size_t)DB * 64 * 128 * 4);
constexpr size_t WS_END = WS_VCS + alup((size_t)DB * 64 * 128 * 4);
constexpr int CW_Q0 = 64, CW_Q1 = 128;
constexpr int CW_BAR = 4096;

constexpr int RING_BYTES = 131072, MISC_OFF = RING_BYTES + 320, ARGS_OFF = RING_BYTES + 1024, LDS_BYTES = 147456;

__device__ __forceinline__ float bf2f(bf16 v) { return __uint_as_float(((unsigned)v) << 16); }
__device__ __forceinline__ unsigned f2bf(float f) { unsigned u = __float_as_uint(f); return (u + 0x7fffu + ((u >> 16) & 1u)) >> 16; }
__device__ __forceinline__ unsigned pk2(float lo, float hi) { return f2bf(lo) | (f2bf(hi) << 16); }
__device__ __forceinline__ float wave_sum(float v) {
#pragma unroll
    for (int o = 1; o < 64; o <<= 1) v += __shfl_xor(v, o);
    return v;
}
__device__ __forceinline__ float wave_max(float v) {
#pragma unroll
    for (int o = 1; o < 64; o <<= 1) v = fmaxf(v, __shfl_xor(v, o));
    return v;
}
__device__ __forceinline__ void wave_lds_sync() { asm volatile("s_waitcnt lgkmcnt(0)" ::: "memory"); }
__device__ __forceinline__ float sigmoidf_(float x) { return 1.0f / (1.0f + __expf(-x)); }
__device__ __forceinline__ float siluf_(float x) { return x / (1.0f + __expf(-x)); }
__device__ __forceinline__ float softplusf_(float x) { return fmaxf(x, 0.f) + log1pf(__expf(-fabsf(x))); }

#define XB_TMO      128
#define XB_XCNT(j)  (256  + 64 * (j))
#define XB_XSUB(j)  (1280 + 64 * (j))
#define XB_XGEN(j)  (2304 + 64 * (j))
#define XB_TOP      3328
#define XB_TOPGEN   3392
#define XCD_BAR_WORDS 3456
#define XB_SPIN_CAP (1u << 18)
__device__ __forceinline__ unsigned xb_ld(unsigned* p)              { return __hip_atomic_load(p, __ATOMIC_RELAXED, __HIP_MEMORY_SCOPE_AGENT); }
__device__ __forceinline__ unsigned xb_add(unsigned* p, unsigned v) { return __hip_atomic_fetch_add(p, v, __ATOMIC_RELAXED, __HIP_MEMORY_SCOPE_AGENT); }
__device__ __forceinline__ unsigned xb_xcc_id() { return (unsigned)__builtin_amdgcn_s_getreg((3 << 11) | 20) & 0xFu; }
#define XB_SPIN(cond, bar) do { unsigned _sp = 0; while (cond) { __builtin_amdgcn_s_sleep(1); \
    if ((++_sp & 255u) == 0u) { if (xb_ld(&(bar)[XB_TMO])) break; if (_sp > XB_SPIN_CAP) { atomicAdd(&(bar)[XB_TMO], 1u); break; } } } } while (0)
struct XcdBarrier { unsigned* bar; unsigned x; volatile LAS unsigned* st; };
__device__ __forceinline__ XcdBarrier xcd_barrier_post(unsigned* bar, volatile LAS unsigned* st) {
    XcdBarrier b; b.bar = bar; b.x = xb_xcc_id(); b.st = st;
    if (threadIdx.x == 0) (void)xb_add(&bar[XB_XCNT(b.x)], 1u);
    return b;
}
__device__ __forceinline__ void xcd_barrier_complete(unsigned* bar, unsigned x, unsigned& nloc, unsigned& nx) {
    const unsigned G = gridDim.x * gridDim.y * gridDim.z;
    unsigned sum, cnt, mine, sp = 0u;
    for (;;) {
        sum = 0u; cnt = 0u; mine = 0u;
#pragma unroll
        for (unsigned j = 0; j < 16; ++j) { const unsigned c = xb_ld(&bar[XB_XCNT(j)]); sum += c; cnt += (c > 0u) ? 1u : 0u; mine = (j == x) ? c : mine; }
        if (sum == G) break;
        __builtin_amdgcn_s_sleep(1);
        if ((++sp & 255u) == 0u) { if (xb_ld(&bar[XB_TMO])) break; if (sp > XB_SPIN_CAP) { atomicAdd(&bar[XB_TMO], 1u); break; } }
    }
    nloc = mine > 0u ? mine : 1u; nx = cnt > 0u ? cnt : 1u;
}
__device__ __forceinline__ void xcd_barrier(const XcdBarrier& b) {
    asm volatile("s_waitcnt vmcnt(0)" ::: "memory");
    __syncthreads();
    if (threadIdx.x == 0) {
        unsigned* bar = b.bar;
        __builtin_amdgcn_s_waitcnt(0);
        unsigned nloc = b.st[0], nx = b.st[1];
        if (nloc == 0u) { xcd_barrier_complete(bar, b.x, nloc, nx); b.st[0] = nloc; b.st[1] = nx; }
        const unsigned old = xb_add(&bar[XB_XSUB(b.x)], 1u);
        const unsigned gen = old / nloc;
        if (old + 1u == (gen + 1u) * nloc) {
            __builtin_amdgcn_fence(__ATOMIC_RELEASE, "agent");
            asm volatile("s_waitcnt vmcnt(0)" ::: "memory");
            const unsigned og = xb_add(&bar[XB_TOP], 1u);
            const unsigned tg = og / nx;
            if (og + 1u == (tg + 1u) * nx) xb_add(&bar[XB_TOPGEN], 1u);
            else XB_SPIN(xb_ld(&bar[XB_TOPGEN]) == tg, bar);
            __builtin_amdgcn_fence(__ATOMIC_ACQUIRE, "agent");
            xb_add(&bar[XB_XGEN(b.x)], 1u);
            asm volatile("s_waitcnt vmcnt(0)" ::: "memory");
        } else {
            XB_SPIN(xb_ld(&bar[XB_XGEN(b.x)]) == gen, bar);
            __builtin_amdgcn_fence(__ATOMIC_ACQUIRE, "agent");
            asm volatile("s_waitcnt vmcnt(0)" ::: "memory");
        }
    }
    __syncthreads();
}

struct Args { const void* in[25]; float* out; unsigned char* ws; int ph_lo, ph_hi; };
enum { I_XP = 0, I_XS, I_CACHE, I_SWIN, I_SGDN, I_SGCONV, I_SFCONV, I_PTAB, I_PP, I_PS, I_WIN, I_PE, I_PHI, I_GCW, I_ALOG, I_DTB, I_GNW, I_WOUT, I_LNG, I_LNB, I_WUP, I_FCW, I_WDN, I_WPJ, I_WGT };

namespace pg8 {
struct EpiIn {
    static constexpr bool PERM = true, AFTER_DRAIN = false;
    bf16_t* H; float* HS; float* kvp; float* kvs;
    __device__ __forceinline__ void operator()(const f32x4 (&acc)[2][2][4][2], const Unit& u, int wr, int wc, int fr, int fq) const {
        const int row0 = u.pm * BM + wr * 64 + fr, col0 = u.pn * BM + wc * 32 + 8 * fq;
        const bool iskv = (u.pn == 2 || u.pn == 3), issm = (u.pn == 13);
#pragma unroll
        for (int ai = 0; ai < 2; ++ai)
#pragma unroll
            for (int m = 0; m < 4; ++m) { const int r = row0 + ai * HALF + m * 16;
#pragma unroll
                for (int bj = 0; bj < 2; ++bj) { const int c = col0 + bj * HALF; const f32x4 v0 = acc[ai][bj][m][0], v1 = acc[ai][bj][m][1];
                    u32x4 w; w.x = cvt_pk_bf16(v0[0], v0[1]); w.y = cvt_pk_bf16(v0[2], v0[3]); w.z = cvt_pk_bf16(v1[0], v1[1]); w.w = cvt_pk_bf16(v1[2], v1[3]);
                    *(u32x4*)(H + (size_t)r * HW + c) = w;
                    if (iskv) { float* dst = nullptr; if (r < MPR) dst = kvp + (size_t)r * 512 + (c - HKV); else if (r < MTOT) dst = kvs + (size_t)(r - MPR) * 512 + (c - HKV);
                        if (dst) { *(f32x4*)dst = v0; *(f32x4*)(dst + 4) = v1; } }
                    if (issm && (c - HSM) < 64) { float* dst = HS + (size_t)r * 64 + (c - HSM); *(f32x4*)dst = v0; *(f32x4*)(dst + 4) = v1; } } }
    }
};
struct EpiRes {
    static constexpr bool PERM = false, AFTER_DRAIN = false;
    const float* XF; float* T1;
    __device__ __forceinline__ void operator()(const f32x4 (&acc)[2][2][4][2], const Unit& u, int wr, int wc, int fr, int fq) const {
        const int row0 = u.pm * BM + wr * 64 + fr, col0 = u.pn * BM + wc * 32 + 4 * fq;
#pragma unroll
        for (int ai = 0; ai < 2; ++ai)
#pragma unroll
            for (int m = 0; m < 4; ++m) { const size_t off = (size_t)(row0 + ai * HALF + m * 16) * DM + col0;
#pragma unroll
                for (int bj = 0; bj < 2; ++bj)
#pragma unroll
                    for (int n = 0; n < 2; ++n) { const size_t o = off + bj * HALF + n * 16; const f32x4 xv = *(const f32x4*)(XF + o); *(f32x4*)(T1 + o) = xv * DN_ALPHA + acc[ai][bj][m][n]; } }
    }
};
struct EpiGate {
    static constexpr bool PERM = false, AFTER_DRAIN = false;
    const float* XF; const float* PP; float* T1;
    __device__ __forceinline__ void operator()(const f32x4 (&acc)[2][2][4][2], const Unit& u, int wr, int wc, int fr, int fq) const {
        const int row0 = u.pm * BM + wr * 64 + fr, col0 = u.pn * BM + wc * 32 + 4 * fq;
#pragma unroll
        for (int ai = 0; ai < 2; ++ai)
#pragma unroll
            for (int m = 0; m < 4; ++m) { const size_t off = (size_t)(row0 + ai * HALF + m * 16) * DM + col0;
#pragma unroll
                for (int bj = 0; bj < 2; ++bj)
#pragma unroll
                    for (int n = 0; n < 2; ++n) { const size_t o = off + bj * HALF + n * 16; const f32x4 xv = *(const f32x4*)(XF + o), pv = *(const f32x4*)(PP + o); const f32x4 a = acc[ai][bj][m][n]; f32x4 s;
#pragma unroll
                        for (int j = 0; j < 4; ++j) s[j] = 1.0f / (1.0f + __expf(-a[j]));
                        *(f32x4*)(T1 + o) = xv * DN_ALPHA + s * pv; } }
    }
};
struct EpiF32 {
    static constexpr bool PERM = false, AFTER_DRAIN = false;
    float* C; int ldc;
    __device__ __forceinline__ void operator()(const f32x4 (&acc)[2][2][4][2], const Unit& u, int wr, int wc, int fr, int fq) const {
        const int row0 = u.pm * BM + wr * 64 + fr, col0 = u.pn * BM + wc * 32 + 4 * fq;
#pragma unroll
        for (int ai = 0; ai < 2; ++ai)
#pragma unroll
            for (int m = 0; m < 4; ++m) { float* rowp = C + (size_t)(row0 + ai * HALF + m * 16) * ldc + col0;
#pragma unroll
                for (int bj = 0; bj < 2; ++bj)
#pragma unroll
                    for (int n = 0; n < 2; ++n) *(f32x4*)(rowp + bj * HALF + n * 16) = acc[ai][bj][m][n]; }
    }
};
}

struct Ctx { int tid, lane, wave, bid, G; LAS unsigned char* lds; unsigned* ctl; const LAS unsigned* la; };
__device__ __forceinline__ const void* ld_ptr(const LAS unsigned* p) { const unsigned lo = (unsigned)__builtin_amdgcn_readfirstlane((int)p[0]), hi = (unsigned)__builtin_amdgcn_readfirstlane((int)p[1]); return (const void*)(uintptr_t)(((unsigned long long)hi << 32) | lo); }
__device__ __forceinline__ int hw_lane() { return (int)__builtin_amdgcn_mbcnt_hi(~0u, __builtin_amdgcn_mbcnt_lo(~0u, 0u)); }
__device__ __forceinline__ Ctx relaunder(const Ctx& c0) { Ctx c = c0; int w = c0.wave; asm volatile("" : "+s"(w) :: "memory"); int ln = hw_lane(); asm volatile("" : "+v"(ln) :: "memory"); c.wave = w; c.lane = ln; c.tid = w * 64 + ln; int b = c0.bid; asm volatile("" : "+s"(b) :: "memory"); c.bid = b; return c; }
#define AIN(i) ld_ptr(c.la + 2 * (i))
#define AOUT ((float*)ld_ptr(c.la + 50))
#define AWS ((unsigned char*)ld_ptr(c.la + 52))

__device__ __forceinline__ int in_colmap(int n) {
    if (n < HGQKV) return n;
    if (n < HGZ) return 1304 + (n - HGQKV);
    if (n < HSM) return 2856 + (n - HGZ);
    if (n < HSM + 24) return 1280 + (n - HSM);
    if (n < HSM + 32) return 2840 + (n - HSM - 24);
    if (n < HSM + 40) return 2848 + (n - HSM - 32);
    return -1;
}
__device__ __forceinline__ void p0_prologue(const Ctx& c0) {
    const Ctx c = relaunder(c0);
    LAS float* tile = (LAS float*)c.lds;
    constexpr int T_IN = (HW / 64) * (DM / 64), T_OUT = 16 * 16, T_UP = (UPW / 64) * 16, T_DN = 16 * (DFF / 64), T_GT = 256, T_PJ = 16 * (PLED / 64);
    constexpr int T_L = T_IN + T_OUT + T_UP + T_DN + T_GT + T_PJ;
    for (int it = c.bid; it < 2 * T_L; it += c.G) {
        const int l = it / T_L; int r = it % T_L;
        const float* W; bf16* WT; int K, Ns, mode = 0;
        if (r < T_IN) { W = (const float*)AIN(I_WIN) + (size_t)l * DM * INW; K = DM; Ns = INW; WT = (bf16*)(AWS + WS_WIN) + (size_t)l * HW * DM; mode = 1; }
        else if ((r -= T_IN) < T_OUT) { W = (const float*)AIN(I_WOUT) + (size_t)l * DM * DM; K = DM; Ns = DM; WT = (bf16*)(AWS + WS_WOUT) + (size_t)l * DM * DM; }
        else if ((r -= T_OUT) < T_UP) { W = (const float*)AIN(I_WUP) + (size_t)l * DM * UPW; K = DM; Ns = UPW; WT = (bf16*)(AWS + WS_WUP) + (size_t)l * UPW * DM; }
        else if ((r -= T_UP) < T_DN) { W = (const float*)AIN(I_WDN) + (size_t)l * DFF * DM; K = DFF; Ns = DM; WT = (bf16*)(AWS + WS_WDN) + (size_t)l * DM * DFF; }
        else if ((r -= T_DN) < T_GT) { W = (const float*)AIN(I_WGT) + (size_t)l * DM * DM; K = DM; Ns = DM; WT = (bf16*)(AWS + WS_WGT) + (size_t)l * DM * DM; }
        else { r -= T_GT; W = (const float*)AIN(I_WPJ) + (size_t)l * PLED * DM; K = PLED; Ns = DM; WT = (bf16*)(AWS + WS_WPJ) + (size_t)l * DM * PLED; }
        const int nk = K / 64, tn = r / nk, tk = r % nk, n0 = tn * 64, k0 = tk * 64;
        { const int nn = c.tid & 63; const int nd = n0 + nn; const int sc = mode ? in_colmap(nd) : nd;
#pragma unroll
          for (int q = 0; q < 8; ++q) { const int kk = q * 8 + (c.tid >> 6); tile[kk * 65 + nn] = (sc >= 0) ? W[(size_t)(k0 + kk) * Ns + sc] : 0.f; } }
        __syncthreads();
        { const int n = c.tid >> 3, kc = (c.tid & 7) * 8; const LAS float* s = tile + kc * 65 + n;
          u32x4 o; o.x = pk2(s[0], s[65]); o.y = pk2(s[2 * 65], s[3 * 65]); o.z = pk2(s[4 * 65], s[5 * 65]); o.w = pk2(s[6 * 65], s[7 * 65]);
          *(u32x4*)(WT + (size_t)(n0 + n) * K + k0 + kc) = o; }
        __syncthreads();
    }
    const size_t gt = (size_t)c.bid * 512 + c.tid, GT = (size_t)c.G * 512;
    { float* XF = (float*)(AWS + WS_XF); bf16* XB = (bf16*)(AWS + WS_XB); const float* xp = (const float*)AIN(I_XP); const float* xs = (const float*)AIN(I_XS);
      for (size_t i = gt; i < (size_t)MPAD * DM / 4; i += GT) { const size_t e = i * 4; const size_t row = e / DM;
          f32x4 v = (f32x4){0.f, 0.f, 0.f, 0.f};
          if (row < (size_t)MPR) v = *(const f32x4*)(xp + e); else if (row < (size_t)MTOT) v = *(const f32x4*)(xs + (e - (size_t)MPR * DM));
          *(f32x4*)(XF + e) = v; u32x2 w; w.x = pk2(v[0], v[1]); w.y = pk2(v[2], v[3]); *(u32x2*)(XB + e) = w; } }
    for (int l = 0; l < 2; ++l) { bf16* PB = (bf16*)(AWS + WS_PB) + (size_t)l * MPAD * PLED; const float* pp = (const float*)AIN(I_PP) + (size_t)l * MPR * PLED; const float* ps = (const float*)AIN(I_PS) + (size_t)l * DB * PLED;
      for (size_t i = gt; i < (size_t)MPAD * PLED / 4; i += GT) { const size_t e = i * 4; const size_t row = e / PLED;
          f32x4 v = (f32x4){0.f, 0.f, 0.f, 0.f};
          if (row < (size_t)MPR) v = *(const f32x4*)(pp + e); else if (row < (size_t)MTOT) v = *(const f32x4*)(ps + (e - (size_t)MPR * PLED));
          u32x2 w; w.x = pk2(v[0], v[1]); w.y = pk2(v[2], v[3]); *(u32x2*)(PB + e) = w; } }
}

__device__ __forceinline__ void p3_prep(const Ctx& c0, int l) {
    const Ctx c = relaunder(c0);
    const int gw = c.bid * 8 + c.wave, NGW = c.G * 8, lane = c.lane;
    const bf16* H = (const bf16*)(AWS + WS_H); const float* HS = (const float*)(AWS + WS_HS);
    const float* pe = (const float*)AIN(I_PE) + (size_t)l * 2 * 32 * 64; const float* phi = (const float*)AIN(I_PHI) + (size_t)l * 2 * 64 * 64;
    const int* ptab = (const int*)AIN(I_PTAB);
    const float* cache = (const float*)AIN(I_CACHE) + (size_t)l * NPOOL * 128 * 512;
    { float* KC = (float*)(AWS + WS_KCP); float* VC = (float*)(AWS + WS_VCP);
      for (int it = gw; it < 4 * 128 * 4; it += NGW) { const int type = it & 1, n = (it >> 1) & 1, cb = (it >> 2) & 127, b = it >> 9;
          float s = 0.f;
          const bf16* src = H + (size_t)(b * SEQ + cb * 32) * HW + HKV + type * 128 + n * 64 + lane;
#pragma unroll 8
          for (int i = 0; i < 32; ++i) s += bf2f(src[(size_t)i * HW]) + pe[(type * 32 + i) * 64 + lane];
          const float mean = s * (1.f / 32.f); float o = 0.f;
#pragma unroll 8
          for (int d = 0; d < 64; ++d) o += __shfl(mean, d) * phi[(type * 64 + d) * 64 + lane];
          (type ? VC : KC)[((size_t)(b * 128 + cb) * 2 + n) * 64 + lane] = o; } }
    { float* KC = (float*)(AWS + WS_KCS); float* VC = (float*)(AWS + WS_VCS);
      for (int it = gw; it < DB * 64 * 4; it += NGW) { const int type = it & 1, n = (it >> 1) & 1, cb = (it >> 2) & 63, b = it >> 8;
          const int page = ptab[b * NPG + (cb >> 2)]; const float* src = cache + ((size_t)page * 128 + (cb & 3) * 32) * 512 + type * 128 + n * 64 + lane;
          float s = 0.f;
#pragma unroll 8
          for (int i = 0; i < 32; ++i) s += src[(size_t)i * 512] + pe[(type * 32 + i) * 64 + lane];
          const float mean = s * (1.f / 32.f); float o = 0.f;
#pragma unroll 8
          for (int d = 0; d < 64; ++d) o += __shfl(mean, d) * phi[(type * 64 + d) * 64 + lane];
          (type ? VC : KC)[((size_t)(b * 64 + cb) * 2 + n) * 64 + lane] = o; } }
    { float* GQ = (float*)(AWS + WS_GQ); float* GK = (float*)(AWS + WS_GK); float* GV = (float*)(AWS + WS_GV); float* GG = (float*)(AWS + WS_GG); float* GB = (float*)(AWS + WS_GB);
      const float* cw = (const float*)AIN(I_GCW) + (size_t)l * 4 * GQKV; const float* sgc = (const float*)AIN(I_SGCONV) + (size_t)l * DB * 3 * GQKV;
      const float* alog = (const float*)AIN(I_ALOG) + l * 8; const float* dtb = (const float*)AIN(I_DTB) + l * 8;
      for (int it = gw; it < MTOT * 8; it += NGW) { const int hh = it & 7, m = it >> 3;
          float y[3];
#pragma unroll
          for (int j = 0; j < 3; ++j) { const int cc = j * 512 + hh * 64 + lane; float xs[4];
              xs[3] = bf2f(H[(size_t)m * HW + HGQKV + cc]);
              if (m < MPR) { const int t = m & (SEQ - 1);
#pragma unroll
                  for (int i = 0; i < 3; ++i) xs[i] = (t + i - 3 >= 0) ? bf2f(H[(size_t)(m + i - 3) * HW + HGQKV + cc]) : 0.f; }
              else { const int b = m - MPR;
#pragma unroll
                  for (int i = 0; i < 3; ++i) xs[i] = sgc[((size_t)b * 3 + i) * GQKV + cc]; }
              float acc = 0.f;
#pragma unroll
              for (int i = 0; i < 4; ++i) acc += cw[i * GQKV + cc] * xs[i];
              y[j] = siluf_(acc); }
          const float sq = wave_sum(y[0] * y[0]), sk = wave_sum(y[1] * y[1]);
          const size_t o = (size_t)m * 512 + hh * 64 + lane;
          GQ[o] = y[0] * rsqrtf(sq + RMS_EPS) * 0.125f; GK[o] = y[1] * rsqrtf(sk + RMS_EPS); GV[o] = y[2];
          if (lane == 0) { const float ai = HS[(size_t)m * 64 + 24 + hh], bi = HS[(size_t)m * 64 + 32 + hh];
              GG[(size_t)m * 8 + hh] = -__expf(alog[hh]) * softplusf_(ai + dtb[hh]); GB[(size_t)m * 8 + hh] = sigmoidf_(bi); } } }
    const size_t gt = (size_t)c.bid * 512 + c.tid, GT = (size_t)c.G * 512;
    { float* o = AOUT + O_GCP + (size_t)l * 4 * 3 * GQKV;
      for (size_t i = gt; i < (size_t)4 * 3 * GQKV; i += GT) { const int cc = (int)(i % GQKV), r = (int)(i / GQKV) % 3, b = (int)(i / (3 * GQKV)); o[i] = bf2f(H[(size_t)(b * SEQ + SEQ - 3 + r) * HW + HGQKV + cc]); } }
    { float* o = AOUT + O_GCS + (size_t)l * DB * 3 * GQKV; const float* sgc = (const float*)AIN(I_SGCONV) + (size_t)l * DB * 3 * GQKV;
      for (size_t i = gt; i < (size_t)DB * 3 * GQKV; i += GT) { const int cc = (int)(i % GQKV), r = (int)(i / GQKV) % 3, b = (int)(i / (3 * GQKV)); o[i] = (r < 2) ? sgc[i + GQKV] : bf2f(H[(size_t)(MPR + b) * HW + HGQKV + cc]); } }
    { float* o = AOUT + O_WINP + (size_t)l * 4 * 512 * 256;
      for (size_t i = gt; i < (size_t)4 * 512 * 256; i += GT) { const int cc = (int)(i & 255), r = (int)(i >> 8) & 511, b = (int)(i >> 17); o[i] = bf2f(H[(size_t)(b * SEQ + SEQ - 512 + r) * HW + HWIN + cc]); } }
    { float* o = AOUT + O_WINS + (size_t)l * DB * 512 * 256; const float* sw = (const float*)AIN(I_SWIN) + (size_t)l * DB * 512 * 256;
      for (size_t i = gt; i < (size_t)DB * 512 * 256; i += GT) { const int cc = (int)(i & 255), r = (int)(i >> 8) & 511, b = (int)(i >> 17); o[i] = (r < 511) ? sw[i + 256] : bf2f(H[(size_t)(MPR + b) * HW + HWIN + cc]); } }
}

__device__ __forceinline__ float ldT(const bf16* p) { return bf2f(*p); }
__device__ __forceinline__ float ldT(const float* p) { return *p; }
__device__ __forceinline__ void qk4(const bf16* kp, const LAS float* qbuf, float (&dot)[4]) {
    dot[0] = dot[1] = dot[2] = dot[3] = 0.f;
#pragma unroll 2
    for (int cch = 0; cch < 8; ++cch) { const u32x4 w = *(const u32x4*)(kp + cch * 8);
#pragma unroll
        for (int j = 0; j < 4; ++j) { const unsigned ww = w[j]; const float k0 = __uint_as_float(ww << 16), k1 = __uint_as_float(ww & 0xffff0000u);
            const f32x4 q0 = *(const LAS f32x4*)(qbuf + (cch * 8 + j * 2) * 4), q1 = *(const LAS f32x4*)(qbuf + (cch * 8 + j * 2 + 1) * 4);
#pragma unroll
            for (int g = 0; g < 4; ++g) dot[g] += k0 * q0[g] + k1 * q1[g]; } }
}
__device__ __forceinline__ void qk4(const float* kp, const LAS float* qbuf, float (&dot)[4]) {
    dot[0] = dot[1] = dot[2] = dot[3] = 0.f;
#pragma unroll 4
    for (int cch = 0; cch < 16; ++cch) { const f32x4 w = *(const f32x4*)(kp + cch * 4);
#pragma unroll
        for (int j = 0; j < 4; ++j) { const f32x4 q0 = *(const LAS f32x4*)(qbuf + (cch * 4 + j) * 4);
#pragma unroll
            for (int g = 0; g < 4; ++g) dot[g] += w[j] * q0[g]; } }
}
template <typename T>
__device__ __forceinline__ void pv4(const T* vp_lane, const LAS float* pbuf, int lane, float (&o)[4]) {
    const unsigned long long pv = (unsigned long long)(uintptr_t)vp_lane; const int lo = (int)(unsigned)pv, hi = (int)(unsigned)(pv >> 32);
#pragma unroll 8
    for (int j = 0; j < 64; ++j) {
        const unsigned l2 = (unsigned)__builtin_amdgcn_readlane(lo, j), h2 = (unsigned)__builtin_amdgcn_readlane(hi, j);
        const T* vp = (const T*)(uintptr_t)(((unsigned long long)h2 << 32) | l2);
        const float v = ldT(vp + lane); const f32x4 p = *(const LAS f32x4*)(pbuf + j * 4);
#pragma unroll
        for (int g = 0; g < 4; ++g) o[g] += p[g] * v;
    }
}
struct OSm { float m[4], l[4], o[4]; };
__device__ __forceinline__ void os_init(OSm& s) {
#pragma unroll
    for (int g = 0; g < 4; ++g) { s.m[g] = NEGV; s.l[g] = 0.f; s.o[g] = 0.f; } }
template <typename T>
__device__ __forceinline__ void attend_block(OSm& st, const T* kp, const T* vp, bool valid, float dist, const LAS float* qbuf, LAS float* pbuf, int lane, const float (&slope)[4]) {
    float dot[4]; qk4(kp, qbuf, dot);
    f32x4 p;
#pragma unroll
    for (int g = 0; g < 4; ++g) { const float s = valid ? (dot[g] * 0.125f - slope[g] * dist) : NEGV;
        const float mn = fmaxf(st.m[g], wave_max(s)); const float pg = valid ? __expf(s - mn) : 0.f; const float corr = __expf(st.m[g] - mn);
        st.l[g] = st.l[g] * corr + wave_sum(pg); st.o[g] *= corr; st.m[g] = mn; p[g] = pg; }
    *(LAS f32x4*)(pbuf + lane * 4) = p; wave_lds_sync();
    pv4(vp, pbuf, lane, st.o);
    wave_lds_sync();
}
__device__ __forceinline__ unsigned long long select_blocks(const LAS float* impbuf, int lane, int cur) {
    const bool excl = lane > cur; const bool forced = (lane == 0) || (lane == cur) || (lane + 1 == cur);
    const float imp = impbuf[2 * lane] + impbuf[2 * lane + 1];
    const float sc = excl ? -__builtin_inff() : (forced ? __builtin_inff() : imp);
    int cnt = 0; const int sci = __float_as_int(sc);
#pragma unroll 8
    for (int i = 0; i < 64; ++i) { const float si = __int_as_float(__builtin_amdgcn_readlane(sci, i)); cnt += ((si > sc) || (si == sc && i < lane)) ? 1 : 0; }
    return __ballot(!excl && cnt < 16);
}

__device__ __forceinline__ void nsa_item(const Ctx& c, int l, bool sample, int row  , int b, int t, int n, LAS float* wl, int lane) {
    LAS float* qbuf = wl; LAS float* pbuf = wl + 256; LAS float* impbuf = wl + 512;
    const bf16* H = (const bf16*)(AWS + WS_H); const float* HS = (const float*)(AWS + WS_HS);
    float slope[4];
#pragma unroll
    for (int g = 0; g < 4; ++g) slope[g] = exp2f(-(float)(n * 4 + g + 1));
    { f32x4 qv;
#pragma unroll
      for (int g = 0; g < 4; ++g) qv[g] = bf2f(H[(size_t)row * HW + HQ + (n * 4 + g) * 64 + lane]);
      wave_lds_sync(); *(LAS f32x4*)(qbuf + lane * 4) = qv; wave_lds_sync(); }
    const float tp = (float)t;
    const int ncb = sample ? 1 : 2;
    const float* KC = sample ? (const float*)(AWS + WS_KCS) + (size_t)b * 64 * 128 : (const float*)(AWS + WS_KCP) + (size_t)b * 128 * 128;
    const float* VC = sample ? (const float*)(AWS + WS_VCS) + (size_t)b * 64 * 128 : (const float*)(AWS + WS_VCP) + (size_t)b * 128 * 128;
    float sc[2][4]; bool cv[2];
#pragma unroll
    for (int blk = 0; blk < 2; ++blk) { const int cidx = blk * 64 + lane; cv[blk] = (blk < ncb) && (32 * cidx + 31 <= t);
        float dot[4] = {0.f, 0.f, 0.f, 0.f};
        if (blk < ncb) qk4(KC + ((size_t)cidx * 2 + n) * 64, qbuf, dot);
        const float dist = tp - (32.f * (float)cidx + 15.5f);
#pragma unroll
        for (int g = 0; g < 4; ++g) sc[blk][g] = cv[blk] ? (dot[g] * 0.125f - slope[g] * dist) : NEGV; }
    float ocmp[4] = {0.f, 0.f, 0.f, 0.f};
    { f32x4 p0, p1; float i0 = 0.f, i1 = 0.f;
#pragma unroll
      for (int g = 0; g < 4; ++g) { const float mx = wave_max(fmaxf(sc[0][g], sc[1][g]));
          const float e0 = cv[0] ? __expf(sc[0][g] - mx) : 0.f, e1 = cv[1] ? __expf(sc[1][g] - mx) : 0.f; const float sum = wave_sum(e0 + e1); const float inv = sum > 0.f ? 1.0f / sum : 0.f;
          p0[g] = e0 * inv; p1[g] = e1 * inv; i0 += p0[g]; i1 += p1[g]; }
      impbuf[lane] = i0; impbuf[64 + lane] = i1;
      *(LAS f32x4*)(pbuf + lane * 4) = p0; wave_lds_sync();
      pv4(VC + ((size_t)lane * 2 + n) * 64, pbuf, lane, ocmp); wave_lds_sync();
      if (ncb > 1) { *(LAS f32x4*)(pbuf + lane * 4) = p1; wave_lds_sync(); pv4(VC + ((size_t)(64 + lane) * 2 + n) * 64, pbuf, lane, ocmp); wave_lds_sync(); } }
    const int cur = t >> 6;
    unsigned long long mask = select_blocks(impbuf, lane, cur);
    OSm ss; os_init(ss);
    if (!sample) {
        while (mask) { const int j = __builtin_ctzll(mask); mask &= mask - 1;
            const int pos = j * 64 + lane; const bf16* kp = H + (size_t)(b * SEQ + pos) * HW + HKV + 256 + n * 64;
            attend_block<bf16>(ss, kp, kp + 128, pos <= t, (float)(t - pos), qbuf, pbuf, lane, slope); }
    } else {
        const int* ptab = (const int*)AIN(I_PTAB); const float* cache = (const float*)AIN(I_CACHE) + (size_t)l * NPOOL * 128 * 512;
        while (mask) { const int j = __builtin_ctzll(mask); mask &= mask - 1;
            if (j < 32) { const int page = ptab[b * NPG + (j >> 1)]; const float* kp = cache + ((size_t)page * 128 + (j & 1) * 64 + lane) * 512 + 256 + n * 64;
                attend_block<float>(ss, kp, kp + 128, true, (float)(t - (j * 64 + lane)), qbuf, pbuf, lane, slope); }
            else { const bf16* kp = H + (size_t)row * HW + HKV + 256 + n * 64; attend_block<bf16>(ss, kp, kp + 128, lane == 0, 0.f, qbuf, pbuf, lane, slope); } }
    }
    OSm sw; os_init(sw);
    if (!sample) {
        for (int blk = 0; blk < 8; ++blk) { const int p0 = t - 511 + blk * 64; if (p0 + 63 < 0) continue;
            const int pos = p0 + lane; const int pc = pos < 0 ? 0 : pos; const bf16* kp = H + (size_t)(b * SEQ + pc) * HW + HWIN + n * 64;
            attend_block<bf16>(sw, kp, kp + 128, pos >= 0, (float)(t - pos), qbuf, pbuf, lane, slope); }
    } else {
        const float* wst = (const float*)AIN(I_SWIN) + ((size_t)l * DB + b) * 512 * 256;
        for (int blk = 0; blk < 8; ++blk) { const int i = 1 + blk * 64 + lane; const int ic = i > 511 ? 511 : i; const float* kp = wst + (size_t)ic * 256 + n * 64;
            attend_block<float>(sw, kp, kp + 128, i <= 511, (float)(512 - i), qbuf, pbuf, lane, slope); }
        const bf16* kp = H + (size_t)row * HW + HWIN + n * 64; attend_block<bf16>(sw, kp, kp + 128, lane == 0, 0.f, qbuf, pbuf, lane, slope);
    }
    bf16* MIX = (bf16*)(AWS + WS_MIX);
#pragma unroll
    for (int g = 0; g < 4; ++g) { const int hq = n * 4 + g; const float* gp = HS + (size_t)row * 64 + hq * 3;
        const float g0 = sigmoidf_(gp[0]), g1 = sigmoidf_(gp[1]), g2 = sigmoidf_(gp[2]);
        const float osl = ss.l[g] > 0.f ? ss.o[g] / ss.l[g] : 0.f, owi = sw.l[g] > 0.f ? sw.o[g] / sw.l[g] : 0.f;
        MIX[(size_t)row * DM + hq * 64 + lane] = (bf16)f2bf(g0 * ocmp[g] + g1 * osl + g2 * owi); }
}

__device__ __forceinline__ void gdn_steps(const Ctx& c, int l, int row0, int nsteps, int hh, float (&S)[64], LAS float* wl, int lane) {
    const float* GQ = (const float*)(AWS + WS_GQ); const float* GK = (const float*)(AWS + WS_GK); const float* GV = (const float*)(AWS + WS_GV);
    const float* GG = (const float*)(AWS + WS_GG); const float* GB = (const float*)(AWS + WS_GB);
    const bf16* H = (const bf16*)(AWS + WS_H); bf16* MIX = (bf16*)(AWS + WS_MIX);
    const float nw = ((const float*)AIN(I_GNW))[l * 64 + lane];
    LAS float* kb = wl; LAS float* qb = wl + 64;
    size_t o = (size_t)row0 * 512 + hh * 64 + lane;
    float nk = GK[o], nq = GQ[o], nv = GV[o], ng = GG[(size_t)row0 * 8 + hh], nb = GB[(size_t)row0 * 8 + hh], nz = bf2f(H[(size_t)row0 * HW + HGZ + hh * 64 + lane]);
    for (int s = 0; s < nsteps; ++s) {
        const int m = row0 + s;
        const float kv = nk, qv = nq, vv = nv, gv = ng, bv = nb, zv = nz;
        if (s + 1 < nsteps) { const size_t o2 = (size_t)(m + 1) * 512 + hh * 64 + lane;
            nk = GK[o2]; nq = GQ[o2]; nv = GV[o2]; ng = GG[(size_t)(m + 1) * 8 + hh]; nb = GB[(size_t)(m + 1) * 8 + hh]; nz = bf2f(H[(size_t)(m + 1) * HW + HGZ + hh * 64 + lane]); }
        wave_lds_sync(); kb[lane] = kv; qb[lane] = qv; wave_lds_sync();
        const float al = __expf(gv);
        float u0 = 0.f, u1 = 0.f, u2 = 0.f, u3 = 0.f;
#pragma unroll
        for (int d = 0; d < 64; d += 4) { const f32x4 k4 = *(const LAS f32x4*)(kb + d); u0 += k4[0] * S[d]; u1 += k4[1] * S[d + 1]; u2 += k4[2] * S[d + 2]; u3 += k4[3] * S[d + 3]; }
        const float u = (u0 + u1) + (u2 + u3);
        const float w = bv * (vv - al * u);
        float o0 = 0.f, o1 = 0.f, o2 = 0.f, o3 = 0.f;
#pragma unroll
        for (int d = 0; d < 64; d += 4) { const f32x4 k4 = *(const LAS f32x4*)(kb + d); const f32x4 q4 = *(const LAS f32x4*)(qb + d);
            S[d] = al * S[d] + k4[0] * w; S[d + 1] = al * S[d + 1] + k4[1] * w; S[d + 2] = al * S[d + 2] + k4[2] * w; S[d + 3] = al * S[d + 3] + k4[3] * w;
            o0 += q4[0] * S[d]; o1 += q4[1] * S[d + 1]; o2 += q4[2] * S[d + 2]; o3 += q4[3] * S[d + 3]; }
        const float ov = (o0 + o1) + (o2 + o3);
        const float ms = wave_sum(ov * ov) * (1.f / 64.f);
        MIX[(size_t)m * DM + 512 + hh * 64 + lane] = (bf16)f2bf(ov * rsqrtf(ms + RMS_EPS) * nw * siluf_(zv));
    }
}
__device__ __forceinline__ void gdn_item_prompt(const Ctx& c, int l, int b, int hh, LAS float* wl, int lane) {
    float S[64];
#pragma unroll
    for (int d = 0; d < 64; ++d) S[d] = 0.f;
    gdn_steps(c, l, b * SEQ, SEQ, hh, S, wl, lane);
    float* o = AOUT + O_GSP + (((size_t)l * 4 + b) * 8 + hh) * 4096;
#pragma unroll
    for (int d = 0; d < 64; ++d) o[d * 64 + lane] = S[d];
}
__device__ __forceinline__ void gdn_item_sample(const Ctx& c, int l, int b, int hh, LAS float* wl, int lane) {
    const float* s0 = (const float*)AIN(I_SGDN) + (((size_t)l * DB + b) * 8 + hh) * 4096;
    float S[64];
#pragma unroll
    for (int d = 0; d < 64; ++d) S[d] = s0[d * 64 + lane];
    gdn_steps(c, l, MPR + b, 1, hh, S, wl, lane);
    float* o = AOUT + O_GSS + (((size_t)l * DB + b) * 8 + hh) * 4096;
#pragma unroll
    for (int d = 0; d < 64; ++d) o[d * 64 + lane] = S[d];
}
__device__ __forceinline__ void p4_mixers(const Ctx& c0, int l) {
    const Ctx c = relaunder(c0);
    LAS float* wl = (LAS float*)(c.lds + c.wave * 4096);
    const int lane = c.lane;
    if (c.wave == 0 && c.bid < 32) gdn_item_prompt(c, l, c.bid >> 3, c.bid & 7, wl, lane);
    unsigned* head = c.ctl + (l ? CW_Q1 : CW_Q0);
    constexpr int N_GS = DB * 8, N_NS = DB * 2, N_NP = MPR * 2, N_ALL = N_GS + N_NS + N_NP, CH = 4;
    for (;;) {
        unsigned base = 0;
        if (lane == 0) base = __hip_atomic_fetch_add(head, (unsigned)CH, __ATOMIC_RELAXED, __HIP_MEMORY_SCOPE_AGENT);
        base = (unsigned)__builtin_amdgcn_readfirstlane((int)base);
        if (base >= (unsigned)N_ALL) break;
        for (int k = 0; k < CH; ++k) { int it = (int)base + k; if (it >= N_ALL) break;
            if (it < N_GS) { gdn_item_sample(c, l, it >> 3, it & 7, wl, lane); continue; } it -= N_GS;
            if (it < N_NS) { const int b = it >> 1, n = it & 1; nsa_item(c, l, true, MPR + b, b, PASTL, n, wl, lane); continue; } it -= N_NS;
            { const int n = it & 1, b = (it >> 1) & 3, t = SEQ - 1 - (it >> 3); nsa_item(c, l, false, b * SEQ + t, b, t, n, wl, lane); } }
    }
}

__device__ __forceinline__ void p_ln(const Ctx& c0, int l, int which, bool final_out) {
    const Ctx c = relaunder(c0);
    const int gw = c.bid * 8 + c.wave, NGW = c.G * 8, lane = c.lane;
    const float* T1 = (const float*)(AWS + WS_T1); float* XF = (float*)(AWS + WS_XF); bf16* XB = (bf16*)(AWS + WS_XB);
    const float* g = (const float*)AIN(I_LNG) + (size_t)(l * 3 + which) * DM; const float* bb = (const float*)AIN(I_LNB) + (size_t)(l * 3 + which) * DM;
    f32x4 gv[4], bv[4];
#pragma unroll
    for (int j = 0; j < 4; ++j) { gv[j] = *(const f32x4*)(g + lane * 4 + 256 * j); bv[j] = *(const f32x4*)(bb + lane * 4 + 256 * j); }
    for (int m = gw; m < MTOT; m += NGW) {
        const float* xr = T1 + (size_t)m * DM + lane * 4; f32x4 v[4]; float s = 0.f;
#pragma unroll
        for (int j = 0; j < 4; ++j) { v[j] = *(const f32x4*)(xr + 256 * j); s += (v[j][0] + v[j][1]) + (v[j][2] + v[j][3]); }
        const float mean = wave_sum(s) * (1.f / DM); float s2 = 0.f;
#pragma unroll
        for (int j = 0; j < 4; ++j) { v[j] = v[j] - mean; s2 += (v[j][0] * v[j][0] + v[j][1] * v[j][1]) + (v[j][2] * v[j][2] + v[j][3] * v[j][3]); }
        const float rstd = rsqrtf(wave_sum(s2) * (1.f / DM) + LN_EPS);
        float* of = final_out ? (m < MPR ? AOUT + O_YP + (size_t)m * DM : AOUT + O_YS + (size_t)(m - MPR) * DM) : XF + (size_t)m * DM;
#pragma unroll
        for (int j = 0; j < 4; ++j) { const f32x4 y = v[j] * rstd * gv[j] + bv[j]; *(f32x4*)(of + lane * 4 + 256 * j) = y;
            if (!final_out) { u32x2 w; w.x = pk2(y[0], y[1]); w.y = pk2(y[2], y[3]); *(u32x2*)(XB + (size_t)m * DM + lane * 4 + 256 * j) = w; } }
    }
}

__device__ __forceinline__ float gelu_erf(float x) { return 0.5f * x * (1.0f + erff(x * 0.70710678118654752f)); }
__device__ __forceinline__ void p8_act(const Ctx& c0, int l) {
    const Ctx c = relaunder(c0);
    const bf16* UP = (const bf16*)(AWS + WS_UP); bf16* ACT = (bf16*)(AWS + WS_ACT);
    const float* fw = (const float*)AIN(I_FCW) + (size_t)l * 3 * DFF; const float* sfc = (const float*)AIN(I_SFCONV) + (size_t)l * DB * 2 * DFF;
    const size_t gt = (size_t)c.bid * 512 + c.tid, GT = (size_t)c.G * 512;
    constexpr int CPR = DFF / 4;
    for (size_t i = gt; i < (size_t)MTOT * CPR; i += GT) { const int m = (int)(i / CPR), cc = (int)(i % CPR) * 4;
        const u32x2 u0 = *(const u32x2*)(UP + (size_t)m * UPW + cc); const u32x2 um = *(const u32x2*)(UP + (size_t)m * UPW + DFF + cc);
        float x0[4] = {__uint_as_float(u0.x << 16), __uint_as_float(u0.x & 0xffff0000u), __uint_as_float(u0.y << 16), __uint_as_float(u0.y & 0xffff0000u)};
        float mu[4] = {__uint_as_float(um.x << 16), __uint_as_float(um.x & 0xffff0000u), __uint_as_float(um.y << 16), __uint_as_float(um.y & 0xffff0000u)};
        float x1[4] = {0.f, 0.f, 0.f, 0.f}, x2[4] = {0.f, 0.f, 0.f, 0.f};
        if (m < MPR) { const int t = m & (SEQ - 1);
            if (t >= 1) { const u32x2 w = *(const u32x2*)(UP + (size_t)(m - 1) * UPW + cc); x1[0] = __uint_as_float(w.x << 16); x1[1] = __uint_as_float(w.x & 0xffff0000u); x1[2] = __uint_as_float(w.y << 16); x1[3] = __uint_as_float(w.y & 0xffff0000u); }
            if (t >= 2) { const u32x2 w = *(const u32x2*)(UP + (size_t)(m - 2) * UPW + cc); x2[0] = __uint_as_float(w.x << 16); x2[1] = __uint_as_float(w.x & 0xffff0000u); x2[2] = __uint_as_float(w.y << 16); x2[3] = __uint_as_float(w.y & 0xffff0000u); } }
        else { const int b = m - MPR; const f32x4 s0 = *(const f32x4*)(sfc + ((size_t)b * 2 + 0) * DFF + cc), s1 = *(const f32x4*)(sfc + ((size_t)b * 2 + 1) * DFF + cc);
#pragma unroll
            for (int j = 0; j < 4; ++j) { x2[j] = s0[j]; x1[j] = s1[j]; } }
        const f32x4 w0 = *(const f32x4*)(fw + cc), w1 = *(const f32x4*)(fw + DFF + cc), w2 = *(const f32x4*)(fw + 2 * DFF + cc);
        float r[4];
#pragma unroll
        for (int j = 0; j < 4; ++j) r[j] = gelu_erf(w0[j] * x2[j] + w1[j] * x1[j] + w2[j] * x0[j]) * mu[j];
        u32x2 w; w.x = pk2(r[0], r[1]); w.y = pk2(r[2], r[3]); *(u32x2*)(ACT + (size_t)m * DFF + cc) = w; }
    { float* o = AOUT + O_FCP + (size_t)l * 4 * 2 * DFF;
      for (size_t i = gt; i < (size_t)4 * 2 * DFF; i += GT) { const int cc = (int)(i % DFF), r = (int)(i / DFF) & 1, b = (int)(i / (2 * DFF)); o[i] = bf2f(UP[(size_t)(b * SEQ + SEQ - 2 + r) * UPW + cc]); } }
    { float* o = AOUT + O_FCS + (size_t)l * DB * 2 * DFF;
      for (size_t i = gt; i < (size_t)DB * 2 * DFF; i += GT) { const int cc = (int)(i % DFF), r = (int)(i / DFF) & 1, b = (int)(i / (2 * DFF)); o[i] = (r == 0) ? sfc[i + DFF] : bf2f(UP[(size_t)(MPR + b) * UPW + cc]); } }
}

constexpr int NPH = 2 + 2 * 11;
__global__ void __launch_bounds__(512, 2) fwd_kernel(Args a) {
    extern __shared__ __attribute__((aligned(16))) unsigned char lds_raw[];
    Ctx c; c.lds = (LAS unsigned char*)lds_raw; c.tid = threadIdx.x; c.lane = c.tid & 63; c.wave = __builtin_amdgcn_readfirstlane(c.tid >> 6); c.bid = blockIdx.x; c.G = gridDim.x;
    volatile LAS unsigned* MISC = (volatile LAS unsigned*)(c.lds + MISC_OFF);
    for (int u = c.tid; u < (LDS_BYTES - RING_BYTES) / 4; u += 512) ((LAS unsigned*)(c.lds + RING_BYTES))[u] = 0u;
    __syncthreads();
    { const unsigned* ap = (const unsigned*)&a; LAS unsigned* la = (LAS unsigned*)(c.lds + ARGS_OFF); if (c.tid < 56) la[c.tid] = ap[c.tid]; c.la = la; }
    __syncthreads();
    c.ctl = (unsigned*)(AWS + WS_CTL);
    XcdBarrier bar; bar.bar = c.ctl + CW_BAR; bar.x = 0; bar.st = nullptr;
    const int lo = a.ph_lo, hi = a.ph_hi;
    if (hi - lo > 1) bar = xcd_barrier_post(c.ctl + CW_BAR, MISC + 8);
#define IN(k) (lo <= (k) && (k) < hi)
#define SEAM(k) do { if (IN(k) && IN((k) + 1)) xcd_barrier(bar); } while (0)
    LAS unsigned char* ring = c.lds;
    if (IN(0)) { p0_prologue(c); } SEAM(0);
    if (IN(1)) {
        for (int l = 0; l < 2; ++l) {
            pg8::Gemm g{(const pg8::bf16_t*)(AWS + WS_PB) + (size_t)l * MPAD * PLED, (const pg8::bf16_t*)(AWS + WS_WPJ) + (size_t)l * DM * PLED, MPAD, DM, PLED};
            pg8::StaticOrder S; S.init(MPAD, DM, c.G, c.bid); pg8::EpiF32 E{(float*)(AWS + WS_PP) + (size_t)l * MPAD * DM, DM};
            pg8::gemm_phase<pg8::EpiF32, pg8::StaticOrder, false, false>(ring, g, S, E, c.wave); }
    } SEAM(1);
    for (int l = 0; l < 2; ++l) {
        const int p = 2 + l * 11;
        if (IN(p + 0)) {
            pg8::Gemm g{(const pg8::bf16_t*)(AWS + WS_XB), (const pg8::bf16_t*)(AWS + WS_WIN) + (size_t)l * HW * DM, MPAD, HW, DM};
            pg8::StaticOrder S; S.init(MPAD, HW, c.G, c.bid);
            pg8::EpiIn E{(pg8::bf16_t*)(AWS + WS_H), (float*)(AWS + WS_HS), AOUT + O_KVP + (size_t)l * MPR * 512, AOUT + O_KVS + (size_t)l * DB * 512};
            pg8::gemm_phase<pg8::EpiIn, pg8::StaticOrder, false, false>(ring, g, S, E, c.wave);
        } SEAM(p + 0);
        if (IN(p + 1)) { p3_prep(c, l); } SEAM(p + 1);
        if (IN(p + 2)) { p4_mixers(c, l); } SEAM(p + 2);
        if (IN(p + 3)) {
            pg8::Gemm g{(const pg8::bf16_t*)(AWS + WS_MIX), (const pg8::bf16_t*)(AWS + WS_WOUT) + (size_t)l * DM * DM, MPAD, DM, DM};
            pg8::StaticOrder S; S.init(MPAD, DM, c.G, c.bid); pg8::EpiRes E{(const float*)(AWS + WS_XF), (float*)(AWS + WS_T1)};
            pg8::gemm_phase<pg8::EpiRes, pg8::StaticOrder, false, false>(ring, g, S, E, c.wave);
        } SEAM(p + 3);
        if (IN(p + 4)) { p_ln(c, l, 0, false); } SEAM(p + 4);
        if (IN(p + 5)) {
            pg8::Gemm g{(const pg8::bf16_t*)(AWS + WS_XB), (const pg8::bf16_t*)(AWS + WS_WUP) + (size_t)l * UPW * DM, MPAD, UPW, DM};
            pg8::StaticOrder S; S.init(MPAD, UPW, c.G, c.bid); pg8::EpiBf16<0> E{(pg8::bf16_t*)(AWS + WS_UP), UPW, nullptr, 0, 0, 1.f};
            pg8::gemm_phase<pg8::EpiBf16<0>, pg8::StaticOrder, false, false>(ring, g, S, E, c.wave);
        } SEAM(p + 5);
        if (IN(p + 6)) { p8_act(c, l); } SEAM(p + 6);
        if (IN(p + 7)) {
            pg8::Gemm g{(const pg8::bf16_t*)(AWS + WS_ACT), (const pg8::bf16_t*)(AWS + WS_WDN) + (size_t)l * DM * DFF, MPAD, DM, DFF};
            pg8::StaticOrder S; S.init(MPAD, DM, c.G, c.bid); pg8::EpiRes E{(const float*)(AWS + WS_XF), (float*)(AWS + WS_T1)};
            pg8::gemm_phase<pg8::EpiRes, pg8::StaticOrder, false, false>(ring, g, S, E, c.wave);
        } SEAM(p + 7);
        if (IN(p + 8)) { p_ln(c, l, 1, false); } SEAM(p + 8);
        if (IN(p + 9)) {
            pg8::Gemm g{(const pg8::bf16_t*)(AWS + WS_XB), (const pg8::bf16_t*)(AWS + WS_WGT) + (size_t)l * DM * DM, MPAD, DM, DM};
            pg8::StaticOrder S; S.init(MPAD, DM, c.G, c.bid); pg8::EpiGate E{(const float*)(AWS + WS_XF), (const float*)(AWS + WS_PP) + (size_t)l * MPAD * DM, (float*)(AWS + WS_T1)};
            pg8::gemm_phase<pg8::EpiGate, pg8::StaticOrder, false, false>(ring, g, S, E, c.wave);
        } SEAM(p + 9);
        if (IN(p + 10)) { p_ln(c, l, 2, l == 1); } SEAM(p + 10);
    }
#undef IN
#undef SEAM
}

extern "C" void kernel_launch(void* const* d_in, const int* in_sizes, int n_in, void* d_out, int out_size, void* d_ws, size_t ws_size, hipStream_t stream) {
    static int grid = 0;
    if (grid == 0) {
        if (n_in != 25 || (size_t)out_size != O_END || ws_size < WS_END) { fprintf(stderr, "kernel_launch: unexpected shapes (n_in %d out %d ws %zu)\n", n_in, out_size, ws_size); grid = -1; return; }
        int dev = 0, cus = 0;
        if (hipGetDevice(&dev) != hipSuccess || hipDeviceGetAttribute(&cus, hipDeviceAttributeMultiprocessorCount, dev) != hipSuccess) { grid = -1; return; }
        if (hipFuncSetAttribute((const void*)fwd_kernel, hipFuncAttributeMaxDynamicSharedMemorySize, LDS_BYTES) != hipSuccess) { fprintf(stderr, "kernel_launch: hipFuncSetAttribute failed\n"); grid = -1; return; }
        int per_cu = 0; (void)hipOccupancyMaxActiveBlocksPerMultiprocessor(&per_cu, (const void*)fwd_kernel, 512, LDS_BYTES); (void)hipGetLastError();
        grid = cus;
    }
    if (grid < 0) return;
    (void)hipMemsetAsync((char*)d_ws + WS_CTL, 0, CTL_BYTES, stream);
    Args a{};
    for (int i = 0; i < 25; ++i) a.in[i] = d_in[i];
    a.out = (float*)d_out; a.ws = (unsigned char*)d_ws;
#if MK_MULTI
    for (int p = 0; p < NPH; ++p) { a.ph_lo = p; a.ph_hi = p + 1; hipLaunchKernelGGL(fwd_kernel, dim3(grid), dim3(512), LDS_BYTES, stream, a); }
#else
    a.ph_lo = 0; a.ph_hi = NPH; hipLaunchKernelGGL(fwd_kernel, dim3(grid), dim3(512), LDS_BYTES, stream, a);
#endif
}
```

```cpp
#include <hip/hip_runtime.h>
#include <cstdio>
#include <cstdint>
namespace pg8 {
#define PG8_LAS __attribute__((address_space(3)))
typedef unsigned short bf16_t;
typedef short bf16x8 __attribute__((ext_vector_type(8)));
typedef float f32x4 __attribute__((ext_vector_type(4)));
typedef unsigned u32x4 __attribute__((ext_vector_type(4)));
constexpr int BM = 256, BK = 64, HALF = 128, HTB = HALF * BK * 2  , STAGE_BYTES = 8 * HTB, NXCD = 8, WGM = 8;

__host__ __device__ __forceinline__ int lds_byte(int r, int c) { const int st = (r >> 4) * 2 + (c >> 5), rr = r & 15, cc = c & 31, ob = rr * 64 + cc * 2; return st * 1024 + (ob ^ (((ob >> 9) & 1) << 5)); }
__host__ __device__ __forceinline__ void stage_rc(int b, int& R, int& C) { const int st = b / 1024, sb = b % 1024, swz = sb ^ (((sb >> 9) & 1) << 5); R = (st >> 1) * 16 + swz / 64; C = (st & 1) * 32 + (swz % 64) / 2; }
__host__ __device__ __forceinline__ int perm32(int rho) { const int n = rho >> 4, i = rho & 15; return 8 * (i >> 2) + 4 * n + (i & 3); }

struct Unit { int pm, pn; };
struct Gemm { const bf16_t* A; const bf16_t* Bt; int M, N, K; };

struct StaticOrder {
    int nM, nN, nwg, G, c;
    __host__ __device__ void init(int M, int N, int G_, int c_) { nM = M / BM; nN = N / BM; nwg = nM * nN; G = G_; c = c_; }
    __host__ __device__ bool next(int i, Unit& u) const {
        const long L = (long)i * G + c; if (L >= nwg) return false;
        int wgid = (int)L; { const int q = nwg / NXCD, r = nwg % NXCD, xcd = wgid % NXCD, off = wgid / NXCD; wgid = (xcd < r ? xcd * (q + 1) : r * (q + 1) + (xcd - r) * q) + off; }
        const int nig = WGM * nN, gid = wgid / nig, fm = gid * WGM, gsz = (nM - fm) < WGM ? (nM - fm) : WGM;
        u.pm = fm + ((wgid % nig) % gsz); u.pn = (wgid % nig) / gsz; return true;
    }
    __device__ __forceinline__ void a_ready(const Unit&) const {}
    __device__ __forceinline__ void done(const Unit&) const {}
};

__device__ __forceinline__ unsigned cvt_pk_bf16(float lo, float hi) { unsigned r; asm volatile("v_cvt_pk_bf16_f32 %0, %1, %2" : "=v"(r) : "v"(lo), "v"(hi)); return r; }
typedef float f32x2 __attribute__((ext_vector_type(2)));
__device__ __forceinline__ f32x2 gelu_pk(f32x2 v) {
    const f32x2 av = __builtin_elementwise_abs(v), d = av * 0.2316418882f + 1.0f;
    f32x2 t; t.x = __builtin_amdgcn_rcpf(d.x); t.y = __builtin_amdgcn_rcpf(d.y);
    f32x2 q = t * 0.5307027145f + (-0.7265760135f); q = q * t + 0.7107068705f; q = q * t + (-0.142248368f); q = q * t + 0.127414796f; q = q * t;
    const f32x2 s = (v * v) * (-0.72134752044f);
    f32x2 e; e.x = __builtin_amdgcn_exp2f(s.x); e.y = __builtin_amdgcn_exp2f(s.y);
    const f32x2 m = v * (q * e), r = v - m;
    f32x2 o; o.x = v.x < 0.f ? m.x : r.x; o.y = v.y < 0.f ? m.y : r.y; return o;
}

template <int ACT  > struct EpiBf16 {
    static constexpr bool PERM = true, AFTER_DRAIN = false; static_assert(ACT == 0 || ACT == 1, "EpiBf16: ACT is 0 (none) or 1 (gelu_pk)");
    bf16_t* O; int ldc; const float* bias; int split_cols; size_t split_stride; float scale0;
    __device__ __forceinline__ void operator()(const f32x4 (&acc)[2][2][4][2], const Unit& u, int wr, int wc, int fr, int fq) const {
        const int row0 = u.pm * BM + wr * 64 + fr; int colt = u.pn * BM; bf16_t* base = O;
        float sc = 1.f; if (split_cols) { const int t = colt / split_cols; base += (size_t)t * split_stride; colt -= t * split_cols; if (t == 0) sc = scale0; }
        const int col0 = colt + wc * 32 + 8 * fq, bcol0 = u.pn * BM + wc * 32 + 8 * fq;
        f32x4 bv[2][2];
#pragma unroll
        for (int bj = 0; bj < 2; ++bj)
#pragma unroll
            for (int n = 0; n < 2; ++n) bv[bj][n] = bias ? *(const f32x4*)(bias + bcol0 + bj * HALF + 4 * n) : (f32x4){0.f, 0.f, 0.f, 0.f};
#pragma unroll
        for (int ai = 0; ai < 2; ++ai)
#pragma unroll
            for (int m = 0; m < 4; ++m) { bf16_t* rowp = base + (size_t)(row0 + ai * HALF + m * 16) * ldc + col0;
#pragma unroll
                for (int bj = 0; bj < 2; ++bj) { f32x4 v0 = acc[ai][bj][m][0] + bv[bj][0], v1 = acc[ai][bj][m][1] + bv[bj][1];
                    if (ACT == 1) { f32x2 a = gelu_pk((f32x2){v0[0], v0[1]}), b = gelu_pk((f32x2){v0[2], v0[3]}), c = gelu_pk((f32x2){v1[0], v1[1]}), d = gelu_pk((f32x2){v1[2], v1[3]});
                        v0 = (f32x4){a.x, a.y, b.x, b.y}; v1 = (f32x4){c.x, c.y, d.x, d.y}; }
                    v0 = v0 * sc; v1 = v1 * sc; u32x4 w; w.x = cvt_pk_bf16(v0[0], v0[1]); w.y = cvt_pk_bf16(v0[2], v0[3]); w.z = cvt_pk_bf16(v1[0], v1[1]); w.w = cvt_pk_bf16(v1[2], v1[3]);
                    *(u32x4*)(rowp + bj * HALF) = w; } }
    }
};
template <class Epi, class Sched, bool ALIGN_EPI = false, bool SP2 = false>
__device__ __forceinline__ void gemm_phase(PG8_LAS unsigned char* lds, const Gemm g, const Sched& S, const Epi& E, int wave_idx  ) {
    int tid_ = (int)__builtin_amdgcn_mbcnt_hi(~0u, __builtin_amdgcn_mbcnt_lo(~0u, 0u)); asm volatile("" : "+v"(tid_)); tid_ += 64 * wave_idx;
    const int tid = tid_, wid = wave_idx, lane = tid & 63, wr = wid >> 2, wc = wid & 3, fr = lane & 15, fq = lane >> 4;
    const int K = g.K, nt = K / BK;
    unsigned voffA[2], voffB[2];
#pragma unroll
    for (int i = 0; i < 2; ++i) { int R, C; stage_rc(tid * 16 + i * 8192, R, C); const int Rb = Epi::PERM ? ((R & ~31) + perm32(R & 31)) : R;
        voffA[i] = (unsigned)(R * K + C) * 2u; voffB[i] = (unsigned)(Rb * K + C) * 2u; }
    const size_t kstep = (size_t)(BK * 2);
    const size_t hstep = (size_t)HALF * K * 2;
    const size_t tstep = 2 * hstep;
    const unsigned ldsw = (unsigned)wid * 1024u;
    const int aoff = lds_byte(wr * 64 + fr, fq * 8), boff = lds_byte(wc * 32 + fr, fq * 8);
#define PG8_SA(b, h) (((b) * 2 + (h)) * HTB)
#define PG8_SB(b, h) ((4 + (b) * 2 + (h)) * HTB)
#define PG8_STAGE(bufoff, gbase, voff) do { _Pragma("unroll") for (int _i = 0; _i < 2; ++_i) \
        __builtin_amdgcn_global_load_lds((const unsigned*)((const char*)(gbase) + (voff)[_i]), (PG8_LAS unsigned*)(lds + (bufoff) + ldsw + _i * 8192), 16, 0, 0); } while (0)
#define PG8_LDA(dst, b, h) do { _Pragma("unroll") for (int m = 0; m < 4; ++m) _Pragma("unroll") for (int k = 0; k < 2; ++k) dst[m][k] = *(const PG8_LAS bf16x8*)(lds + PG8_SA(b, h) + aoff + m * 2048 + k * 1024); } while (0)
#define PG8_LDB(dst, b, h) do { _Pragma("unroll") for (int n = 0; n < 2; ++n) _Pragma("unroll") for (int k = 0; k < 2; ++k) dst[n][k] = *(const PG8_LAS bf16x8*)(lds + PG8_SB(b, h) + boff + n * 2048 + k * 1024); } while (0)
#define PG8_MMA(ai, bj, At, Bt) do { __builtin_amdgcn_s_setprio(1); _Pragma("unroll") for (int m = 0; m < 4; ++m) _Pragma("unroll") for (int n = 0; n < 2; ++n) _Pragma("unroll") for (int k = 0; k < 2; ++k) \
        acc[ai][bj][m][n] = __builtin_amdgcn_mfma_f32_16x16x32_bf16(Bt[n][k], At[m][k], acc[ai][bj][m][n], 0, 0, 0); __builtin_amdgcn_s_setprio(0); } while (0)
#define PG8_WAIT_V(n) asm volatile("s_waitcnt vmcnt(" #n ")" ::: "memory")
#define PG8_WAIT_L(n) asm volatile("s_waitcnt lgkmcnt(" #n ")" ::: "memory")
#define PG8_BAR __builtin_amdgcn_s_barrier()
#define PG8_SCHED __builtin_amdgcn_sched_barrier(0)
    Unit cur, nxt; int ui = 0;
    if (!S.next(0, cur)) return;
    f32x4 acc[2][2][4][2];
#pragma unroll
    for (int a = 0; a < 2; ++a)
#pragma unroll
        for (int b = 0; b < 2; ++b)
#pragma unroll
            for (int m = 0; m < 4; ++m)
#pragma unroll
                for (int n = 0; n < 2; ++n) acc[a][b][m][n] = (f32x4){0.f, 0.f, 0.f, 0.f};
    bf16x8 At[4][2], B0[2][2], B1[2][2];
    const char* cA = (const char*)g.A + (size_t)cur.pm * tstep; const char* cB = (const char*)g.Bt + (size_t)cur.pn * tstep;
    S.a_ready(cur);
    if constexpr (SP2) {
        PG8_STAGE(PG8_SB(0, 0), cB, voffB); PG8_STAGE(PG8_SB(0, 1), cB + hstep, voffB); PG8_STAGE(PG8_SA(0, 0), cA, voffA); PG8_STAGE(PG8_SA(0, 1), cA + hstep, voffA);
        if (wr == 1) PG8_BAR;
        PG8_WAIT_V(2); PG8_BAR;
        PG8_STAGE(PG8_SB(1, 0), cB + kstep, voffB); PG8_STAGE(PG8_SA(1, 0), cA + kstep, voffA); PG8_STAGE(PG8_SB(1, 1), cB + hstep + kstep, voffB);
        PG8_WAIT_V(6); PG8_BAR;
    } else {
        PG8_STAGE(PG8_SB(0, 0), cB, voffB); PG8_STAGE(PG8_SA(0, 0), cA, voffA); PG8_STAGE(PG8_SB(0, 1), cB + hstep, voffB); PG8_STAGE(PG8_SA(0, 1), cA + hstep, voffA);
        if (wr == 1) PG8_BAR;
        PG8_WAIT_V(4); PG8_BAR;
        PG8_STAGE(PG8_SB(1, 0), cB + kstep, voffB); PG8_STAGE(PG8_SA(1, 0), cA + kstep, voffA); PG8_STAGE(PG8_SB(1, 1), cB + hstep + kstep, voffB);
        PG8_WAIT_V(6); PG8_BAR;
    }
    for (;;) {
        const bool has_next = S.next(ui + 1, nxt);
        const char* nA = has_next ? (const char*)g.A + (size_t)nxt.pm * tstep : cA; const char* nB = has_next ? (const char*)g.Bt + (size_t)nxt.pn * tstep : cB;
        for (int t = 0; t < nt; t += 2) {
            const bool last = (t == nt - 2);
            const char* a1 = cA + (size_t)(t + 1) * kstep;
            const char* a2 = last ? nA : cA + (size_t)(t + 2) * kstep; const char* b2 = last ? nB : cB + (size_t)(t + 2) * kstep;
            const char* a3 = a2 + kstep; const char* b3 = b2 + kstep;
            if (last && has_next) S.a_ready(nxt);
            if constexpr (SP2) {
            PG8_LDB(B0, 0, 0); PG8_LDB(B1, 0, 1); PG8_SCHED; PG8_LDA(At, 0, 0); PG8_STAGE(PG8_SA(1, 1), a1 + hstep, voffA);
            PG8_WAIT_V(8); PG8_WAIT_L(0); PG8_BAR; PG8_MMA(0, 0, At, B0); PG8_MMA(0, 1, At, B1); PG8_BAR; PG8_SCHED;
            PG8_LDA(At, 0, 1); PG8_STAGE(PG8_SB(0, 0), b2, voffB); PG8_STAGE(PG8_SB(0, 1), b2 + hstep, voffB); PG8_STAGE(PG8_SA(0, 0), a2, voffA);
            PG8_WAIT_V(8); PG8_WAIT_L(0); PG8_BAR; PG8_MMA(1, 0, At, B0); PG8_MMA(1, 1, At, B1); PG8_BAR; PG8_SCHED;
            PG8_LDB(B0, 1, 0); PG8_LDB(B1, 1, 1); PG8_SCHED; PG8_LDA(At, 1, 0); PG8_STAGE(PG8_SA(0, 1), a2 + hstep, voffA);
            PG8_WAIT_V(8); PG8_WAIT_L(0); PG8_BAR; PG8_MMA(0, 0, At, B0); PG8_MMA(0, 1, At, B1); PG8_BAR; PG8_SCHED;
            PG8_LDA(At, 1, 1); PG8_STAGE(PG8_SB(1, 0), b3, voffB); PG8_STAGE(PG8_SB(1, 1), b3 + hstep, voffB); PG8_STAGE(PG8_SA(1, 0), a3, voffA);
            PG8_WAIT_V(8); PG8_WAIT_L(0); PG8_BAR; PG8_MMA(1, 0, At, B0); PG8_MMA(1, 1, At, B1); PG8_BAR; PG8_SCHED;
            } else {
            PG8_LDB(B0, 0, 0); PG8_SCHED; PG8_LDA(At, 0, 0); PG8_STAGE(PG8_SA(1, 1), a1 + hstep, voffA);
            PG8_WAIT_L(8); PG8_BAR; PG8_WAIT_L(0); PG8_MMA(0, 0, At, B0); PG8_BAR; PG8_SCHED;
            PG8_LDB(B1, 0, 1); PG8_STAGE(PG8_SB(0, 0), b2, voffB);
            PG8_BAR; PG8_WAIT_L(0); PG8_MMA(0, 1, At, B1); PG8_BAR;
            PG8_LDA(At, 0, 1); PG8_STAGE(PG8_SA(0, 0), a2, voffA);
            PG8_BAR; PG8_WAIT_L(0); PG8_MMA(1, 0, At, B0); PG8_BAR; PG8_SCHED;
            PG8_STAGE(PG8_SB(0, 1), b2 + hstep, voffB);
            PG8_WAIT_V(6); PG8_BAR; PG8_MMA(1, 1, At, B1); PG8_BAR;
            PG8_LDB(B0, 1, 0); PG8_SCHED; PG8_LDA(At, 1, 0); PG8_STAGE(PG8_SA(0, 1), a2 + hstep, voffA);
            PG8_WAIT_L(8); PG8_BAR; PG8_WAIT_L(0); PG8_MMA(0, 0, At, B0); PG8_BAR; PG8_SCHED;
            PG8_LDB(B1, 1, 1); PG8_STAGE(PG8_SB(1, 0), b3, voffB);
            PG8_BAR; PG8_WAIT_L(0); PG8_MMA(0, 1, At, B1); PG8_BAR;
            PG8_LDA(At, 1, 1); PG8_STAGE(PG8_SA(1, 0), a3, voffA);
            PG8_BAR; PG8_WAIT_L(0); PG8_MMA(1, 0, At, B0); PG8_BAR; PG8_SCHED;
            PG8_STAGE(PG8_SB(1, 1), b3 + hstep, voffB);
            PG8_WAIT_V(6); PG8_BAR; PG8_MMA(1, 1, At, B1); PG8_BAR;
            }
        }
        if constexpr (ALIGN_EPI) { if (wr == 0) PG8_BAR; }
        if constexpr (!Epi::AFTER_DRAIN) { E(acc, cur, wr, wc, fr, fq); S.done(cur); }
        if (!has_next) break;
#pragma unroll
        for (int a = 0; a < 2; ++a)
#pragma unroll
            for (int b = 0; b < 2; ++b)
#pragma unroll
                for (int m = 0; m < 4; ++m)
#pragma unroll
                    for (int n = 0; n < 2; ++n) acc[a][b][m][n] = (f32x4){0.f, 0.f, 0.f, 0.f};
        cur = nxt; cA = nA; cB = nB; ++ui;
        if constexpr (ALIGN_EPI) { if (wr == 1) PG8_BAR; }
    }
    PG8_WAIT_V(0);
    if constexpr (!ALIGN_EPI) { if (wr == 0) PG8_BAR; }
    PG8_BAR;
    if constexpr (Epi::AFTER_DRAIN) { E.fused(acc, cur, wr, wc, fr, fq, lds, wid, lane); S.done(cur); }
#undef PG8_SA
#undef PG8_SB
#undef PG8_STAGE
#undef PG8_LDA
#undef PG8_LDB
#undef PG8_MMA
#undef PG8_WAIT_V
#undef PG8_WAIT_L
#undef PG8_BAR
#undef PG8_SCHED
}
}

#ifndef MK_MULTI
#define MK_MULTI 0
#endif
#define LAS __attribute__((address_space(3)))
typedef unsigned short bf16;
typedef float f32x4 __attribute__((ext_vector_type(4)));
typedef unsigned u32x4 __attribute__((ext_vector_type(4)));
typedef unsigned u32x2 __attribute__((ext_vector_type(2)));

constexpr int DM = 1024, NBATCH = 4, SEQ = 4096, MPR = NBATCH * SEQ, DB = 128, MTOT = MPR + DB, MPAD = 16640;
constexpr int PASTL = 2048, NPOOL = 2560, NPG = 16;
constexpr int INW = 3368, HW = 3584, DFF = 2816, UPW = 5632, PLED = 256;
constexpr int HQ = 0, HKV = 512, HWIN = 1024, HGQKV = 1280, HGZ = 2816, HSM = 3328;
constexpr int GQKV = 1536;
constexpr float LN_EPS = 1e-5f, RMS_EPS = 1e-6f, NEGV = -1e30f;
constexpr float DN_ALPHA = 1.41421356237309515f;

constexpr size_t O_YP = 0, O_YS = O_YP + (size_t)MPR * DM, O_KVP = O_YS + (size_t)DB * DM, O_KVS = O_KVP + (size_t)2 * MPR * 512,
                 O_WINP = O_KVS + (size_t)2 * DB * 512, O_WINS = O_WINP + (size_t)2 * 4 * 512 * 256, O_GSP = O_WINS + (size_t)2 * DB * 512 * 256,
                 O_GSS = O_GSP + (size_t)2 * 4 * 8 * 4096, O_GCP = O_GSS + (size_t)2 * DB * 8 * 4096, O_GCS = O_GCP + (size_t)2 * 4 * 3 * GQKV,
                 O_FCP = O_GCS + (size_t)2 * DB * 3 * GQKV, O_FCS = O_FCP + (size_t)2 * 4 * 2 * DFF, O_END = O_FCS + (size_t)2 * DB * 2 * DFF;

constexpr size_t MiB = 1u << 20;
constexpr size_t alup(size_t x) { return (x + MiB - 1) & ~(MiB - 1); }
constexpr size_t WS_CTL = 0, CTL_BYTES = 1 * MiB;
constexpr size_t WS_WIN = WS_CTL + CTL_BYTES;
constexpr size_t WS_WOUT = WS_WIN + alup((size_t)2 * HW * DM * 2);
constexpr size_t WS_WUP = WS_WOUT + alup((size_t)2 * DM * DM * 2);
constexpr size_t WS_WDN = WS_WUP + alup((size_t)2 * UPW * DM * 2);
constexpr size_t WS_WGT = WS_WDN + alup((size_t)2 * DM * DFF * 2);
constexpr size_t WS_WPJ = WS_WGT + alup((size_t)2 * DM * DM * 2);
constexpr size_t WS_XF = WS_WPJ + alup((size_t)2 * DM * PLED * 2);
constexpr size_t WS_XB = WS_XF + alup((size_t)MPAD * DM * 4);
constexpr size_t WS_T1 = WS_XB + alup((size_t)MPAD * DM * 2);
constexpr size_t WS_H = WS_T1 + alup((size_t)MPAD * DM * 4);
constexpr size_t WS_HS = WS_H + alup((size_t)MPAD * HW * 2);
constexpr size_t WS_PB = WS_HS + alup((size_t)MPAD * 64 * 4);
constexpr size_t WS_PP = WS_PB + alup((size_t)2 * MPAD * PLED * 2);
constexpr size_t WS_MIX = WS_PP + alup((size_t)2 * MPAD * DM * 4);
constexpr size_t WS_UP = WS_MIX + alup((size_t)MPAD * DM * 2);
constexpr size_t WS_ACT = WS_UP + alup((size_t)MPAD * UPW * 2);
constexpr size_t WS_GQ = WS_ACT + alup((size_t)MPAD * DFF * 2);
constexpr size_t WS_GK = WS_GQ + alup((size_t)MTOT * 512 * 4);
constexpr size_t WS_GV = WS_GK + alup((size_t)MTOT * 512 * 4);
constexpr size_t WS_GG = WS_GV + alup((size_t)MTOT * 512 * 4);
constexpr size_t WS_GB = WS_GG + alup((size_t)MTOT * 8 * 4);
constexpr size_t WS_KCP = WS_GB + alup((size_t)MTOT * 8 * 4);
constexpr size_t WS_VCP = WS_KCP + alup((size_t)4 * 128 * 128 * 4);
constexpr size_t WS_KCS = WS_VCP + alup((size_t)4 * 128 * 128 * 4);
constexpr size_t WS_VCS = WS_KCS + alup((size_t)DB * 64 * 128 * 4);
constexpr size_t WS_END = WS_VCS + alup((size_t)DB * 64 * 128 * 4);
constexpr int CW_Q0 = 64, CW_Q1 = 128;
constexpr int CW_BAR = 4096;

constexpr int RING_BYTES = 131072, MISC_OFF = RING_BYTES + 320, ARGS_OFF = RING_BYTES + 1024, LDS_BYTES = 147456;

__device__ __forceinline__ float bf2f(bf16 v) { return __uint_as_float(((unsigned)v) << 16); }
__device__ __forceinline__ unsigned f2bf(float f) { unsigned u = __float_as_uint(f); return (u + 0x7fffu + ((u >> 16) & 1u)) >> 16; }
__device__ __forceinline__ unsigned pk2(float lo, float hi) { return f2bf(lo) | (f2bf(hi) << 16); }
__device__ __forceinline__ float wave_sum(float v) {
#pragma unroll
    for (int o = 1; o < 64; o <<= 1) v += __shfl_xor(v, o);
    return v;
}
__device__ __forceinline__ float wave_max(float v) {
#pragma unroll
    for (int o = 1; o < 64; o <<= 1) v = fmaxf(v, __shfl_xor(v, o));
    return v;
}
__device__ __forceinline__ void wave_lds_sync() { asm volatile("s_waitcnt lgkmcnt(0)" ::: "memory"); }
__device__ __forceinline__ float sigmoidf_(float x) { return 1.0f / (1.0f + __expf(-x)); }
__device__ __forceinline__ float siluf_(float x) { return x / (1.0f + __expf(-x)); }
__device__ __forceinline__ float softplusf_(float x) { return fmaxf(x, 0.f) + log1pf(__expf(-fabsf(x))); }

#define XB_TMO      128
#define XB_XCNT(j)  (256  + 64 * (j))
#define XB_XSUB(j)  (1280 + 64 * (j))
#define XB_XGEN(j)  (2304 + 64 * (j))
#define XB_TOP      3328
#define XB_TOPGEN   3392
#define XCD_BAR_WORDS 3456
#define XB_SPIN_CAP (1u << 18)
__device__ __forceinline__ unsigned xb_ld(unsigned* p)              { return __hip_atomic_load(p, __ATOMIC_RELAXED, __HIP_MEMORY_SCOPE_AGENT); }
__device__ __forceinline__ unsigned xb_add(unsigned* p, unsigned v) { return __hip_atomic_fetch_add(p, v, __ATOMIC_RELAXED, __HIP_MEMORY_SCOPE_AGENT); }
__device__ __forceinline__ unsigned xb_xcc_id() { return (unsigned)__builtin_amdgcn_s_getreg((3 << 11) | 20) & 0xFu; }
#define XB_SPIN(cond, bar) do { unsigned _sp = 0; while (cond) { __builtin_amdgcn_s_sleep(1); \
    if ((++_sp & 255u) == 0u) { if (xb_ld(&(bar)[XB_TMO])) break; if (_sp > XB_SPIN_CAP) { atomicAdd(&(bar)[XB_TMO], 1u); break; } } } } while (0)
struct XcdBarrier { unsigned* bar; unsigned x; volatile LAS unsigned* st; };
__device__ __forceinline__ XcdBarrier xcd_barrier_post(unsigned* bar, volatile LAS unsigned* st) {
    XcdBarrier b; b.bar = bar; b.x = xb_xcc_id(); b.st = st;
    if (threadIdx.x == 0) (void)xb_add(&bar[XB_XCNT(b.x)], 1u);
    return b;
}
__device__ __forceinline__ void xcd_barrier_complete(unsigned* bar, unsigned x, unsigned& nloc, unsigned& nx) {
    const unsigned G = gridDim.x * gridDim.y * gridDim.z;
    unsigned sum, cnt, mine, sp = 0u;
    for (;;) {
        sum = 0u; cnt = 0u; mine = 0u;
#pragma unroll
        for (unsigned j = 0; j < 16; ++j) { const unsigned c = xb_ld(&bar[XB_XCNT(j)]); sum += c; cnt += (c > 0u) ? 1u : 0u; mine = (j == x) ? c : mine; }
        if (sum == G) break;
        __builtin_amdgcn_s_sleep(1);
        if ((++sp & 255u) == 0u) { if (xb_ld(&bar[XB_TMO])) break; if (sp > XB_SPIN_CAP) { atomicAdd(&bar[XB_TMO], 1u); break; } }
    }
    nloc = mine > 0u ? mine : 1u; nx = cnt > 0u ? cnt : 1u;
}
__device__ __forceinline__ void xcd_barrier(const XcdBarrier& b) {
    asm volatile("s_waitcnt vmcnt(0)" ::: "memory");
    __syncthreads();
    if (threadIdx.x == 0) {
        unsigned* bar = b.bar;
        __builtin_amdgcn_s_waitcnt(0);
        unsigned nloc = b.st[0], nx = b.st[1];
        if (nloc == 0u) { xcd_barrier_complete(bar, b.x, nloc, nx); b.st[0] = nloc; b.st[1] = nx; }
        const unsigned old = xb_add(&bar[XB_XSUB(b.x)], 1u);
        const unsigned gen = old / nloc;
        if (old + 1u == (gen + 1u) * nloc) {
            __builtin_amdgcn_fence(__ATOMIC_RELEASE, "agent");
            asm volatile("s_waitcnt vmcnt(0)" ::: "memory");
            const unsigned og = xb_add(&bar[XB_TOP], 1u);
            const unsigned tg = og / nx;
            if (og + 1u == (tg + 1u) * nx) xb_add(&bar[XB_TOPGEN], 1u);
            else XB_SPIN(xb_ld(&bar[XB_TOPGEN]) == tg, bar);
            __builtin_amdgcn_fence(__ATOMIC_ACQUIRE, "agent");
            xb_add(&bar[XB_XGEN(b.x)], 1u);
            asm volatile("s_waitcnt vmcnt(0)" ::: "memory");
        } else {
            XB_SPIN(xb_ld(&bar[XB_XGEN(b.x)]) == gen, bar);
            __builtin_amdgcn_fence(__ATOMIC_ACQUIRE, "agent");
            asm volatile("s_waitcnt vmcnt(0)" ::: "memory");
        }
    }
    __syncthreads();
}

struct Args { const void* in[25]; float* out; unsigned char* ws; int ph_lo, ph_hi; };
enum { I_XP = 0, I_XS, I_CACHE, I_SWIN, I_SGDN, I_SGCONV, I_SFCONV, I_PTAB, I_PP, I_PS, I_WIN, I_PE, I_PHI, I_GCW, I_ALOG, I_DTB, I_GNW, I_WOUT, I_LNG, I_LNB, I_WUP, I_FCW, I_WDN, I_WPJ, I_WGT };

namespace pg8 {
struct EpiIn {
    static constexpr bool PERM = true, AFTER_DRAIN = false;
    bf16_t* H; float* HS; float* kvp; float* kvs;
    __device__ __forceinline__ void operator()(const f32x4 (&acc)[2][2][4][2], const Unit& u, int wr, int wc, int fr, int fq) const {
        const int row0 = u.pm * BM + wr * 64 + fr, col0 = u.pn * BM + wc * 32 + 8 * fq;
        const bool iskv = (u.pn == 2 || u.pn == 3), issm = (u.pn == 13);
#pragma unroll
        for (int ai = 0; ai < 2; ++ai)
#pragma unroll
            for (int m = 0; m < 4; ++m) { const int r = row0 + ai * HALF + m * 16;
#pragma unroll
                for (int bj = 0; bj < 2; ++bj) { const int c = col0 + bj * HALF; const f32x4 v0 = acc[ai][bj][m][0], v1 = acc[ai][bj][m][1];
                    u32x4 w; w.x = cvt_pk_bf16(v0[0], v0[1]); w.y = cvt_pk_bf16(v0[2], v0[3]); w.z = cvt_pk_bf16(v1[0], v1[1]); w.w = cvt_pk_bf16(v1[2], v1[3]);
                    *(u32x4*)(H + (size_t)r * HW + c) = w;
                    if (iskv) { float* dst = nullptr; if (r < MPR) dst = kvp + (size_t)r * 512 + (c - HKV); else if (r < MTOT) dst = kvs + (size_t)(r - MPR) * 512 + (c - HKV);
                        if (dst) { *(f32x4*)dst = v0; *(f32x4*)(dst + 4) = v1; } }
                    if (issm && (c - HSM) < 64) { float* dst = HS + (size_t)r * 64 + (c - HSM); *(f32x4*)dst = v0; *(f32x4*)(dst + 4) = v1; } } }
    }
};
struct EpiRes {
    static constexpr bool PERM = false, AFTER_DRAIN = false;
    const float* XF; float* T1;
    __device__ __forceinline__ void operator()(const f32x4 (&acc)[2][2][4][2], const Unit& u, int wr, int wc, int fr, int fq) const {
        const int row0 = u.pm * BM + wr * 64 + fr, col0 = u.pn * BM + wc * 32 + 4 * fq;
#pragma unroll
        for (int ai = 0; ai < 2; ++ai)
#pragma unroll
            for (int m = 0; m < 4; ++m) { const size_t off = (size_t)(row0 + ai * HALF + m * 16) * DM + col0;
#pragma unroll
                for (int bj = 0; bj < 2; ++bj)
#pragma unroll
                    for (int n = 0; n < 2; ++n) { const size_t o = off + bj * HALF + n * 16; const f32x4 xv = *(const f32x4*)(XF + o); *(f32x4*)(T1 + o) = xv * DN_ALPHA + acc[ai][bj][m][n]; } }
    }
};
struct EpiGate {
    static constexpr bool PERM = false, AFTER_DRAIN = false;
    const float* XF; const float* PP; float* T1;
    __device__ __forceinline__ void operator()(const f32x4 (&acc)[2][2][4][2], const Unit& u, int wr, int wc, int fr, int fq) const {
        const int row0 = u.pm * BM + wr * 64 + fr, col0 = u.pn * BM + wc * 32 + 4 * fq;
#pragma unroll
        for (int ai = 0; ai < 2; ++ai)
#pragma unroll
            for (int m = 0; m < 4; ++m) { const size_t off = (size_t)(row0 + ai * HALF + m * 16) * DM + col0;
#pragma unroll
                for (int bj = 0; bj < 2; ++bj)
#pragma unroll
                    for (int n = 0; n < 2; ++n) { const size_t o = off + bj * HALF + n * 16; const f32x4 xv = *(const f32x4*)(XF + o), pv = *(const f32x4*)(PP + o); const f32x4 a = acc[ai][bj][m][n]; f32x4 s;
#pragma unroll
                        for (int j = 0; j < 4; ++j) s[j] = 1.0f / (1.0f + __expf(-a[j]));
                        *(f32x4*)(T1 + o) = xv * DN_ALPHA + s * pv; } }
    }
};
struct EpiF32 {
    static constexpr bool PERM = false, AFTER_DRAIN = false;
    float* C; int ldc;
    __device__ __forceinline__ void operator()(const f32x4 (&acc)[2][2][4][2], const Unit& u, int wr, int wc, int fr, int fq) const {
        const int row0 = u.pm * BM + wr * 64 + fr, col0 = u.pn * BM + wc * 32 + 4 * fq;
#pragma unroll
        for (int ai = 0; ai < 2; ++ai)
#pragma unroll
            for (int m = 0; m < 4; ++m) { float* rowp = C + (size_t)(row0 + ai * HALF + m * 16) * ldc + col0;
#pragma unroll
                for (int bj = 0; bj < 2; ++bj)
#pragma unroll
                    for (int n = 0; n < 2; ++n) *(f32x4*)(rowp + bj * HALF + n * 16) = acc[ai][bj][m][n]; }
    }
};
}

struct Ctx { int tid, lane, wave, bid, G; LAS unsigned char* lds; unsigned* ctl; const LAS unsigned* la; };
__device__ __forceinline__ const void* ld_ptr(const LAS unsigned* p) { const unsigned lo = (unsigned)__builtin_amdgcn_readfirstlane((int)p[0]), hi = (unsigned)__builtin_amdgcn_readfirstlane((int)p[1]); return (const void*)(uintptr_t)(((unsigned long long)hi << 32) | lo); }
__device__ __forceinline__ int hw_lane() { return (int)__builtin_amdgcn_mbcnt_hi(~0u, __builtin_amdgcn_mbcnt_lo(~0u, 0u)); }
__device__ __forceinline__ Ctx relaunder(const Ctx& c0) { Ctx c = c0; int w = c0.wave; asm volatile("" : "+s"(w) :: "memory"); int ln = hw_lane(); asm volatile("" : "+v"(ln) :: "memory"); c.wave = w; c.lane = ln; c.tid = w * 64 + ln; int b = c0.bid; asm volatile("" : "+s"(b) :: "memory"); c.bid = b; return c; }
#define AIN(i) ld_ptr(c.la + 2 * (i))
#define AOUT ((float*)ld_ptr(c.la + 50))
#define AWS ((unsigned char*)ld_ptr(c.la + 52))

__device__ __forceinline__ int in_colmap(int n) {
    if (n < HGQKV) return n;
    if (n < HGZ) return 1304 + (n - HGQKV);
    if (n < HSM) return 2856 + (n - HGZ);
    if (n < HSM + 24) return 1280 + (n - HSM);
    if (n < HSM + 32) return 2840 + (n - HSM - 24);
    if (n < HSM + 40) return 2848 + (n - HSM - 32);
    return -1;
}
__device__ __forceinline__ void p0_prologue(const Ctx& c0) {
    const Ctx c = relaunder(c0);
    LAS float* tile = (LAS float*)c.lds;
    constexpr int T_IN = (HW / 64) * (DM / 64), T_OUT = 16 * 16, T_UP = (UPW / 64) * 16, T_DN = 16 * (DFF / 64), T_GT = 256, T_PJ = 16 * (PLED / 64);
    constexpr int T_L = T_IN + T_OUT + T_UP + T_DN + T_GT + T_PJ;
    for (int it = c.bid; it < 2 * T_L; it += c.G) {
        const int l = it / T_L; int r = it % T_L;
        const float* W; bf16* WT; int K, Ns, mode = 0;
        if (r < T_IN) { W = (const float*)AIN(I_WIN) + (size_t)l * DM * INW; K = DM; Ns = INW; WT = (bf16*)(AWS + WS_WIN) + (size_t)l * HW * DM; mode = 1; }
        else if ((r -= T_IN) < T_OUT) { W = (const float*)AIN(I_WOUT) + (size_t)l * DM * DM; K = DM; Ns = DM; WT = (bf16*)(AWS + WS_WOUT) + (size_t)l * DM * DM; }
        else if ((r -= T_OUT) < T_UP) { W = (const float*)AIN(I_WUP) + (size_t)l * DM * UPW; K = DM; Ns = UPW; WT = (bf16*)(AWS + WS_WUP) + (size_t)l * UPW * DM; }
        else if ((r -= T_UP) < T_DN) { W = (const float*)AIN(I_WDN) + (size_t)l * DFF * DM; K = DFF; Ns = DM; WT = (bf16*)(AWS + WS_WDN) + (size_t)l * DM * DFF; }
        else if ((r -= T_DN) < T_GT) { W = (const float*)AIN(I_WGT) + (size_t)l * DM * DM; K = DM; Ns = DM; WT = (bf16*)(AWS + WS_WGT) + (size_t)l * DM * DM; }
        else { r -= T_GT; W = (const float*)AIN(I_WPJ) + (size_t)l * PLED * DM; K = PLED; Ns = DM; WT = (bf16*)(AWS + WS_WPJ) + (size_t)l * DM * PLED; }
        const int nk = K / 64, tn = r / nk, tk = r % nk, n0 = tn * 64, k0 = tk * 64;
        { const int nn = c.tid & 63; const int nd = n0 + nn; const int sc = mode ? in_colmap(nd) : nd;
#pragma unroll
          for (int q = 0; q < 8; ++q) { const int kk = q * 8 + (c.tid >> 6); tile[kk * 65 + nn] = (sc >= 0) ? W[(size_t)(k0 + kk) * Ns + sc] : 0.f; } }
        __syncthreads();
        { const int n = c.tid >> 3, kc = (c.tid & 7) * 8; const LAS float* s = tile + kc * 65 + n;
          u32x4 o; o.x = pk2(s[0], s[65]); o.y = pk2(s[2 * 65], s[3 * 65]); o.z = pk2(s[4 * 65], s[5 * 65]); o.w = pk2(s[6 * 65], s[7 * 65]);
          *(u32x4*)(WT + (size_t)(n0 + n) * K + k0 + kc) = o; }
        __syncthreads();
    }
    const size_t gt = (size_t)c.bid * 512 + c.tid, GT = (size_t)c.G * 512;
    { float* XF = (float*)(AWS + WS_XF); bf16* XB = (bf16*)(AWS + WS_XB); const float* xp = (const float*)AIN(I_XP); const float* xs = (const float*)AIN(I_XS);
      for (size_t i = gt; i < (size_t)MPAD * DM / 4; i += GT) { const size_t e = i * 4; const size_t row = e / DM;
          f32x4 v = (f32x4){0.f, 0.f, 0.f, 0.f};
          if (row < (size_t)MPR) v = *(const f32x4*)(xp + e); else if (row < (size_t)MTOT) v = *(const f32x4*)(xs + (e - (size_t)MPR * DM));
          *(f32x4*)(XF + e) = v; u32x2 w; w.x = pk2(v[0], v[1]); w.y = pk2(v[2], v[3]); *(u32x2*)(XB + e) = w; } }
    for (int l = 0; l < 2; ++l) { bf16* PB = (bf16*)(AWS + WS_PB) + (size_t)l * MPAD * PLED; const float* pp = (const float*)AIN(I_PP) + (size_t)l * MPR * PLED; const float* ps = (const float*)AIN(I_PS) + (size_t)l * DB * PLED;
      for (size_t i = gt; i < (size_t)MPAD * PLED / 4; i += GT) { const size_t e = i * 4; const size_t row = e / PLED;
          f32x4 v = (f32x4){0.f, 0.f, 0.f, 0.f};
          if (row < (size_t)MPR) v = *(const f32x4*)(pp + e); else if (row < (size_t)MTOT) v = *(const f32x4*)(ps + (e - (size_t)MPR * PLED));
          u32x2 w; w.x = pk2(v[0], v[1]); w.y = pk2(v[2], v[3]); *(u32x2*)(PB + e) = w; } }
}

__device__ __forceinline__ void p3_prep(const Ctx& c0, int l) {
    const Ctx c = relaunder(c0);
    const int gw = c.bid * 8 + c.wave, NGW = c.G * 8, lane = c.lane;
    const bf16* H = (const bf16*)(AWS + WS_H); const float* HS = (const float*)(AWS + WS_HS);
    const float* pe = (const float*)AIN(I_PE) + (size_t)l * 2 * 32 * 64; const float* phi = (const float*)AIN(I_PHI) + (size_t)l * 2 * 64 * 64;
    const int* ptab = (const int*)AIN(I_PTAB);
    const float* cache = (const float*)AIN(I_CACHE) + (size_t)l * NPOOL * 128 * 512;
    { float* KC = (float*)(AWS + WS_KCP); float* VC = (float*)(AWS + WS_VCP);
      for (int it = gw; it < 4 * 128 * 4; it += NGW) { const int type = it & 1, n = (it >> 1) & 1, cb = (it >> 2) & 127, b = it >> 9;
          float s = 0.f;
          const bf16* src = H + (size_t)(b * SEQ + cb * 32) * HW + HKV + type * 128 + n * 64 + lane;
#pragma unroll 8
          for (int i = 0; i < 32; ++i) s += bf2f(src[(size_t)i * HW]) + pe[(type * 32 + i) * 64 + lane];
          const float mean = s * (1.f / 32.f); float o = 0.f;
#pragma unroll 8
          for (int d = 0; d < 64; ++d) o += __shfl(mean, d) * phi[(type * 64 + d) * 64 + lane];
          (type ? VC : KC)[((size_t)(b * 128 + cb) * 2 + n) * 64 + lane] = o; } }
    { float* KC = (float*)(AWS + WS_KCS); float* VC = (float*)(AWS + WS_VCS);
      for (int it = gw; it < DB * 64 * 4; it += NGW) { const int type = it & 1, n = (it >> 1) & 1, cb = (it >> 2) & 63, b = it >> 8;
          const int page = ptab[b * NPG + (cb >> 2)]; const float* src = cache + ((size_t)page * 128 + (cb & 3) * 32) * 512 + type * 128 + n * 64 + lane;
          float s = 0.f;
#pragma unroll 8
          for (int i = 0; i < 32; ++i) s += src[(size_t)i * 512] + pe[(type * 32 + i) * 64 + lane];
          const float mean = s * (1.f / 32.f); float o = 0.f;
#pragma unroll 8
          for (int d = 0; d < 64; ++d) o += __shfl(mean, d) * phi[(type * 64 + d) * 64 + lane];
          (type ? VC : KC)[((size_t)(b * 64 + cb) * 2 + n) * 64 + lane] = o; } }
    { float* GQ = (float*)(AWS + WS_GQ); float* GK = (float*)(AWS + WS_GK); float* GV = (float*)(AWS + WS_GV); float* GG = (float*)(AWS + WS_GG); float* GB = (float*)(AWS + WS_GB);
      const float* cw = (const float*)AIN(I_GCW) + (size_t)l * 4 * GQKV; const float* sgc = (const float*)AIN(I_SGCONV) + (size_t)l * DB * 3 * GQKV;
      const float* alog = (const float*)AIN(I_ALOG) + l * 8; const float* dtb = (const float*)AIN(I_DTB) + l * 8;
      for (int it = gw; it < MTOT * 8; it += NGW) { const int hh = it & 7, m = it >> 3;
          float y[3];
#pragma unroll
          for (int j = 0; j < 3; ++j) { const int cc = j * 512 + hh * 64 + lane; float xs[4];
              xs[3] = bf2f(H[(size_t)m * HW + HGQKV + cc]);
              if (m < MPR) { const int t = m & (SEQ - 1);
#pragma unroll
                  for (int i = 0; i < 3; ++i) xs[i] = (t + i - 3 >= 0) ? bf2f(H[(size_t)(m + i - 3) * HW + HGQKV + cc]) : 0.f; }
              else { const int b = m - MPR;
#pragma unroll
                  for (int i = 0; i < 3; ++i) xs[i] = sgc[((size_t)b * 3 + i) * GQKV + cc]; }
              float acc = 0.f;
#pragma unroll
              for (int i = 0; i < 4; ++i) acc += cw[i * GQKV + cc] * xs[i];
              y[j] = siluf_(acc); }
          const float sq = wave_sum(y[0] * y[0]), sk = wave_sum(y[1] * y[1]);
          const size_t o = (size_t)m * 512 + hh * 64 + lane;
          GQ[o] = y[0] * rsqrtf(sq + RMS_EPS) * 0.125f; GK[o] = y[1] * rsqrtf(sk + RMS_EPS); GV[o] = y[2];
          if (lane == 0) { const float ai = HS[(size_t)m * 64 + 24 + hh], bi = HS[(size_t)m * 64 + 32 + hh];
              GG[(size_t)m * 8 + hh] = -__expf(alog[hh]) * softplusf_(ai + dtb[hh]); GB[(size_t)m * 8 + hh] = sigmoidf_(bi); } } }
    const size_t gt = (size_t)c.bid * 512 + c.tid, GT = (size_t)c.G * 512;
    { float* o = AOUT + O_GCP + (size_t)l * 4 * 3 * GQKV;
      for (size_t i = gt; i < (size_t)4 * 3 * GQKV; i += GT) { const int cc = (int)(i % GQKV), r = (int)(i / GQKV) % 3, b = (int)(i / (3 * GQKV)); o[i] = bf2f(H[(size_t)(b * SEQ + SEQ - 3 + r) * HW + HGQKV + cc]); } }
    { float* o = AOUT + O_GCS + (size_t)l * DB * 3 * GQKV; const float* sgc = (const float*)AIN(I_SGCONV) + (size_t)l * DB * 3 * GQKV;
      for (size_t i = gt; i < (size_t)DB * 3 * GQKV; i += GT) { const int cc = (int)(i % GQKV), r = (int)(i / GQKV) % 3, b = (int)(i / (3 * GQKV)); o[i] = (r < 2) ? sgc[i + GQKV] : bf2f(H[(size_t)(MPR + b) * HW + HGQKV + cc]); } }
    { float* o = AOUT + O_WINP + (size_t)l * 4 * 512 * 256;
      for (size_t i = gt; i < (size_t)4 * 512 * 256; i += GT) { const int cc = (int)(i & 255), r = (int)(i >> 8) & 511, b = (int)(i >> 17); o[i] = bf2f(H[(size_t)(b * SEQ + SEQ - 512 + r) * HW + HWIN + cc]); } }
    { float* o = AOUT + O_WINS + (size_t)l * DB * 512 * 256; const float* sw = (const float*)AIN(I_SWIN) + (size_t)l * DB * 512 * 256;
      for (size_t i = gt; i < (size_t)DB * 512 * 256; i += GT) { const int cc = (int)(i & 255), r = (int)(i >> 8) & 511, b = (int)(i >> 17); o[i] = (r < 511) ? sw[i + 256] : bf2f(H[(size_t)(MPR + b) * HW + HWIN + cc]); } }
}

__device__ __forceinline__ float ldT(const bf16* p) { return bf2f(*p); }
__device__ __forceinline__ float ldT(const float* p) { return *p; }
__device__ __forceinline__ void qk4(const bf16* kp, const LAS float* qbuf, float (&dot)[4]) {
    dot[0] = dot[1] = dot[2] = dot[3] = 0.f;
#pragma unroll 2
    for (int cch = 0; cch < 8; ++cch) { const u32x4 w = *(const u32x4*)(kp + cch * 8);
#pragma unroll
        for (int j = 0; j < 4; ++j) { const unsigned ww = w[j]; const float k0 = __uint_as_float(ww << 16), k1 = __uint_as_float(ww & 0xffff0000u);
            const f32x4 q0 = *(const LAS f32x4*)(qbuf + (cch * 8 + j * 2) * 4), q1 = *(const LAS f32x4*)(qbuf + (cch * 8 + j * 2 + 1) * 4);
#pragma unroll
            for (int g = 0; g < 4; ++g) dot[g] += k0 * q0[g] + k1 * q1[g]; } }
}
__device__ __forceinline__ void qk4(const float* kp, const LAS float* qbuf, float (&dot)[4]) {
    dot[0] = dot[1] = dot[2] = dot[3] = 0.f;
#pragma unroll 4
    for (int cch = 0; cch < 16; ++cch) { const f32x4 w = *(const f32x4*)(kp + cch * 4);
#pragma unroll
        for (int j = 0; j < 4; ++j) { const f32x4 q0 = *(const LAS f32x4*)(qbuf + (cch * 4 + j) * 4);
#pragma unroll
            for (int g = 0; g < 4; ++g) dot[g] += w[j] * q0[g]; } }
}
template <typename T>
__device__ __forceinline__ void pv4(const T* vp_lane, const LAS float* pbuf, int lane, float (&o)[4]) {
    const unsigned long long pv = (unsigned long long)(uintptr_t)vp_lane; const int lo = (int)(unsigned)pv, hi = (int)(unsigned)(pv >> 32);
#pragma unroll 8
    for (int j = 0; j < 64; ++j) {
        const unsigned l2 = (unsigned)__builtin_amdgcn_readlane(lo, j), h2 = (unsigned)__builtin_amdgcn_readlane(hi, j);
        const T* vp = (const T*)(uintptr_t)(((unsigned long long)h2 << 32) | l2);
        const float v = ldT(vp + lane); const f32x4 p = *(const LAS f32x4*)(pbuf + j * 4);
#pragma unroll
        for (int g = 0; g < 4; ++g) o[g] += p[g] * v;
    }
}
struct OSm { float m[4], l[4], o[4]; };
__device__ __forceinline__ void os_init(OSm& s) {
#pragma unroll
    for (int g = 0; g < 4; ++g) { s.m[g] = NEGV; s.l[g] = 0.f; s.o[g] = 0.f; } }
template <typename T>
__device__ __forceinline__ void attend_block(OSm& st, const T* kp, const T* vp, bool valid, float dist, const LAS float* qbuf, LAS float* pbuf, int lane, const float (&slope)[4]) {
    float dot[4]; qk4(kp, qbuf, dot);
    f32x4 p;
#pragma unroll
    for (int g = 0; g < 4; ++g) { const float s = valid ? (dot[g] * 0.125f - slope[g] * dist) : NEGV;
        const float mn = fmaxf(st.m[g], wave_max(s)); const float pg = valid ? __expf(s - mn) : 0.f; const float corr = __expf(st.m[g] - mn);
        st.l[g] = st.l[g] * corr + wave_sum(pg); st.o[g] *= corr; st.m[g] = mn; p[g] = pg; }
    *(LAS f32x4*)(pbuf + lane * 4) = p; wave_lds_sync();
    pv4(vp, pbuf, lane, st.o);
    wave_lds_sync();
}
__device__ __forceinline__ unsigned long long select_blocks(const LAS float* impbuf, int lane, int cur) {
    const bool excl = lane > cur; const bool forced = (lane == 0) || (lane == cur) || (lane + 1 == cur);
    const float imp = impbuf[2 * lane] + impbuf[2 * lane + 1];
    const float sc = excl ? -__builtin_inff() : (forced ? __builtin_inff() : imp);
    int cnt = 0; const int sci = __float_as_int(sc);
#pragma unroll 8
    for (int i = 0; i < 64; ++i) { const float si = __int_as_float(__builtin_amdgcn_readlane(sci, i)); cnt += ((si > sc) || (si == sc && i < lane)) ? 1 : 0; }
    return __ballot(!excl && cnt < 16);
}

__device__ __forceinline__ void nsa_item(const Ctx& c, int l, bool sample, int row  , int b, int t, int n, LAS float* wl, int lane) {
    LAS float* qbuf = wl; LAS float* pbuf = wl + 256; LAS float* impbuf = wl + 512;
    const bf16* H = (const bf16*)(AWS + WS_H); const float* HS = (const float*)(AWS + WS_HS);
    float slope[4];
#pragma unroll
    for (int g = 0; g < 4; ++g) slope[g] = exp2f(-(float)(n * 4 + g + 1));
    { f32x4 qv;
#pragma unroll
      for (int g = 0; g < 4; ++g) qv[g] = bf2f(H[(size_t)row * HW + HQ + (n * 4 + g) * 64 + lane]);
      wave_lds_sync(); *(LAS f32x4*)(qbuf + lane * 4) = qv; wave_lds_sync(); }
    const float tp = (float)t;
    const int ncb = sample ? 1 : 2;
    const float* KC = sample ? (const float*)(AWS + WS_KCS) + (size_t)b * 64 * 128 : (const float*)(AWS + WS_KCP) + (size_t)b * 128 * 128;
    const float* VC = sample ? (const float*)(AWS + WS_VCS) + (size_t)b * 64 * 128 : (const float*)(AWS + WS_VCP) + (size_t)b * 128 * 128;
    float sc[2][4]; bool cv[2];
#pragma unroll
    for (int blk = 0; blk < 2; ++blk) { const int cidx = blk * 64 + lane; cv[blk] = (blk < ncb) && (32 * cidx + 31 <= t);
        float dot[4] = {0.f, 0.f, 0.f, 0.f};
        if (blk < ncb) qk4(KC + ((size_t)cidx * 2 + n) * 64, qbuf, dot);
        const float dist = tp - (32.f * (float)cidx + 15.5f);
#pragma unroll
        for (int g = 0; g < 4; ++g) sc[blk][g] = cv[blk] ? (dot[g] * 0.125f - slope[g] * dist) : NEGV; }
    float ocmp[4] = {0.f, 0.f, 0.f, 0.f};
    { f32x4 p0, p1; float i0 = 0.f, i1 = 0.f;
#pragma unroll
      for (int g = 0; g < 4; ++g) { const float mx = wave_max(fmaxf(sc[0][g], sc[1][g]));
          const float e0 = cv[0] ? __expf(sc[0][g] - mx) : 0.f, e1 = cv[1] ? __expf(sc[1][g] - mx) : 0.f; const float sum = wave_sum(e0 + e1); const float inv = sum > 0.f ? 1.0f / sum : 0.f;
          p0[g] = e0 * inv; p1[g] = e1 * inv; i0 += p0[g]; i1 += p1[g]; }
      impbuf[lane] = i0; impbuf[64 + lane] = i1;
      *(LAS f32x4*)(pbuf + lane * 4) = p0; wave_lds_sync();
      pv4(VC + ((size_t)lane * 2 + n) * 64, pbuf, lane, ocmp); wave_lds_sync();
      if (ncb > 1) { *(LAS f32x4*)(pbuf + lane * 4) = p1; wave_lds_sync(); pv4(VC + ((size_t)(64 + lane) * 2 + n) * 64, pbuf, lane, ocmp); wave_lds_sync(); } }
    const int cur = t >> 6;
    unsigned long long mask = select_blocks(impbuf, lane, cur);
    OSm ss; os_init(ss);
    if (!sample) {
        while (mask) { const int j = __builtin_ctzll(mask); mask &= mask - 1;
            const int pos = j * 64 + lane; const bf16* kp = H + (size_t)(b * SEQ + pos) * HW + HKV + 256 + n * 64;
            attend_block<bf16>(ss, kp, kp + 128, pos <= t, (float)(t - pos), qbuf, pbuf, lane, slope); }
    } else {
        const int* ptab = (const int*)AIN(I_PTAB); const float* cache = (const float*)AIN(I_CACHE) + (size_t)l * NPOOL * 128 * 512;
        while (mask) { const int j = __builtin_ctzll(mask); mask &= mask - 1;
            if (j < 32) { const int page = ptab[b * NPG + (j >> 1)]; const float* kp = cache + ((size_t)page * 128 + (j & 1) * 64 + lane) * 512 + 256 + n * 64;
                attend_block<float>(ss, kp, kp + 128, true, (float)(t - (j * 64 + lane)), qbuf, pbuf, lane, slope); }
            else { const bf16* kp = H + (size_t)row * HW + HKV + 256 + n * 64; attend_block<bf16>(ss, kp, kp + 128, lane == 0, 0.f, qbuf, pbuf, lane, slope); } }
    }
    OSm sw; os_init(sw);
    if (!sample) {
        for (int blk = 0; blk < 8; ++blk) { const int p0 = t - 511 + blk * 64; if (p0 + 63 < 0) continue;
            const int pos = p0 + lane; const int pc = pos < 0 ? 0 : pos; const bf16* kp = H + (size_t)(b * SEQ + pc) * HW + HWIN + n * 64;
            attend_block<bf16>(sw, kp, kp + 128, pos >= 0, (float)(t - pos), qbuf, pbuf, lane, slope); }
    } else {
        const float* wst = (const float*)AIN(I_SWIN) + ((size_t)l * DB + b) * 512 * 256;
        for (int blk = 0; blk < 8; ++blk) { const int i = 1 + blk * 64 + lane; const int ic = i > 511 ? 511 : i; const float* kp = wst + (size_t)ic * 256 + n * 64;
            attend_block<float>(sw, kp, kp + 128, i <= 511, (float)(512 - i), qbuf, pbuf, lane, slope); }
        const bf16* kp = H + (size_t)row * HW + HWIN + n * 64; attend_block<bf16>(sw, kp, kp + 128, lane == 0, 0.f, qbuf, pbuf, lane, slope);
    }
    bf16* MIX = (bf16*)(AWS + WS_MIX);
#pragma unroll
    for (int g = 0; g < 4; ++g) { const int hq = n * 4 + g; const float* gp = HS + (size_t)row * 64 + hq * 3;
        const float g0 = sigmoidf_(gp[0]), g1 = sigmoidf_(gp[1]), g2 = sigmoidf_(gp[2]);
        const float osl = ss.l[g] > 0.f ? ss.o[g] / ss.l[g] : 0.f, owi = sw.l[g] > 0.f ? sw.o[g] / sw.l[g] : 0.f;
        MIX[(size_t)row * DM + hq * 64 + lane] = (bf16)f2bf(g0 * ocmp[g] + g1 * osl + g2 * owi); }
}

__device__ __forceinline__ void gdn_steps(const Ctx& c, int l, int row0, int nsteps, int hh, float (&S)[64], LAS float* wl, int lane) {
    const float* GQ = (const float*)(AWS + WS_GQ); const float* GK = (const float*)(AWS + WS_GK); const float* GV = (const float*)(AWS + WS_GV);
    const float* GG = (const float*)(AWS + WS_GG); const float* GB = (const float*)(AWS + WS_GB);
    const bf16* H = (const bf16*)(AWS + WS_H); bf16* MIX = (bf16*)(AWS + WS_MIX);
    const float nw = ((const float*)AIN(I_GNW))[l * 64 + lane];
    LAS float* kb = wl; LAS float* qb = wl + 64;
    size_t o = (size_t)row0 * 512 + hh * 64 + lane;
    float nk = GK[o], nq = GQ[o], nv = GV[o], ng = GG[(size_t)row0 * 8 + hh], nb = GB[(size_t)row0 * 8 + hh], nz = bf2f(H[(size_t)row0 * HW + HGZ + hh * 64 + lane]);
    for (int s = 0; s < nsteps; ++s) {
        const int m = row0 + s;
        const float kv = nk, qv = nq, vv = nv, gv = ng, bv = nb, zv = nz;
        if (s + 1 < nsteps) { const size_t o2 = (size_t)(m + 1) * 512 + hh * 64 + lane;
            nk = GK[o2]; nq = GQ[o2]; nv = GV[o2]; ng = GG[(size_t)(m + 1) * 8 + hh]; nb = GB[(size_t)(m + 1) * 8 + hh]; nz = bf2f(H[(size_t)(m + 1) * HW + HGZ + hh * 64 + lane]); }
        wave_lds_sync(); kb[lane] = kv; qb[lane] = qv; wave_lds_sync();
        const float al = __expf(gv);
        float u0 = 0.f, u1 = 0.f, u2 = 0.f, u3 = 0.f;
#pragma unroll
        for (int d = 0; d < 64; d += 4) { const f32x4 k4 = *(const LAS f32x4*)(kb + d); u0 += k4[0] * S[d]; u1 += k4[1] * S[d + 1]; u2 += k4[2] * S[d + 2]; u3 += k4[3] * S[d + 3]; }
        const float u = (u0 + u1) + (u2 + u3);
        const float w = bv * (vv - al * u);
        float o0 = 0.f, o1 = 0.f, o2 = 0.f, o3 = 0.f;
#pragma unroll
        for (int d = 0; d < 64; d += 4) { const f32x4 k4 = *(const LAS f32x4*)(kb + d); const f32x4 q4 = *(const LAS f32x4*)(qb + d);
            S[d] = al * S[d] + k4[0] * w; S[d + 1] = al * S[d + 1] + k4[1] * w; S[d + 2] = al * S[d + 2] + k4[2] * w; S[d + 3] = al * S[d + 3] + k4[3] * w;
            o0 += q4[0] * S[d]; o1 += q4[1] * S[d + 1]; o2 += q4[2] * S[d + 2]; o3 += q4[3] * S[d + 3]; }
        const float ov = (o0 + o1) + (o2 + o3);
        const float ms = wave_sum(ov * ov) * (1.f / 64.f);
        MIX[(size_t)m * DM + 512 + hh * 64 + lane] = (bf16)f2bf(ov * rsqrtf(ms + RMS_EPS) * nw * siluf_(zv));
    }
}
__device__ __forceinline__ void gdn_item_prompt(const Ctx& c, int l, int b, int hh, LAS float* wl, int lane) {
    float S[64];
#pragma unroll
    for (int d = 0; d < 64; ++d) S[d] = 0.f;
    gdn_steps(c, l, b * SEQ, SEQ, hh, S, wl, lane);
    float* o = AOUT + O_GSP + (((size_t)l * 4 + b) * 8 + hh) * 4096;
#pragma unroll
    for (int d = 0; d < 64; ++d) o[d * 64 + lane] = S[d];
}
__device__ __forceinline__ void gdn_item_sample(const Ctx& c, int l, int b, int hh, LAS float* wl, int lane) {
    const float* s0 = (const float*)AIN(I_SGDN) + (((size_t)l * DB + b) * 8 + hh) * 4096;
    float S[64];
#pragma unroll
    for (int d = 0; d < 64; ++d) S[d] = s0[d * 64 + lane];
    gdn_steps(c, l, MPR + b, 1, hh, S, wl, lane);
    float* o = AOUT + O_GSS + (((size_t)l * DB + b) * 8 + hh) * 4096;
#pragma unroll
    for (int d = 0; d < 64; ++d) o[d * 64 + lane] = S[d];
}
__device__ __forceinline__ void p4_mixers(const Ctx& c0, int l) {
    const Ctx c = relaunder(c0);
    LAS float* wl = (LAS float*)(c.lds + c.wave * 4096);
    const int lane = c.lane;
    if (c.wave == 0 && c.bid < 32) gdn_item_prompt(c, l, c.bid >> 3, c.bid & 7, wl, lane);
    unsigned* head = c.ctl + (l ? CW_Q1 : CW_Q0);
    constexpr int N_GS = DB * 8, N_NS = DB * 2, N_NP = MPR * 2, N_ALL = N_GS + N_NS + N_NP, CH = 4;
    for (;;) {
        unsigned base = 0;
        if (lane == 0) base = __hip_atomic_fetch_add(head, (unsigned)CH, __ATOMIC_RELAXED, __HIP_MEMORY_SCOPE_AGENT);
        base = (unsigned)__builtin_amdgcn_readfirstlane((int)base);
        if (base >= (unsigned)N_ALL) break;
        for (int k = 0; k < CH; ++k) { int it = (int)base + k; if (it >= N_ALL) break;
            if (it < N_GS) { gdn_item_sample(c, l, it >> 3, it & 7, wl, lane); continue; } it -= N_GS;
            if (it < N_NS) { const int b = it >> 1, n = it & 1; nsa_item(c, l, true, MPR + b, b, PASTL, n, wl, lane); continue; } it -= N_NS;
            { const int n = it & 1, b = (it >> 1) & 3, t = SEQ - 1 - (it >> 3); nsa_item(c, l, false, b * SEQ + t, b, t, n, wl, lane); } }
    }
}

__device__ __forceinline__ void p_ln(const Ctx& c0, int l, int which, bool final_out) {
    const Ctx c = relaunder(c0);
    const int gw = c.bid * 8 + c.wave, NGW = c.G * 8, lane = c.lane;
    const float* T1 = (const float*)(AWS + WS_T1); float* XF = (float*)(AWS + WS_XF); bf16* XB = (bf16*)(AWS + WS_XB);
    const float* g = (const float*)AIN(I_LNG) + (size_t)(l * 3 + which) * DM; const float* bb = (const float*)AIN(I_LNB) + (size_t)(l * 3 + which) * DM;
    f32x4 gv[4], bv[4];
#pragma unroll
    for (int j = 0; j < 4; ++j) { gv[j] = *(const f32x4*)(g + lane * 4 + 256 * j); bv[j] = *(const f32x4*)(bb + lane * 4 + 256 * j); }
    for (int m = gw; m < MTOT; m += NGW) {
        const float* xr = T1 + (size_t)m * DM + lane * 4; f32x4 v[4]; float s = 0.f;
#pragma unroll
        for (int j = 0; j < 4; ++j) { v[j] = *(const f32x4*)(xr + 256 * j); s += (v[j][0] + v[j][1]) + (v[j][2] + v[j][3]); }
        const float mean = wave_sum(s) * (1.f / DM); float s2 = 0.f;
#pragma unroll
        for (int j = 0; j < 4; ++j) { v[j] = v[j] - mean; s2 += (v[j][0] * v[j][0] + v[j][1] * v[j][1]) + (v[j][2] * v[j][2] + v[j][3] * v[j][3]); }
        const float rstd = rsqrtf(wave_sum(s2) * (1.f / DM) + LN_EPS);
        float* of = final_out ? (m < MPR ? AOUT + O_YP + (size_t)m * DM : AOUT + O_YS + (size_t)(m - MPR) * DM) : XF + (size_t)m * DM;
#pragma unroll
        for (int j = 0; j < 4; ++j) { const f32x4 y = v[j] * rstd * gv[j] + bv[j]; *(f32x4*)(of + lane * 4 + 256 * j) = y;
            if (!final_out) { u32x2 w; w.x = pk2(y[0], y[1]); w.y = pk2(y[2], y[3]); *(u32x2*)(XB + (size_t)m * DM + lane * 4 + 256 * j) = w; } }
    }
}

__device__ __forceinline__ float gelu_erf(float x) { return 0.5f * x * (1.0f + erff(x * 0.70710678118654752f)); }
__device__ __forceinline__ void p8_act(const Ctx& c0, int l) {
    const Ctx c = relaunder(c0);
    const bf16* UP = (const bf16*)(AWS + WS_UP); bf16* ACT = (bf16*)(AWS + WS_ACT);
    const float* fw = (const float*)AIN(I_FCW) + (size_t)l * 3 * DFF; const float* sfc = (const float*)AIN(I_SFCONV) + (size_t)l * DB * 2 * DFF;
    const size_t gt = (size_t)c.bid * 512 + c.tid, GT = (size_t)c.G * 512;
    constexpr int CPR = DFF / 4;
    for (size_t i = gt; i < (size_t)MTOT * CPR; i += GT) { const int m = (int)(i / CPR), cc = (int)(i % CPR) * 4;
        const u32x2 u0 = *(const u32x2*)(UP + (size_t)m * UPW + cc); const u32x2 um = *(const u32x2*)(UP + (size_t)m * UPW + DFF + cc);
        float x0[4] = {__uint_as_float(u0.x << 16), __uint_as_float(u0.x & 0xffff0000u), __uint_as_float(u0.y << 16), __uint_as_float(u0.y & 0xffff0000u)};
        float mu[4] = {__uint_as_float(um.x << 16), __uint_as_float(um.x & 0xffff0000u), __uint_as_float(um.y << 16), __uint_as_float(um.y & 0xffff0000u)};
        float x1[4] = {0.f, 0.f, 0.f, 0.f}, x2[4] = {0.f, 0.f, 0.f, 0.f};
        if (m < MPR) { const int t = m & (SEQ - 1);
            if (t >= 1) { const u32x2 w = *(const u32x2*)(UP + (size_t)(m - 1) * UPW + cc); x1[0] = __uint_as_float(w.x << 16); x1[1] = __uint_as_float(w.x & 0xffff0000u); x1[2] = __uint_as_float(w.y << 16); x1[3] = __uint_as_float(w.y & 0xffff0000u); }
            if (t >= 2) { const u32x2 w = *(const u32x2*)(UP + (size_t)(m - 2) * UPW + cc); x2[0] = __uint_as_float(w.x << 16); x2[1] = __uint_as_float(w.x & 0xffff0000u); x2[2] = __uint_as_float(w.y << 16); x2[3] = __uint_as_float(w.y & 0xffff0000u); } }
        else { const int b = m - MPR; const f32x4 s0 = *(const f32x4*)(sfc + ((size_t)b * 2 + 0) * DFF + cc), s1 = *(const f32x4*)(sfc + ((size_t)b * 2 + 1) * DFF + cc);
#pragma unroll
            for (int j = 0; j < 4; ++j) { x2[j] = s0[j]; x1[j] = s1[j]; } }
        const f32x4 w0 = *(const f32x4*)(fw + cc), w1 = *(const f32x4*)(fw + DFF + cc), w2 = *(const f32x4*)(fw + 2 * DFF + cc);
        float r[4];
#pragma unroll
        for (int j = 0; j < 4; ++j) r[j] = gelu_erf(w0[j] * x2[j] + w1[j] * x1[j] + w2[j] * x0[j]) * mu[j];
        u32x2 w; w.x = pk2(r[0], r[1]); w.y = pk2(r[2], r[3]); *(u32x2*)(ACT + (size_t)m * DFF + cc) = w; }
    { float* o = AOUT + O_FCP + (size_t)l * 4 * 2 * DFF;
      for (size_t i = gt; i < (size_t)4 * 2 * DFF; i += GT) { const int cc = (int)(i % DFF), r = (int)(i / DFF) & 1, b = (int)(i / (2 * DFF)); o[i] = bf2f(UP[(size_t)(b * SEQ + SEQ - 2 + r) * UPW + cc]); } }
    { float* o = AOUT + O_FCS + (size_t)l * DB * 2 * DFF;
      for (size_t i = gt; i < (size_t)DB * 2 * DFF; i += GT) { const int cc = (int)(i % DFF), r = (int)(i / DFF) & 1, b = (int)(i / (2 * DFF)); o[i] = (r == 0) ? sfc[i + DFF] : bf2f(UP[(size_t)(MPR + b) * UPW + cc]); } }
}

constexpr int NPH = 2 + 2 * 11;
__global__ void __launch_bounds__(512, 2) fwd_kernel(Args a) {
    extern __shared__ __attribute__((aligned(16))) unsigned char lds_raw[];
    Ctx c; c.lds = (LAS unsigned char*)lds_raw; c.tid = threadIdx.x; c.lane = c.tid & 63; c.wave = __builtin_amdgcn_readfirstlane(c.tid >> 6); c.bid = blockIdx.x; c.G = gridDim.x;
    volatile LAS unsigned* MISC = (volatile LAS unsigned*)(c.lds + MISC_OFF);
    for (int u = c.tid; u < (LDS_BYTES - RING_BYTES) / 4; u += 512) ((LAS unsigned*)(c.lds + RING_BYTES))[u] = 0u;
    __syncthreads();
    { const unsigned* ap = (const unsigned*)&a; LAS unsigned* la = (LAS unsigned*)(c.lds + ARGS_OFF); if (c.tid < 56) la[c.tid] = ap[c.tid]; c.la = la; }
    __syncthreads();
    c.ctl = (unsigned*)(AWS + WS_CTL);
    XcdBarrier bar; bar.bar = c.ctl + CW_BAR; bar.x = 0; bar.st = nullptr;
    const int lo = a.ph_lo, hi = a.ph_hi;
    if (hi - lo > 1) bar = xcd_barrier_post(c.ctl + CW_BAR, MISC + 8);
#define IN(k) (lo <= (k) && (k) < hi)
#define SEAM(k) do { if (IN(k) && IN((k) + 1)) xcd_barrier(bar); } while (0)
    LAS unsigned char* ring = c.lds;
    if (IN(0)) { p0_prologue(c); } SEAM(0);
    if (IN(1)) {
        for (int l = 0; l < 2; ++l) {
            pg8::Gemm g{(const pg8::bf16_t*)(AWS + WS_PB) + (size_t)l * MPAD * PLED, (const pg8::bf16_t*)(AWS + WS_WPJ) + (size_t)l * DM * PLED, MPAD, DM, PLED};
            pg8::StaticOrder S; S.init(MPAD, DM, c.G, c.bid); pg8::EpiF32 E{(float*)(AWS + WS_PP) + (size_t)l * MPAD * DM, DM};
            pg8::gemm_phase<pg8::EpiF32, pg8::StaticOrder, false, false>(ring, g, S, E, c.wave); }
    } SEAM(1);
    for (int l = 0; l < 2; ++l) {
        const int p = 2 + l * 11;
        if (IN(p + 0)) {
            pg8::Gemm g{(const pg8::bf16_t*)(AWS + WS_XB), (const pg8::bf16_t*)(AWS + WS_WIN) + (size_t)l * HW * DM, MPAD, HW, DM};
            pg8::StaticOrder S; S.init(MPAD, HW, c.G, c.bid);
            pg8::EpiIn E{(pg8::bf16_t*)(AWS + WS_H), (float*)(AWS + WS_HS), AOUT + O_KVP + (size_t)l * MPR * 512, AOUT + O_KVS + (size_t)l * DB * 512};
            pg8::gemm_phase<pg8::EpiIn, pg8::StaticOrder, false, false>(ring, g, S, E, c.wave);
        } SEAM(p + 0);
        if (IN(p + 1)) { p3_prep(c, l); } SEAM(p + 1);
        if (IN(p + 2)) { p4_mixers(c, l); } SEAM(p + 2);
        if (IN(p + 3)) {
            pg8::Gemm g{(const pg8::bf16_t*)(AWS + WS_MIX), (const pg8::bf16_t*)(AWS + WS_WOUT) + (size_t)l * DM * DM, MPAD, DM, DM};
            pg8::StaticOrder S; S.init(MPAD, DM, c.G, c.bid); pg8::EpiRes E{(const float*)(AWS + WS_XF), (float*)(AWS + WS_T1)};
            pg8::gemm_phase<pg8::EpiRes, pg8::StaticOrder, false, false>(ring, g, S, E, c.wave);
        } SEAM(p + 3);
        if (IN(p + 4)) { p_ln(c, l, 0, false); } SEAM(p + 4);
        if (IN(p + 5)) {
            pg8::Gemm g{(const pg8::bf16_t*)(AWS + WS_XB), (const pg8::bf16_t*)(AWS + WS_WUP) + (size_t)l * UPW * DM, MPAD, UPW, DM};
            pg8::StaticOrder S; S.init(MPAD, UPW, c.G, c.bid); pg8::EpiBf16<0> E{(pg8::bf16_t*)(AWS + WS_UP), UPW, nullptr, 0, 0, 1.f};
            pg8::gemm_phase<pg8::EpiBf16<0>, pg8::StaticOrder, false, false>(ring, g, S, E, c.wave);
        } SEAM(p + 5);
        if (IN(p + 6)) { p8_act(c, l); } SEAM(p + 6);
        if (IN(p + 7)) {
            pg8::Gemm g{(const pg8::bf16_t*)(AWS + WS_ACT), (const pg8::bf16_t*)(AWS + WS_WDN) + (size_t)l * DM * DFF, MPAD, DM, DFF};
            pg8::StaticOrder S; S.init(MPAD, DM, c.G, c.bid); pg8::EpiRes E{(const float*)(AWS + WS_XF), (float*)(AWS + WS_T1)};
            pg8::gemm_phase<pg8::EpiRes, pg8::StaticOrder, false, false>(ring, g, S, E, c.wave);
        } SEAM(p + 7);
        if (IN(p + 8)) { p_ln(c, l, 1, false); } SEAM(p + 8);
        if (IN(p + 9)) {
            pg8::Gemm g{(const pg8::bf16_t*)(AWS + WS_XB), (const pg8::bf16_t*)(AWS + WS_WGT) + (size_t)l * DM * DM, MPAD, DM, DM};
            pg8::StaticOrder S; S.init(MPAD, DM, c.G, c.bid); pg8::EpiGate E{(const float*)(AWS + WS_XF), (const float*)(AWS + WS_PP) + (size_t)l * MPAD * DM, (float*)(AWS + WS_T1)};
            pg8::gemm_phase<pg8::EpiGate, pg8::StaticOrder, false, false>(ring, g, S, E, c.wave);
        } SEAM(p + 9);
        if (IN(p + 10)) { p_ln(c, l, 2, l == 1); } SEAM(p + 10);
    }
#undef IN
#undef SEAM
}

extern "C" void kernel_launch(void* const* d_in, const int* in_sizes, int n_in, void* d_out, int out_size, void* d_ws, size_t ws_size, hipStream_t stream) {
    static int grid = 0;
    if (grid == 0) {
        if (n_in != 25 || (size_t)out_size != O_END || ws_size < WS_END) { fprintf(stderr, "kernel_launch: unexpected shapes (n_in %d out %d ws %zu)\n", n_in, out_size, ws_size); grid = -1; return; }
        int dev = 0, cus = 0;
        if (hipGetDevice(&dev) != hipSuccess || hipDeviceGetAttribute(&cus, hipDeviceAttributeMultiprocessorCount, dev) != hipSuccess) { grid = -1; return; }
        if (hipFuncSetAttribute((const void*)fwd_kernel, hipFuncAttributeMaxDynamicSharedMemorySize, LDS_BYTES) != hipSuccess) { fprintf(stderr, "kernel_launch: hipFuncSetAttribute failed\n"); grid = -1; return; }
        int per_cu = 0; (void)hipOccupancyMaxActiveBlocksPerMultiprocessor(&per_cu, (const void*)fwd_kernel, 512, LDS_BYTES); (void)hipGetLastError();
        grid = cus;
    }
    if (grid < 0) return;
    (void)hipMemsetAsync((char*)d_ws + WS_CTL, 0, CTL_BYTES, stream);
    Args a{};
    for (int i = 0; i < 25; ++i) a.in[i] = d_in[i];
    a.out = (float*)d_out; a.ws = (unsigned char*)d_ws;
#if MK_MULTI
    for (int p = 0; p < NPH; ++p) { a.ph_lo = p; a.ph_hi = p + 1; hipLaunchKernelGGL(fwd_kernel, dim3(grid), dim3(512), LDS_BYTES, stream, a); }
#else
    a.ph_lo = 0; a.ph_hi = NPH; hipLaunchKernelGGL(fwd_kernel, dim3(grid), dim3(512), LDS_BYTES, stream, a);
#endif
}
```

```cpp
#include <hip/hip_runtime.h>
#include <cstdio>
#include <cstdint>
namespace pg8 {
#define PG8_LAS __attribute__((address_space(3)))
typedef unsigned short bf16_t;
typedef short bf16x8 __attribute__((ext_vector_type(8)));
typedef float f32x4 __attribute__((ext_vector_type(4)));
typedef unsigned u32x4 __attribute__((ext_vector_type(4)));
constexpr int BM = 256, BK = 64, HALF = 128, HTB = HALF * BK * 2  , STAGE_BYTES = 8 * HTB, NXCD = 8, WGM = 8;

__host__ __device__ __forceinline__ int lds_byte(int r, int c) { const int st = (r >> 4) * 2 + (c >> 5), rr = r & 15, cc = c & 31, ob = rr * 64 + cc * 2; return st * 1024 + (ob ^ (((ob >> 9) & 1) << 5)); }
__host__ __device__ __forceinline__ void stage_rc(int b, int& R, int& C) { const int st = b / 1024, sb = b % 1024, swz = sb ^ (((sb >> 9) & 1) << 5); R = (st >> 1) * 16 + swz / 64; C = (st & 1) * 32 + (swz % 64) / 2; }
__host__ __device__ __forceinline__ int perm32(int rho) { const int n = rho >> 4, i = rho & 15; return 8 * (i >> 2) + 4 * n + (i & 3); }

struct Unit { int pm, pn; };
struct Gemm { const bf16_t* A; const bf16_t* Bt; int M, N, K; };

struct StaticOrder {
    int nM, nN, nwg, G, c;
    __host__ __device__ void init(int M, int N, int G_, int c_) { nM = M / BM; nN = N / BM; nwg = nM * nN; G = G_; c = c_; }
    __host__ __device__ bool next(int i, Unit& u) const {
        const long L = (long)i * G + c; if (L >= nwg) return false;
        int wgid = (int)L; { const int q = nwg / NXCD, r = nwg % NXCD, xcd = wgid % NXCD, off = wgid / NXCD; wgid = (xcd < r ? xcd * (q + 1) : r * (q + 1) + (xcd - r) * q) + off; }
        const int nig = WGM * nN, gid = wgid / nig, fm = gid * WGM, gsz = (nM - fm) < WGM ? (nM - fm) : WGM;
        u.pm = fm + ((wgid % nig) % gsz); u.pn = (wgid % nig) / gsz; return true;
    }
    __device__ __forceinline__ void a_ready(const Unit&) const {}
    __device__ __forceinline__ void done(const Unit&) const {}
};

__device__ __forceinline__ unsigned cvt_pk_bf16(float lo, float hi) { unsigned r; asm volatile("v_cvt_pk_bf16_f32 %0, %1, %2" : "=v"(r) : "v"(lo), "v"(hi)); return r; }
typedef float f32x2 __attribute__((ext_vector_type(2)));
__device__ __forceinline__ f32x2 gelu_pk(f32x2 v) {
    const f32x2 av = __builtin_elementwise_abs(v), d = av * 0.2316418882f + 1.0f;
    f32x2 t; t.x = __builtin_amdgcn_rcpf(d.x); t.y = __builtin_amdgcn_rcpf(d.y);
    f32x2 q = t * 0.5307027145f + (-0.7265760135f); q = q * t + 0.7107068705f; q = q * t + (-0.142248368f); q = q * t + 0.127414796f; q = q * t;
    const f32x2 s = (v * v) * (-0.72134752044f);
    f32x2 e; e.x = __builtin_amdgcn_exp2f(s.x); e.y = __builtin_amdgcn_exp2f(s.y);
    const f32x2 m = v * (q * e), r = v - m;
    f32x2 o; o.x = v.x < 0.f ? m.x : r.x; o.y = v.y < 0.f ? m.y : r.y; return o;
}

template <int ACT  > struct EpiBf16 {
    static constexpr bool PERM = true, AFTER_DRAIN = false; static_assert(ACT == 0 || ACT == 1, "EpiBf16: ACT is 0 (none) or 1 (gelu_pk)");
    bf16_t* O; int ldc; const float* bias; int split_cols; size_t split_stride; float scale0;
    __device__ __forceinline__ void operator()(const f32x4 (&acc)[2][2][4][2], const Unit& u, int wr, int wc, int fr, int fq) const {
        const int row0 = u.pm * BM + wr * 64 + fr; int colt = u.pn * BM; bf16_t* base = O;
        float sc = 1.f; if (split_cols) { const int t = colt / split_cols; base += (size_t)t * split_stride; colt -= t * split_cols; if (t == 0) sc = scale0; }
        const int col0 = colt + wc * 32 + 8 * fq, bcol0 = u.pn * BM + wc * 32 + 8 * fq;
        f32x4 bv[2][2];
#pragma unroll
        for (int bj = 0; bj < 2; ++bj)
#pragma unroll
            for (int n = 0; n < 2; ++n) bv[bj][n] = bias ? *(const f32x4*)(bias + bcol0 + bj * HALF + 4 * n) : (f32x4){0.f, 0.f, 0.f, 0.f};
#pragma unroll
        for (int ai = 0; ai < 2; ++ai)
#pragma unroll
            for (int m = 0; m < 4; ++m) { bf16_t* rowp = base + (size_t)(row0 + ai * HALF + m * 16) * ldc + col0;
#pragma unroll
                for (int bj = 0; bj < 2; ++bj) { f32x4 v0 = acc[ai][bj][m][0] + bv[bj][0], v1 = acc[ai][bj][m][1] + bv[bj][1];
                    if (ACT == 1) { f32x2 a = gelu_pk((f32x2){v0[0], v0[1]}), b = gelu_pk((f32x2){v0[2], v0[3]}), c = gelu_pk((f32x2){v1[0], v1[1]}), d = gelu_pk((f32x2){v1[2], v1[3]});
                        v0 = (f32x4){a.x, a.y, b.x, b.y}; v1 = (f32x4){c.x, c.y, d.x, d.y}; }
                    v0 = v0 * sc; v1 = v1 * sc; u32x4 w; w.x = cvt_pk_bf16(v0[0], v0[1]); w.y = cvt_pk_bf16(v0[2], v0[3]); w.z = cvt_pk_bf16(v1[0], v1[1]); w.w = cvt_pk_bf16(v1[2], v1[3]);
                    *(u32x4*)(rowp + bj * HALF) = w; } }
    }
};
template <class Epi, class Sched, bool ALIGN_EPI = false, bool SP2 = false>
__device__ __forceinline__ void gemm_phase(PG8_LAS unsigned char* lds, const Gemm g, const Sched& S, const Epi& E, int wave_idx  ) {
    int tid_ = (int)__builtin_amdgcn_mbcnt_hi(~0u, __builtin_amdgcn_mbcnt_lo(~0u, 0u)); asm volatile("" : "+v"(tid_)); tid_ += 64 * wave_idx;
    const int tid = tid_, wid = wave_idx, lane = tid & 63, wr = wid >> 2, wc = wid & 3, fr = lane & 15, fq = lane >> 4;
    const int K = g.K, nt = K / BK;
    unsigned voffA[2], voffB[2];
#pragma unroll
    for (int i = 0; i < 2; ++i) { int R, C; stage_rc(tid * 16 + i * 8192, R, C); const int Rb = Epi::PERM ? ((R & ~31) + perm32(R & 31)) : R;
        voffA[i] = (unsigned)(R * K + C) * 2u; voffB[i] = (unsigned)(Rb * K + C) * 2u; }
    const size_t kstep = (size_t)(BK * 2);
    const size_t hstep = (size_t)HALF * K * 2;
    const size_t tstep = 2 * hstep;
    const unsigned ldsw = (unsigned)wid * 1024u;
    const int aoff = lds_byte(wr * 64 + fr, fq * 8), boff = lds_byte(wc * 32 + fr, fq * 8);
#define PG8_SA(b, h) (((b) * 2 + (h)) * HTB)
#define PG8_SB(b, h) ((4 + (b) * 2 + (h)) * HTB)
#define PG8_STAGE(bufoff, gbase, voff) do { _Pragma("unroll") for (int _i = 0; _i < 2; ++_i) \
        __builtin_amdgcn_global_load_lds((const unsigned*)((const char*)(gbase) + (voff)[_i]), (PG8_LAS unsigned*)(lds + (bufoff) + ldsw + _i * 8192), 16, 0, 0); } while (0)
#define PG8_LDA(dst, b, h) do { _Pragma("unroll") for (int m = 0; m < 4; ++m) _Pragma("unroll") for (int k = 0; k < 2; ++k) dst[m][k] = *(const PG8_LAS bf16x8*)(lds + PG8_SA(b, h) + aoff + m * 2048 + k * 1024); } while (0)
#define PG8_LDB(dst, b, h) do { _Pragma("unroll") for (int n = 0; n < 2; ++n) _Pragma("unroll") for (int k = 0; k < 2; ++k) dst[n][k] = *(const PG8_LAS bf16x8*)(lds + PG8_SB(b, h) + boff + n * 2048 + k * 1024); } while (0)
#define PG8_MMA(ai, bj, At, Bt) do { __builtin_amdgcn_s_setprio(1); _Pragma("unroll") for (int m = 0; m < 4; ++m) _Pragma("unroll") for (int n = 0; n < 2; ++n) _Pragma("unroll") for (int k = 0; k < 2; ++k) \
        acc[ai][bj][m][n] = __builtin_amdgcn_mfma_f32_16x16x32_bf16(Bt[n][k], At[m][k], acc[ai][bj][m][n], 0, 0, 0); __builtin_amdgcn_s_setprio(0); } while (0)
#define PG8_WAIT_V(n) asm volatile("s_waitcnt vmcnt(" #n ")" ::: "memory")
#define PG8_WAIT_L(n) asm volatile("s_waitcnt lgkmcnt(" #n ")" ::: "memory")
#define PG8_BAR __builtin_amdgcn_s_barrier()
#define PG8_SCHED __builtin_amdgcn_sched_barrier(0)
    Unit cur, nxt; int ui = 0;
    if (!S.next(0, cur)) return;
    f32x4 acc[2][2][4][2];
#pragma unroll
    for (int a = 0; a < 2; ++a)
#pragma unroll
        for (int b = 0; b < 2; ++b)
#pragma unroll
            for (int m = 0; m < 4; ++m)
#pragma unroll
                for (int n = 0; n < 2; ++n) acc[a][b][m][n] = (f32x4){0.f, 0.f, 0.f, 0.f};
    bf16x8 At[4][2], B0[2][2], B1[2][2];
    const char* cA = (const char*)g.A + (size_t)cur.pm * tstep; const char* cB = (const char*)g.Bt + (size_t)cur.pn * tstep;
    S.a_ready(cur);
    if constexpr (SP2) {
        PG8_STAGE(PG8_SB(0, 0), cB, voffB); PG8_STAGE(PG8_SB(0, 1), cB + hstep, voffB); PG8_STAGE(PG8_SA(0, 0), cA, voffA); PG8_STAGE(PG8_SA(0, 1), cA + hstep, voffA);
        if (wr == 1) PG8_BAR;
        PG8_WAIT_V(2); PG8_BAR;
        PG8_STAGE(PG8_SB(1, 0), cB + kstep, voffB); PG8_STAGE(PG8_SA(1, 0), cA + kstep, voffA); PG8_STAGE(PG8_SB(1, 1), cB + hstep + kstep, voffB);
        PG8_WAIT_V(6); PG8_BAR;
    } else {
        PG8_STAGE(PG8_SB(0, 0), cB, voffB); PG8_STAGE(PG8_SA(0, 0), cA, voffA); PG8_STAGE(PG8_SB(0, 1), cB + hstep, voffB); PG8_STAGE(PG8_SA(0, 1), cA + hstep, voffA);
        if (wr == 1) PG8_BAR;
        PG8_WAIT_V(4); PG8_BAR;
        PG8_STAGE(PG8_SB(1, 0), cB + kstep, voffB); PG8_STAGE(PG8_SA(1, 0), cA + kstep, voffA); PG8_STAGE(PG8_SB(1, 1), cB + hstep + kstep, voffB);
        PG8_WAIT_V(6); PG8_BAR;
    }
    for (;;) {
        const bool has_next = S.next(ui + 1, nxt);
        const char* nA = has_next ? (const char*)g.A + (size_t)nxt.pm * tstep : cA; const char* nB = has_next ? (const char*)g.Bt + (size_t)nxt.pn * tstep : cB;
        for (int t = 0; t < nt; t += 2) {
            const bool last = (t == nt - 2);
            const char* a1 = cA + (size_t)(t + 1) * kstep;
            const char* a2 = last ? nA : cA + (size_t)(t + 2) * kstep; const char* b2 = last ? nB : cB + (size_t)(t + 2) * kstep;
            const char* a3 = a2 + kstep; const char* b3 = b2 + kstep;
            if (last && has_next) S.a_ready(nxt);
            if constexpr (SP2) {
            PG8_LDB(B0, 0, 0); PG8_LDB(B1, 0, 1); PG8_SCHED; PG8_LDA(At, 0, 0); PG8_STAGE(PG8_SA(1, 1), a1 + hstep, voffA);
            PG8_WAIT_V(8); PG8_WAIT_L(0); PG8_BAR; PG8_MMA(0, 0, At, B0); PG8_MMA(0, 1, At, B1); PG8_BAR; PG8_SCHED;
            PG8_LDA(At, 0, 1); PG8_STAGE(PG8_SB(0, 0), b2, voffB); PG8_STAGE(PG8_SB(0, 1), b2 + hstep, voffB); PG8_STAGE(PG8_SA(0, 0), a2, voffA);
            PG8_WAIT_V(8); PG8_WAIT_L(0); PG8_BAR; PG8_MMA(1, 0, At, B0); PG8_MMA(1, 1, At, B1); PG8_BAR; PG8_SCHED;
            PG8_LDB(B0, 1, 0); PG8_LDB(B1, 1, 1); PG8_SCHED; PG8_LDA(At, 1, 0); PG8_STAGE(PG8_SA(0, 1), a2 + hstep, voffA);
            PG8_WAIT_V(8); PG8_WAIT_L(0); PG8_BAR; PG8_MMA(0, 0, At, B0); PG8_MMA(0, 1, At, B1); PG8_BAR; PG8_SCHED;
            PG8_LDA(At, 1, 1); PG8_STAGE(PG8_SB(1, 0), b3, voffB); PG8_STAGE(PG8_SB(1, 1), b3 + hstep, voffB); PG8_STAGE(PG8_SA(1, 0), a3, voffA);
            PG8_WAIT_V(8); PG8_WAIT_L(0); PG8_BAR; PG8_MMA(1, 0, At, B0); PG8_MMA(1, 1, At, B1); PG8_BAR; PG8_SCHED;
            } else {
            PG8_LDB(B0, 0, 0); PG8_SCHED; PG8_LDA(At, 0, 0); PG8_STAGE(PG8_SA(1, 1), a1 + hstep, voffA);
            PG8_WAIT_L(8); PG8_BAR; PG8_WAIT_L(0); PG8_MMA(0, 0, At, B0); PG8_BAR; PG8_SCHED;
            PG8_LDB(B1, 0, 1); PG8_STAGE(PG8_SB(0, 0), b2, voffB);
            PG8_BAR; PG8_WAIT_L(0); PG8_MMA(0, 1, At, B1); PG8_BAR;
            PG8_LDA(At, 0, 1); PG8_STAGE(PG8_SA(0, 0), a2, voffA);
            PG8_BAR; PG8_WAIT_L(0); PG8_MMA(1, 0, At, B0); PG8_BAR; PG8_SCHED;
            PG8_STAGE(PG8_SB(0, 1), b2 + hstep, voffB);
            PG8_WAIT_V(6); PG8_BAR; PG8_MMA(1, 1, At, B1); PG8_BAR;
            PG8_LDB(B0, 1, 0); PG8_SCHED; PG8_LDA(At, 1, 0); PG8_STAGE(PG8_SA(0, 1), a2 + hstep, voffA);
            PG8_WAIT_L(8); PG8_BAR; PG8_WAIT_L(0); PG8_MMA(0, 0, At, B0); PG8_BAR; PG8_SCHED;
            PG8_LDB(B1, 1, 1); PG8_STAGE(PG8_SB(1, 0), b3, voffB);
            PG8_BAR; PG8_WAIT_L(0); PG8_MMA(0, 1, At, B1); PG8_BAR;
            PG8_LDA(At, 1, 1); PG8_STAGE(PG8_SA(1, 0), a3, voffA);
            PG8_BAR; PG8_WAIT_L(0); PG8_MMA(1, 0, At, B0); PG8_BAR; PG8_SCHED;
            PG8_STAGE(PG8_SB(1, 1), b3 + hstep, voffB);
            PG8_WAIT_V(6); PG8_BAR; PG8_MMA(1, 1, At, B1); PG8_BAR;
            }
        }
        if constexpr (ALIGN_EPI) { if (wr == 0) PG8_BAR; }
        if constexpr (!Epi::AFTER_DRAIN) { E(acc, cur, wr, wc, fr, fq); S.done(cur); }
        if (!has_next) break;
#pragma unroll
        for (int a = 0; a < 2; ++a)
#pragma unroll
            for (int b = 0; b < 2; ++b)
#pragma unroll
                for (int m = 0; m < 4; ++m)
#pragma unroll
                    for (int n = 0; n < 2; ++n) acc[a][b][m][n] = (f32x4){0.f, 0.f, 0.f, 0.f};
        cur = nxt; cA = nA; cB = nB; ++ui;
        if constexpr (ALIGN_EPI) { if (wr == 1) PG8_BAR; }
    }
    PG8_WAIT_V(0);
    if constexpr (!ALIGN_EPI) { if (wr == 0) PG8_BAR; }
    PG8_BAR;
    if constexpr (Epi::AFTER_DRAIN) { E.fused(acc, cur, wr, wc, fr, fq, lds, wid, lane); S.done(cur); }
#undef PG8_SA
#undef PG8_SB
#undef PG8_STAGE
#undef PG8_LDA
#undef PG8_LDB
#undef PG8_MMA
#undef PG8_WAIT_V
#undef PG8_WAIT_L
#undef PG8_BAR
#undef PG8_SCHED
}
}

#ifndef MK_MULTI
#define MK_MULTI 0
#endif
#define LAS __attribute__((address_space(3)))
typedef unsigned short bf16;
typedef float f32x4 __attribute__((ext_vector_type(4)));
typedef unsigned u32x4 __attribute__((ext_vector_type(4)));
typedef unsigned u32x2 __attribute__((ext_vector_type(2)));

constexpr int DM = 1024, NBATCH = 4, SEQ = 4096, MPR = NBATCH * SEQ, DB = 128, MTOT = MPR + DB, MPAD = 16640;
constexpr int PASTL = 2048, NPOOL = 2560, NPG = 16;
constexpr int INW = 3368, HW = 3584, DFF = 2816, UPW = 5632, PLED = 256;
constexpr int HQ = 0, HKV = 512, HWIN = 1024, HGQKV = 1280, HGZ = 2816, HSM = 3328;
constexpr int GQKV = 1536;
constexpr float LN_EPS = 1e-5f, RMS_EPS = 1e-6f, NEGV = -1e30f;
constexpr float DN_ALPHA = 1.41421356237309515f;

constexpr size_t O_YP = 0, O_YS = O_YP + (size_t)MPR * DM, O_KVP = O_YS + (size_t)DB * DM, O_KVS = O_KVP + (size_t)2 * MPR * 512,
                 O_WINP = O_KVS + (size_t)2 * DB * 512, O_WINS = O_WINP + (size_t)2 * 4 * 512 * 256, O_GSP = O_WINS + (size_t)2 * DB * 512 * 256,
                 O_GSS = O_GSP + (size_t)2 * 4 * 8 * 4096, O_GCP = O_GSS + (size_t)2 * DB * 8 * 4096, O_GCS = O_GCP + (size_t)2 * 4 * 3 * GQKV,
                 O_FCP = O_GCS + (size_t)2 * DB * 3 * GQKV, O_FCS = O_FCP + (size_t)2 * 4 * 2 * DFF, O_END = O_FCS + (size_t)2 * DB * 2 * DFF;

constexpr size_t MiB = 1u << 20;
constexpr size_t alup(size_t x) { return (x + MiB - 1) & ~(MiB - 1); }
constexpr size_t WS_CTL = 0, CTL_BYTES = 1 * MiB;
constexpr size_t WS_WIN = WS_CTL + CTL_BYTES;
constexpr size_t WS_WOUT = WS_WIN + alup((size_t)2 * HW * DM * 2);
constexpr size_t WS_WUP = WS_WOUT + alup((size_t)2 * DM * DM * 2);
constexpr size_t WS_WDN = WS_WUP + alup((size_t)2 * UPW * DM * 2);
constexpr size_t WS_WGT = WS_WDN + alup((size_t)2 * DM * DFF * 2);
constexpr size_t WS_WPJ = WS_WGT + alup((size_t)2 * DM * DM * 2);
constexpr size_t WS_XF = WS_WPJ + alup((size_t)2 * DM * PLED * 2);
constexpr size_t WS_XB = WS_XF + alup((size_t)MPAD * DM * 4);
constexpr size_t WS_T1 = WS_XB + alup((size_t)MPAD * DM * 2);
constexpr size_t WS_H = WS_T1 + alup((size_t)MPAD * DM * 4);
constexpr size_t WS_HS = WS_H + alup((size_t)MPAD * HW * 2);
constexpr size_t WS_PB = WS_HS + alup((size_t)MPAD * 64 * 4);
constexpr size_t WS_PP = WS_PB + alup((size_t)2 * MPAD * PLED * 2);
constexpr size_t WS_MIX = WS_PP + alup((size_t)2 * MPAD * DM * 4);
constexpr size_t WS_UP = WS_MIX + alup((size_t)MPAD * DM * 2);
constexpr size_t WS_ACT = WS_UP + alup((size_t)MPAD * UPW * 2);
constexpr size_t WS_GQ = WS_ACT + alup((size_t)MPAD * DFF * 2);
constexpr size_t WS_GK = WS_GQ + alup((size_t)MTOT * 512 * 4);
constexpr size_t WS_GV = WS_GK + alup((size_t)MTOT * 512 * 4);
constexpr size_t WS_GG = WS_GV + alup((size_t)MTOT * 512 * 4);
constexpr size_t WS_GB = WS_GG + alup((size_t)MTOT * 8 * 4);
constexpr size_t WS_KCP = WS_GB + alup((size_t)MTOT * 8 * 4);
constexpr size_t WS_VCP = WS_KCP + alup((size_t)4 * 128 * 128 * 4);
constexpr size_t WS_KCS = WS_VCP + alup((size_t)4 * 128 * 128 * 4);
constexpr size_t WS_VCS = WS_KCS + alup((size_t)DB * 64 * 128 * 4);
constexpr size_t WS_KCB = WS_VCS + alup((size_t)DB * 64 * 128 * 4);
constexpr size_t WS_VCB = WS_KCB + alup((size_t)4 * 128 * 128 * 2);
constexpr size_t WS_END = WS_VCB + alup((size_t)4 * 128 * 128 * 2);
constexpr int CW_Q0 = 64, CW_Q1 = 128, CW_U0 = 192, CW_U1 = 256;
constexpr int CW_BAR = 4096;

constexpr int CTLB = 1024, RING_BYTES = 131072, MISC_OFF = 0, ARGS_OFF = 256, LDS_BYTES = 147456;

__device__ __forceinline__ float bf2f(bf16 v) { return __uint_as_float(((unsigned)v) << 16); }
__device__ __forceinline__ unsigned f2bf(float f) { unsigned u = __float_as_uint(f); return (u + 0x7fffu + ((u >> 16) & 1u)) >> 16; }
__device__ __forceinline__ unsigned pk2(float lo, float hi) { return f2bf(lo) | (f2bf(hi) << 16); }
__device__ __forceinline__ float wave_sum(float v) {
#pragma unroll
    for (int o = 1; o < 64; o <<= 1) v += __shfl_xor(v, o);
    return v;
}
__device__ __forceinline__ float wave_max(float v) {
#pragma unroll
    for (int o = 1; o < 64; o <<= 1) v = fmaxf(v, __shfl_xor(v, o));
    return v;
}
__device__ __forceinline__ void wave_lds_sync() { asm volatile("s_waitcnt lgkmcnt(0)" ::: "memory"); }
__device__ __forceinline__ float sigmoidf_(float x) { return 1.0f / (1.0f + __expf(-x)); }
__device__ __forceinline__ float siluf_(float x) { return x / (1.0f + __expf(-x)); }
__device__ __forceinline__ float softplusf_(float x) { return fmaxf(x, 0.f) + log1pf(__expf(-fabsf(x))); }

#define XB_TMO      128
#define XB_XCNT(j)  (256  + 64 * (j))
#define XB_XSUB(j)  (1280 + 64 * (j))
#define XB_XGEN(j)  (2304 + 64 * (j))
#define XB_TOP      3328
#define XB_TOPGEN   3392
#define XCD_BAR_WORDS 3456
#define XB_SPIN_CAP (1u << 18)
__device__ __forceinline__ unsigned xb_ld(unsigned* p)              { return __hip_atomic_load(p, __ATOMIC_RELAXED, __HIP_MEMORY_SCOPE_AGENT); }
__device__ __forceinline__ unsigned xb_add(unsigned* p, unsigned v) { return __hip_atomic_fetch_add(p, v, __ATOMIC_RELAXED, __HIP_MEMORY_SCOPE_AGENT); }
__device__ __forceinline__ unsigned xb_xcc_id() { return (unsigned)__builtin_amdgcn_s_getreg((3 << 11) | 20) & 0xFu; }
#define XB_SPIN(cond, bar) do { unsigned _sp = 0; while (cond) { __builtin_amdgcn_s_sleep(1); \
    if ((++_sp & 255u) == 0u) { if (xb_ld(&(bar)[XB_TMO])) break; if (_sp > XB_SPIN_CAP) { atomicAdd(&(bar)[XB_TMO], 1u); break; } } } } while (0)
struct XcdBarrier { unsigned* bar; unsigned x; volatile LAS unsigned* st; };
__device__ __forceinline__ XcdBarrier xcd_barrier_post(unsigned* bar, volatile LAS unsigned* st) {
    XcdBarrier b; b.bar = bar; b.x = xb_xcc_id(); b.st = st;
    if (threadIdx.x == 0) (void)xb_add(&bar[XB_XCNT(b.x)], 1u);
    return b;
}
__device__ __forceinline__ void xcd_barrier_complete(unsigned* bar, unsigned x, unsigned& nloc, unsigned& nx) {
    const unsigned G = gridDim.x * gridDim.y * gridDim.z;
    unsigned sum, cnt, mine, sp = 0u;
    for (;;) {
        sum = 0u; cnt = 0u; mine = 0u;
#pragma unroll
        for (unsigned j = 0; j < 16; ++j) { const unsigned c = xb_ld(&bar[XB_XCNT(j)]); sum += c; cnt += (c > 0u) ? 1u : 0u; mine = (j == x) ? c : mine; }
        if (sum == G) break;
        __builtin_amdgcn_s_sleep(1);
        if ((++sp & 255u) == 0u) { if (xb_ld(&bar[XB_TMO])) break; if (sp > XB_SPIN_CAP) { atomicAdd(&bar[XB_TMO], 1u); break; } }
    }
    nloc = mine > 0u ? mine : 1u; nx = cnt > 0u ? cnt : 1u;
}
__device__ __forceinline__ void xcd_barrier(const XcdBarrier& b) {
    asm volatile("s_waitcnt vmcnt(0)" ::: "memory");
    __syncthreads();
    if (threadIdx.x == 0) {
        unsigned* bar = b.bar;
        __builtin_amdgcn_s_waitcnt(0);
        unsigned nloc = b.st[0], nx = b.st[1];
        if (nloc == 0u) { xcd_barrier_complete(bar, b.x, nloc, nx); b.st[0] = nloc; b.st[1] = nx; }
        const unsigned old = xb_add(&bar[XB_XSUB(b.x)], 1u);
        const unsigned gen = old / nloc;
        if (old + 1u == (gen + 1u) * nloc) {
            __builtin_amdgcn_fence(__ATOMIC_RELEASE, "agent");
            asm volatile("s_waitcnt vmcnt(0)" ::: "memory");
            const unsigned og = xb_add(&bar[XB_TOP], 1u);
            const unsigned tg = og / nx;
            if (og + 1u == (tg + 1u) * nx) xb_add(&bar[XB_TOPGEN], 1u);
            else XB_SPIN(xb_ld(&bar[XB_TOPGEN]) == tg, bar);
            __builtin_amdgcn_fence(__ATOMIC_ACQUIRE, "agent");
            xb_add(&bar[XB_XGEN(b.x)], 1u);
            asm volatile("s_waitcnt vmcnt(0)" ::: "memory");
        } else {
            XB_SPIN(xb_ld(&bar[XB_XGEN(b.x)]) == gen, bar);
            __builtin_amdgcn_fence(__ATOMIC_ACQUIRE, "agent");
            asm volatile("s_waitcnt vmcnt(0)" ::: "memory");
        }
    }
    __syncthreads();
}

struct Args { const void* in[25]; float* out; unsigned char* ws; int ph_lo, ph_hi; };
enum { I_XP = 0, I_XS, I_CACHE, I_SWIN, I_SGDN, I_SGCONV, I_SFCONV, I_PTAB, I_PP, I_PS, I_WIN, I_PE, I_PHI, I_GCW, I_ALOG, I_DTB, I_GNW, I_WOUT, I_LNG, I_LNB, I_WUP, I_FCW, I_WDN, I_WPJ, I_WGT };

namespace pg8 {
struct EpiIn {
    static constexpr bool PERM = true, AFTER_DRAIN = false;
    bf16_t* H; float* HS; float* kvp; float* kvs;
    __device__ __forceinline__ void operator()(const f32x4 (&acc)[2][2][4][2], const Unit& u, int wr, int wc, int fr, int fq) const {
        const int row0 = u.pm * BM + wr * 64 + fr, col0 = u.pn * BM + wc * 32 + 8 * fq;
        const bool iskv = (u.pn == 2 || u.pn == 3), issm = (u.pn == 13);
#pragma unroll
        for (int ai = 0; ai < 2; ++ai)
#pragma unroll
            for (int m = 0; m < 4; ++m) { const int r = row0 + ai * HALF + m * 16;
#pragma unroll
                for (int bj = 0; bj < 2; ++bj) { const int c = col0 + bj * HALF; const f32x4 v0 = acc[ai][bj][m][0], v1 = acc[ai][bj][m][1];
                    u32x4 w; w.x = cvt_pk_bf16(v0[0], v0[1]); w.y = cvt_pk_bf16(v0[2], v0[3]); w.z = cvt_pk_bf16(v1[0], v1[1]); w.w = cvt_pk_bf16(v1[2], v1[3]);
                    *(u32x4*)(H + (size_t)r * HW + c) = w;
                    if (iskv) { float* dst = nullptr; if (r < MPR) dst = kvp + (size_t)r * 512 + (c - HKV); else if (r < MTOT) dst = kvs + (size_t)(r - MPR) * 512 + (c - HKV);
                        if (dst) { *(f32x4*)dst = v0; *(f32x4*)(dst + 4) = v1; } }
                    if (issm && (c - HSM) < 64) { float* dst = HS + (size_t)r * 64 + (c - HSM); *(f32x4*)dst = v0; *(f32x4*)(dst + 4) = v1; } } }
    }
};
struct EpiRes {
    static constexpr bool PERM = false, AFTER_DRAIN = false;
    const float* XF; float* T1;
    __device__ __forceinline__ void operator()(const f32x4 (&acc)[2][2][4][2], const Unit& u, int wr, int wc, int fr, int fq) const {
        const int row0 = u.pm * BM + wr * 64 + fr, col0 = u.pn * BM + wc * 32 + 4 * fq;
#pragma unroll
        for (int ai = 0; ai < 2; ++ai)
#pragma unroll
            for (int m = 0; m < 4; ++m) { const size_t off = (size_t)(row0 + ai * HALF + m * 16) * DM + col0;
#pragma unroll
                for (int bj = 0; bj < 2; ++bj)
#pragma unroll
                    for (int n = 0; n < 2; ++n) { const size_t o = off + bj * HALF + n * 16; const f32x4 xv = *(const f32x4*)(XF + o); *(f32x4*)(T1 + o) = xv * DN_ALPHA + acc[ai][bj][m][n]; } }
    }
};
struct EpiGate {
    static constexpr bool PERM = false, AFTER_DRAIN = false;
    const float* XF; const float* PP; float* T1;
    __device__ __forceinline__ void operator()(const f32x4 (&acc)[2][2][4][2], const Unit& u, int wr, int wc, int fr, int fq) const {
        const int row0 = u.pm * BM + wr * 64 + fr, col0 = u.pn * BM + wc * 32 + 4 * fq;
#pragma unroll
        for (int ai = 0; ai < 2; ++ai)
#pragma unroll
            for (int m = 0; m < 4; ++m) { const size_t off = (size_t)(row0 + ai * HALF + m * 16) * DM + col0;
#pragma unroll
                for (int bj = 0; bj < 2; ++bj)
#pragma unroll
                    for (int n = 0; n < 2; ++n) { const size_t o = off + bj * HALF + n * 16; const f32x4 xv = *(const f32x4*)(XF + o), pv = *(const f32x4*)(PP + o); const f32x4 a = acc[ai][bj][m][n]; f32x4 s;
#pragma unroll
                        for (int j = 0; j < 4; ++j) s[j] = 1.0f / (1.0f + __expf(-a[j]));
                        *(f32x4*)(T1 + o) = xv * DN_ALPHA + s * pv; } }
    }
};
struct EpiF32 {
    static constexpr bool PERM = false, AFTER_DRAIN = false;
    float* C; int ldc;
    __device__ __forceinline__ void operator()(const f32x4 (&acc)[2][2][4][2], const Unit& u, int wr, int wc, int fr, int fq) const {
        const int row0 = u.pm * BM + wr * 64 + fr, col0 = u.pn * BM + wc * 32 + 4 * fq;
#pragma unroll
        for (int ai = 0; ai < 2; ++ai)
#pragma unroll
            for (int m = 0; m < 4; ++m) { float* rowp = C + (size_t)(row0 + ai * HALF + m * 16) * ldc + col0;
#pragma unroll
                for (int bj = 0; bj < 2; ++bj)
#pragma unroll
                    for (int n = 0; n < 2; ++n) *(f32x4*)(rowp + bj * HALF + n * 16) = acc[ai][bj][m][n]; }
    }
};
}

struct Ctx { int tid, lane, wave, bid, G; LAS unsigned char* lds; unsigned* ctl; const LAS unsigned* la; };
#define GAS __attribute__((address_space(1)))
__device__ __forceinline__ const void* ld_ptr(const LAS unsigned* p) { const unsigned lo = (unsigned)__builtin_amdgcn_readfirstlane((int)p[0]), hi = (unsigned)__builtin_amdgcn_readfirstlane((int)p[1]);
    return (const void*)(const GAS void*)(uintptr_t)(((unsigned long long)hi << 32) | lo); }
__device__ __forceinline__ int hw_lane() { return (int)__builtin_amdgcn_mbcnt_hi(~0u, __builtin_amdgcn_mbcnt_lo(~0u, 0u)); }
__device__ __forceinline__ Ctx relaunder(const Ctx& c0) { Ctx c = c0; int w = c0.wave; asm volatile("" : "+s"(w) :: "memory"); int ln = hw_lane(); asm volatile("" : "+v"(ln) :: "memory"); c.wave = w; c.lane = ln; c.tid = w * 64 + ln; int b = c0.bid; asm volatile("" : "+s"(b) :: "memory"); c.bid = b; return c; }
#define AIN(i) ld_ptr(c.la + 2 * (i))
#define AOUT ((float*)ld_ptr(c.la + 50))
#define AWS ((unsigned char*)ld_ptr(c.la + 52))

__device__ __forceinline__ int in_colmap(int n) {
    if (n < HGQKV) return n;
    if (n < HGZ) return 1304 + (n - HGQKV);
    if (n < HSM) return 2856 + (n - HGZ);
    if (n < HSM + 24) return 1280 + (n - HSM);
    if (n < HSM + 32) return 2840 + (n - HSM - 24);
    if (n < HSM + 40) return 2848 + (n - HSM - 32);
    return -1;
}
__device__ __forceinline__ void p0_prologue(const Ctx& c0) {
    const Ctx c = relaunder(c0);
    LAS float* tile = (LAS float*)c.lds;
    constexpr int T_IN = (HW / 64) * (DM / 64), T_OUT = 16 * 16, T_UP = (UPW / 64) * 16, T_DN = 16 * (DFF / 64), T_GT = 256, T_PJ = 16 * (PLED / 64);
    constexpr int T_L = T_IN + T_OUT + T_UP + T_DN + T_GT + T_PJ;
    for (int it = c.bid; it < 2 * T_L; it += c.G) {
        const int l = it / T_L; int r = it % T_L;
        const float* W; bf16* WT; int K, Ns, mode = 0;
        if (r < T_IN) { W = (const float*)AIN(I_WIN) + (size_t)l * DM * INW; K = DM; Ns = INW; WT = (bf16*)(AWS + WS_WIN) + (size_t)l * HW * DM; mode = 1; }
        else if ((r -= T_IN) < T_OUT) { W = (const float*)AIN(I_WOUT) + (size_t)l * DM * DM; K = DM; Ns = DM; WT = (bf16*)(AWS + WS_WOUT) + (size_t)l * DM * DM; }
        else if ((r -= T_OUT) < T_UP) { W = (const float*)AIN(I_WUP) + (size_t)l * DM * UPW; K = DM; Ns = UPW; WT = (bf16*)(AWS + WS_WUP) + (size_t)l * UPW * DM; }
        else if ((r -= T_UP) < T_DN) { W = (const float*)AIN(I_WDN) + (size_t)l * DFF * DM; K = DFF; Ns = DM; WT = (bf16*)(AWS + WS_WDN) + (size_t)l * DM * DFF; }
        else if ((r -= T_DN) < T_GT) { W = (const float*)AIN(I_WGT) + (size_t)l * DM * DM; K = DM; Ns = DM; WT = (bf16*)(AWS + WS_WGT) + (size_t)l * DM * DM; }
        else { r -= T_GT; W = (const float*)AIN(I_WPJ) + (size_t)l * PLED * DM; K = PLED; Ns = DM; WT = (bf16*)(AWS + WS_WPJ) + (size_t)l * DM * PLED; }
        const int nk = K / 64, tn = r / nk, tk = r % nk, n0 = tn * 64, k0 = tk * 64;
        { const int nn = c.tid & 63; const int nd = n0 + nn; const int sc = mode ? in_colmap(nd) : nd;
#pragma unroll
          for (int q = 0; q < 8; ++q) { const int kk = q * 8 + (c.tid >> 6); tile[kk * 65 + nn] = (sc >= 0) ? W[(size_t)(k0 + kk) * Ns + sc] : 0.f; } }
        __syncthreads();
        { const int n = c.tid >> 3, kc = (c.tid & 7) * 8; const LAS float* s = tile + kc * 65 + n;
          u32x4 o; o.x = pk2(s[0], s[65]); o.y = pk2(s[2 * 65], s[3 * 65]); o.z = pk2(s[4 * 65], s[5 * 65]); o.w = pk2(s[6 * 65], s[7 * 65]);
          *(u32x4*)(WT + (size_t)(n0 + n) * K + k0 + kc) = o; }
        __syncthreads();
    }
    const size_t gt = (size_t)c.bid * 512 + c.tid, GT = (size_t)c.G * 512;
    { float* XF = (float*)(AWS + WS_XF); bf16* XB = (bf16*)(AWS + WS_XB); const float* xp = (const float*)AIN(I_XP); const float* xs = (const float*)AIN(I_XS);
      for (size_t i = gt; i < (size_t)MPAD * DM / 4; i += GT) { const size_t e = i * 4; const size_t row = e / DM;
          f32x4 v = (f32x4){0.f, 0.f, 0.f, 0.f};
          if (row < (size_t)MPR) v = *(const f32x4*)(xp + e); else if (row < (size_t)MTOT) v = *(const f32x4*)(xs + (e - (size_t)MPR * DM));
          *(f32x4*)(XF + e) = v; u32x2 w; w.x = pk2(v[0], v[1]); w.y = pk2(v[2], v[3]); *(u32x2*)(XB + e) = w; } }
    for (int l = 0; l < 2; ++l) { bf16* PB = (bf16*)(AWS + WS_PB) + (size_t)l * MPAD * PLED; const float* pp = (const float*)AIN(I_PP) + (size_t)l * MPR * PLED; const float* ps = (const float*)AIN(I_PS) + (size_t)l * DB * PLED;
      for (size_t i = gt; i < (size_t)MPAD * PLED / 4; i += GT) { const size_t e = i * 4; const size_t row = e / PLED;
          f32x4 v = (f32x4){0.f, 0.f, 0.f, 0.f};
          if (row < (size_t)MPR) v = *(const f32x4*)(pp + e); else if (row < (size_t)MTOT) v = *(const f32x4*)(ps + (e - (size_t)MPR * PLED));
          u32x2 w; w.x = pk2(v[0], v[1]); w.y = pk2(v[2], v[3]); *(u32x2*)(PB + e) = w; } }
}

__device__ __forceinline__ void p3_prep(const Ctx& c0, int l) {
    const Ctx c = relaunder(c0);
    const int gw = c.bid * 8 + c.wave, NGW = c.G * 8, lane = c.lane;
    const bf16* H = (const bf16*)(AWS + WS_H); const float* HS = (const float*)(AWS + WS_HS);
    const float* pe = (const float*)AIN(I_PE) + (size_t)l * 2 * 32 * 64; const float* phi = (const float*)AIN(I_PHI) + (size_t)l * 2 * 64 * 64;
    const int* ptab = (const int*)AIN(I_PTAB);
    const float* cache = (const float*)AIN(I_CACHE) + (size_t)l * NPOOL * 128 * 512;
    { float* KC = (float*)(AWS + WS_KCP); float* VC = (float*)(AWS + WS_VCP);
      for (int it = gw; it < 4 * 128 * 4; it += NGW) { const int type = it & 1, n = (it >> 1) & 1, cb = (it >> 2) & 127, b = it >> 9;
          float s = 0.f;
          const bf16* src = H + (size_t)(b * SEQ + cb * 32) * HW + HKV + type * 128 + n * 64 + lane;
#pragma unroll 8
          for (int i = 0; i < 32; ++i) s += bf2f(src[(size_t)i * HW]) + pe[(type * 32 + i) * 64 + lane];
          const float mean = s * (1.f / 32.f); float o = 0.f;
#pragma unroll 8
          for (int d = 0; d < 64; ++d) o += __shfl(mean, d) * phi[(type * 64 + d) * 64 + lane];
          (type ? VC : KC)[((size_t)(b * 128 + cb) * 2 + n) * 64 + lane] = o;
          ((bf16*)(AWS + (type ? WS_VCB : WS_KCB)))[((size_t)(b * 128 + cb) * 2 + n) * 64 + lane] = (bf16)f2bf(o); } }
    { float* KC = (float*)(AWS + WS_KCS); float* VC = (float*)(AWS + WS_VCS);
      for (int it = gw; it < DB * 64 * 4; it += NGW) { const int type = it & 1, n = (it >> 1) & 1, cb = (it >> 2) & 63, b = it >> 8;
          const int page = ptab[b * NPG + (cb >> 2)]; const float* src = cache + ((size_t)page * 128 + (cb & 3) * 32) * 512 + type * 128 + n * 64 + lane;
          float s = 0.f;
#pragma unroll 8
          for (int i = 0; i < 32; ++i) s += src[(size_t)i * 512] + pe[(type * 32 + i) * 64 + lane];
          const float mean = s * (1.f / 32.f); float o = 0.f;
#pragma unroll 8
          for (int d = 0; d < 64; ++d) o += __shfl(mean, d) * phi[(type * 64 + d) * 64 + lane];
          (type ? VC : KC)[((size_t)(b * 64 + cb) * 2 + n) * 64 + lane] = o; } }
    { float* GQ = (float*)(AWS + WS_GQ); float* GK = (float*)(AWS + WS_GK); float* GV = (float*)(AWS + WS_GV); float* GG = (float*)(AWS + WS_GG); float* GB = (float*)(AWS + WS_GB);
      const float* cw = (const float*)AIN(I_GCW) + (size_t)l * 4 * GQKV; const float* sgc = (const float*)AIN(I_SGCONV) + (size_t)l * DB * 3 * GQKV;
      const float* alog = (const float*)AIN(I_ALOG) + l * 8; const float* dtb = (const float*)AIN(I_DTB) + l * 8;
      for (int it = gw; it < MTOT * 8; it += NGW) { const int hh = it & 7, m = it >> 3;
          float y[3];
#pragma unroll
          for (int j = 0; j < 3; ++j) { const int cc = j * 512 + hh * 64 + lane; float xs[4];
              xs[3] = bf2f(H[(size_t)m * HW + HGQKV + cc]);
              if (m < MPR) { const int t = m & (SEQ - 1);
#pragma unroll
                  for (int i = 0; i < 3; ++i) xs[i] = (t + i - 3 >= 0) ? bf2f(H[(size_t)(m + i - 3) * HW + HGQKV + cc]) : 0.f; }
              else { const int b = m - MPR;
#pragma unroll
                  for (int i = 0; i < 3; ++i) xs[i] = sgc[((size_t)b * 3 + i) * GQKV + cc]; }
              float acc = 0.f;
#pragma unroll
              for (int i = 0; i < 4; ++i) acc += cw[i * GQKV + cc] * xs[i];
              y[j] = siluf_(acc); }
          const float sq = wave_sum(y[0] * y[0]), sk = wave_sum(y[1] * y[1]);
          const size_t o = (size_t)m * 512 + hh * 64 + lane;
          GQ[o] = y[0] * rsqrtf(sq + RMS_EPS) * 0.125f; GK[o] = y[1] * rsqrtf(sk + RMS_EPS); GV[o] = y[2];
          if (lane == 0) { const float ai = HS[(size_t)m * 64 + 24 + hh], bi = HS[(size_t)m * 64 + 32 + hh];
              GG[(size_t)m * 8 + hh] = -__expf(alog[hh]) * softplusf_(ai + dtb[hh]); GB[(size_t)m * 8 + hh] = sigmoidf_(bi); } } }
    const size_t gt = (size_t)c.bid * 512 + c.tid, GT = (size_t)c.G * 512;
    { float* o = AOUT + O_GCP + (size_t)l * 4 * 3 * GQKV;
      for (size_t i = gt; i < (size_t)4 * 3 * GQKV; i += GT) { const int cc = (int)(i % GQKV), r = (int)(i / GQKV) % 3, b = (int)(i / (3 * GQKV)); o[i] = bf2f(H[(size_t)(b * SEQ + SEQ - 3 + r) * HW + HGQKV + cc]); } }
    { float* o = AOUT + O_GCS + (size_t)l * DB * 3 * GQKV; const float* sgc = (const float*)AIN(I_SGCONV) + (size_t)l * DB * 3 * GQKV;
      for (size_t i = gt; i < (size_t)DB * 3 * GQKV; i += GT) { const int cc = (int)(i % GQKV), r = (int)(i / GQKV) % 3, b = (int)(i / (3 * GQKV)); o[i] = (r < 2) ? sgc[i + GQKV] : bf2f(H[(size_t)(MPR + b) * HW + HGQKV + cc]); } }
    { float* o = AOUT + O_WINP + (size_t)l * 4 * 512 * 256;
      for (size_t i = gt; i < (size_t)4 * 512 * 256; i += GT) { const int cc = (int)(i & 255), r = (int)(i >> 8) & 511, b = (int)(i >> 17); o[i] = bf2f(H[(size_t)(b * SEQ + SEQ - 512 + r) * HW + HWIN + cc]); } }
    { float* o = AOUT + O_WINS + (size_t)l * DB * 512 * 256; const float* sw = (const float*)AIN(I_SWIN) + (size_t)l * DB * 512 * 256;
      for (size_t i = gt; i < (size_t)DB * 512 * 256; i += GT) { const int cc = (int)(i & 255), r = (int)(i >> 8) & 511, b = (int)(i >> 17); o[i] = (r < 511) ? sw[i + 256] : bf2f(H[(size_t)(MPR + b) * HW + HWIN + cc]); } }
}

__device__ __forceinline__ float ldT(const bf16* p) { return bf2f(*p); }
__device__ __forceinline__ float ldT(const float* p) { return *p; }
__device__ __forceinline__ void qk4(const bf16* kp, const LAS float* qbuf, float (&dot)[4]) {
    dot[0] = dot[1] = dot[2] = dot[3] = 0.f;
#pragma unroll 2
    for (int cch = 0; cch < 8; ++cch) { const u32x4 w = *(const u32x4*)(kp + cch * 8);
#pragma unroll
        for (int j = 0; j < 4; ++j) { const unsigned ww = w[j]; const float k0 = __uint_as_float(ww << 16), k1 = __uint_as_float(ww & 0xffff0000u);
            const f32x4 q0 = *(const LAS f32x4*)(qbuf + (cch * 8 + j * 2) * 4), q1 = *(const LAS f32x4*)(qbuf + (cch * 8 + j * 2 + 1) * 4);
#pragma unroll
            for (int g = 0; g < 4; ++g) dot[g] += k0 * q0[g] + k1 * q1[g]; } }
}
__device__ __forceinline__ void qk4(const float* kp, const LAS float* qbuf, float (&dot)[4]) {
    dot[0] = dot[1] = dot[2] = dot[3] = 0.f;
#pragma unroll 4
    for (int cch = 0; cch < 16; ++cch) { const f32x4 w = *(const f32x4*)(kp + cch * 4);
#pragma unroll
        for (int j = 0; j < 4; ++j) { const f32x4 q0 = *(const LAS f32x4*)(qbuf + (cch * 4 + j) * 4);
#pragma unroll
            for (int g = 0; g < 4; ++g) dot[g] += w[j] * q0[g]; } }
}
template <typename T>
__device__ __forceinline__ void pv4(const T* vp_lane, const LAS float* pbuf, int lane, float (&o)[4]) {
    const unsigned long long pv = (unsigned long long)(uintptr_t)vp_lane; const int lo = (int)(unsigned)pv, hi = (int)(unsigned)(pv >> 32);
#pragma unroll 8
    for (int j = 0; j < 64; ++j) {
        const unsigned l2 = (unsigned)__builtin_amdgcn_readlane(lo, j), h2 = (unsigned)__builtin_amdgcn_readlane(hi, j);
        const T* vp = (const T*)(uintptr_t)(((unsigned long long)h2 << 32) | l2);
        const float v = ldT(vp + lane); const f32x4 p = *(const LAS f32x4*)(pbuf + j * 4);
#pragma unroll
        for (int g = 0; g < 4; ++g) o[g] += p[g] * v;
    }
}
struct OSm { float m[4], l[4], o[4]; };
__device__ __forceinline__ void os_init(OSm& s) {
#pragma unroll
    for (int g = 0; g < 4; ++g) { s.m[g] = NEGV; s.l[g] = 0.f; s.o[g] = 0.f; } }
template <typename T>
__device__ __forceinline__ void attend_block(OSm& st, const T* kp, const T* vp, bool valid, float dist, const LAS float* qbuf, LAS float* pbuf, int lane, const float (&slope)[4]) {
    float dot[4]; qk4(kp, qbuf, dot);
    f32x4 p;
#pragma unroll
    for (int g = 0; g < 4; ++g) { const float s = valid ? (dot[g] * 0.125f - slope[g] * dist) : NEGV;
        const float mn = fmaxf(st.m[g], wave_max(s)); const float pg = valid ? __expf(s - mn) : 0.f; const float corr = __expf(st.m[g] - mn);
        st.l[g] = st.l[g] * corr + wave_sum(pg); st.o[g] *= corr; st.m[g] = mn; p[g] = pg; }
    *(LAS f32x4*)(pbuf + lane * 4) = p; wave_lds_sync();
    pv4(vp, pbuf, lane, st.o);
    wave_lds_sync();
}
__device__ __forceinline__ unsigned long long select_blocks(const LAS float* impbuf, int lane, int cur) {
    const bool excl = lane > cur; const bool forced = (lane == 0) || (lane == cur) || (lane + 1 == cur);
    const float imp = impbuf[2 * lane] + impbuf[2 * lane + 1];
    const float sc = excl ? -__builtin_inff() : (forced ? __builtin_inff() : imp);
    int cnt = 0; const int sci = __float_as_int(sc);
#pragma unroll 8
    for (int i = 0; i < 64; ++i) { const float si = __int_as_float(__builtin_amdgcn_readlane(sci, i)); cnt += ((si > sc) || (si == sc && i < lane)) ? 1 : 0; }
    return __ballot(!excl && cnt < 16);
}

__device__ __forceinline__ void nsa_item(const Ctx& c, int l, bool sample, int row  , int b, int t, int n, LAS float* wl, int lane) {
    LAS float* qbuf = wl; LAS float* pbuf = wl + 256; LAS float* impbuf = wl + 512;
    const bf16* H = (const bf16*)(AWS + WS_H); const float* HS = (const float*)(AWS + WS_HS);
    float slope[4];
#pragma unroll
    for (int g = 0; g < 4; ++g) slope[g] = exp2f(-(float)(n * 4 + g + 1));
    { f32x4 qv;
#pragma unroll
      for (int g = 0; g < 4; ++g) qv[g] = bf2f(H[(size_t)row * HW + HQ + (n * 4 + g) * 64 + lane]);
      wave_lds_sync(); *(LAS f32x4*)(qbuf + lane * 4) = qv; wave_lds_sync(); }
    const float tp = (float)t;
    const int ncb = sample ? 1 : 2;
    const float* KC = sample ? (const float*)(AWS + WS_KCS) + (size_t)b * 64 * 128 : (const float*)(AWS + WS_KCP) + (size_t)b * 128 * 128;
    const float* VC = sample ? (const float*)(AWS + WS_VCS) + (size_t)b * 64 * 128 : (const float*)(AWS + WS_VCP) + (size_t)b * 128 * 128;
    float sc[2][4]; bool cv[2];
#pragma unroll
    for (int blk = 0; blk < 2; ++blk) { const int cidx = blk * 64 + lane; cv[blk] = (blk < ncb) && (32 * cidx + 31 <= t);
        float dot[4] = {0.f, 0.f, 0.f, 0.f};
        if (blk < ncb) qk4(KC + ((size_t)cidx * 2 + n) * 64, qbuf, dot);
        const float dist = tp - (32.f * (float)cidx + 15.5f);
#pragma unroll
        for (int g = 0; g < 4; ++g) sc[blk][g] = cv[blk] ? (dot[g] * 0.125f - slope[g] * dist) : NEGV; }
    float ocmp[4] = {0.f, 0.f, 0.f, 0.f};
    { f32x4 p0, p1; float i0 = 0.f, i1 = 0.f;
#pragma unroll
      for (int g = 0; g < 4; ++g) { const float mx = wave_max(fmaxf(sc[0][g], sc[1][g]));
          const float e0 = cv[0] ? __expf(sc[0][g] - mx) : 0.f, e1 = cv[1] ? __expf(sc[1][g] - mx) : 0.f; const float sum = wave_sum(e0 + e1); const float inv = sum > 0.f ? 1.0f / sum : 0.f;
          p0[g] = e0 * inv; p1[g] = e1 * inv; i0 += p0[g]; i1 += p1[g]; }
      impbuf[lane] = i0; impbuf[64 + lane] = i1;
      *(LAS f32x4*)(pbuf + lane * 4) = p0; wave_lds_sync();
      pv4(VC + ((size_t)lane * 2 + n) * 64, pbuf, lane, ocmp); wave_lds_sync();
      if (ncb > 1) { *(LAS f32x4*)(pbuf + lane * 4) = p1; wave_lds_sync(); pv4(VC + ((size_t)(64 + lane) * 2 + n) * 64, pbuf, lane, ocmp); wave_lds_sync(); } }
    const int cur = t >> 6;
    unsigned long long mask = select_blocks(impbuf, lane, cur);
    OSm ss; os_init(ss);
    if (!sample) {
        while (mask) { const int j = __builtin_ctzll(mask); mask &= mask - 1;
            const int pos = j * 64 + lane; const bf16* kp = H + (size_t)(b * SEQ + pos) * HW + HKV + 256 + n * 64;
            attend_block<bf16>(ss, kp, kp + 128, pos <= t, (float)(t - pos), qbuf, pbuf, lane, slope); }
    } else {
        const int* ptab = (const int*)AIN(I_PTAB); const float* cache = (const float*)AIN(I_CACHE) + (size_t)l * NPOOL * 128 * 512;
        while (mask) { const int j = __builtin_ctzll(mask); mask &= mask - 1;
            if (j < 32) { const int page = ptab[b * NPG + (j >> 1)]; const float* kp = cache + ((size_t)page * 128 + (j & 1) * 64 + lane) * 512 + 256 + n * 64;
                attend_block<float>(ss, kp, kp + 128, true, (float)(t - (j * 64 + lane)), qbuf, pbuf, lane, slope); }
            else { const bf16* kp = H + (size_t)row * HW + HKV + 256 + n * 64; attend_block<bf16>(ss, kp, kp + 128, lane == 0, 0.f, qbuf, pbuf, lane, slope); } }
    }
    OSm sw; os_init(sw);
    if (!sample) {
        for (int blk = 0; blk < 8; ++blk) { const int p0 = t - 511 + blk * 64; if (p0 + 63 < 0) continue;
            const int pos = p0 + lane; const int pc = pos < 0 ? 0 : pos; const bf16* kp = H + (size_t)(b * SEQ + pc) * HW + HWIN + n * 64;
            attend_block<bf16>(sw, kp, kp + 128, pos >= 0, (float)(t - pos), qbuf, pbuf, lane, slope); }
    } else {
        const float* wst = (const float*)AIN(I_SWIN) + ((size_t)l * DB + b) * 512 * 256;
        for (int blk = 0; blk < 8; ++blk) { const int i = 1 + blk * 64 + lane; const int ic = i > 511 ? 511 : i; const float* kp = wst + (size_t)ic * 256 + n * 64;
            attend_block<float>(sw, kp, kp + 128, i <= 511, (float)(512 - i), qbuf, pbuf, lane, slope); }
        const bf16* kp = H + (size_t)row * HW + HWIN + n * 64; attend_block<bf16>(sw, kp, kp + 128, lane == 0, 0.f, qbuf, pbuf, lane, slope);
    }
    bf16* MIX = (bf16*)(AWS + WS_MIX);
#pragma unroll
    for (int g = 0; g < 4; ++g) { const int hq = n * 4 + g; const float* gp = HS + (size_t)row * 64 + hq * 3;
        const float g0 = sigmoidf_(gp[0]), g1 = sigmoidf_(gp[1]), g2 = sigmoidf_(gp[2]);
        const float osl = ss.l[g] > 0.f ? ss.o[g] / ss.l[g] : 0.f, owi = sw.l[g] > 0.f ? sw.o[g] / sw.l[g] : 0.f;
        MIX[(size_t)row * DM + hq * 64 + lane] = (bf16)f2bf(g0 * ocmp[g] + g1 * osl + g2 * owi); }
}

__device__ __forceinline__ void gdn_steps(const Ctx& c, int l, int row0, int nsteps, int hh, float (&S)[64], LAS float* wl, int lane) {
    const float* GQ = (const float*)(AWS + WS_GQ); const float* GK = (const float*)(AWS + WS_GK); const float* GV = (const float*)(AWS + WS_GV);
    const float* GG = (const float*)(AWS + WS_GG); const float* GB = (const float*)(AWS + WS_GB);
    const bf16* H = (const bf16*)(AWS + WS_H); bf16* MIX = (bf16*)(AWS + WS_MIX);
    const float nw = ((const float*)AIN(I_GNW))[l * 64 + lane];
    LAS float* kb = wl; LAS float* qb = wl + 64;
    size_t o = (size_t)row0 * 512 + hh * 64 + lane;
    float nk = GK[o], nq = GQ[o], nv = GV[o], ng = GG[(size_t)row0 * 8 + hh], nb = GB[(size_t)row0 * 8 + hh], nz = bf2f(H[(size_t)row0 * HW + HGZ + hh * 64 + lane]);
    for (int s = 0; s < nsteps; ++s) {
        const int m = row0 + s;
        const float kv = nk, qv = nq, vv = nv, gv = ng, bv = nb, zv = nz;
        if (s + 1 < nsteps) { const size_t o2 = (size_t)(m + 1) * 512 + hh * 64 + lane;
            nk = GK[o2]; nq = GQ[o2]; nv = GV[o2]; ng = GG[(size_t)(m + 1) * 8 + hh]; nb = GB[(size_t)(m + 1) * 8 + hh]; nz = bf2f(H[(size_t)(m + 1) * HW + HGZ + hh * 64 + lane]); }
        wave_lds_sync(); kb[lane] = kv; qb[lane] = qv; wave_lds_sync();
        const float al = __expf(gv);
        float u0 = 0.f, u1 = 0.f, u2 = 0.f, u3 = 0.f;
#pragma unroll
        for (int d = 0; d < 64; d += 4) { const f32x4 k4 = *(const LAS f32x4*)(kb + d); u0 += k4[0] * S[d]; u1 += k4[1] * S[d + 1]; u2 += k4[2] * S[d + 2]; u3 += k4[3] * S[d + 3]; }
        const float u = (u0 + u1) + (u2 + u3);
        const float w = bv * (vv - al * u);
        float o0 = 0.f, o1 = 0.f, o2 = 0.f, o3 = 0.f;
#pragma unroll
        for (int d = 0; d < 64; d += 4) { const f32x4 k4 = *(const LAS f32x4*)(kb + d); const f32x4 q4 = *(const LAS f32x4*)(qb + d);
            S[d] = al * S[d] + k4[0] * w; S[d + 1] = al * S[d + 1] + k4[1] * w; S[d + 2] = al * S[d + 2] + k4[2] * w; S[d + 3] = al * S[d + 3] + k4[3] * w;
            o0 += q4[0] * S[d]; o1 += q4[1] * S[d + 1]; o2 += q4[2] * S[d + 2]; o3 += q4[3] * S[d + 3]; }
        const float ov = (o0 + o1) + (o2 + o3);
        const float ms = wave_sum(ov * ov) * (1.f / 64.f);
        MIX[(size_t)m * DM + 512 + hh * 64 + lane] = (bf16)f2bf(ov * rsqrtf(ms + RMS_EPS) * nw * siluf_(zv));
    }
}
__device__ __forceinline__ void gdn_item_prompt(const Ctx& c, int l, int b, int hh, LAS float* wl, int lane) {
    float S[64];
#pragma unroll
    for (int d = 0; d < 64; ++d) S[d] = 0.f;
    gdn_steps(c, l, b * SEQ, SEQ, hh, S, wl, lane);
    float* o = AOUT + O_GSP + (((size_t)l * 4 + b) * 8 + hh) * 4096;
#pragma unroll
    for (int d = 0; d < 64; ++d) o[d * 64 + lane] = S[d];
}
__device__ __forceinline__ void gdn_item_sample(const Ctx& c, int l, int b, int hh, LAS float* wl, int lane) {
    const float* s0 = (const float*)AIN(I_SGDN) + (((size_t)l * DB + b) * 8 + hh) * 4096;
    float S[64];
#pragma unroll
    for (int d = 0; d < 64; ++d) S[d] = s0[d * 64 + lane];
    gdn_steps(c, l, MPR + b, 1, hh, S, wl, lane);
    float* o = AOUT + O_GSS + (((size_t)l * DB + b) * 8 + hh) * 4096;
#pragma unroll
    for (int d = 0; d < 64; ++d) o[d * 64 + lane] = S[d];
}

typedef short bf16x8v __attribute__((ext_vector_type(8)));
typedef float f32x16 __attribute__((ext_vector_type(16)));
typedef short s16x4v __attribute__((ext_vector_type(4)));
typedef float f32x2v_ __attribute__((ext_vector_type(2))); typedef __bf16 bf16x2v_ __attribute__((ext_vector_type(2)));
__device__ __forceinline__ unsigned cvtpk(float lo, float hi) { f32x2v_ v = {lo, hi}; bf16x2v_ b = __builtin_convertvector(v, bf16x2v_); return __builtin_bit_cast(unsigned, b); }
__device__ __forceinline__ int crow(int r, int hi) { return (r & 3) + 8 * (r >> 2) + 4 * hi; }
constexpr int NL_KS = 0, NL_VS = 16384, NL_IMP = 32768, NL_IMPB = 4 * 64 * 65 * 4, NL_MASK = NL_IMP + NL_IMPB, NL_WSF = NL_MASK + 512, NL_END = NL_WSF + 8 * 256;
static_assert(NL_END <= RING_BYTES && CTLB + RING_BYTES <= LDS_BYTES, "nsa unit LDS");
constexpr float LOG2E = 1.4426950408889634f, C2S = 0.125f * 1.4426950408889634f, MCLAMP = -1.0e4f, SNEG = -1.0e30f;
struct NsaSm { float m, l; f32x16 o0, o1; };
__device__ __forceinline__ float rowmax32(const f32x16& p0, const f32x16& p1) {
    float a = fmaxf(fmaxf(p0[0], p0[1]), p1[0]), b = fmaxf(fmaxf(p0[2], p0[3]), p1[1]); a = fmaxf(fmaxf(a, p1[2]), p1[3]);
#pragma unroll
    for (int r = 4; r < 16; r += 4) { a = fmaxf(fmaxf(a, p0[r]), p0[r + 1]); b = fmaxf(fmaxf(b, p0[r + 2]), p0[r + 3]); a = fmaxf(fmaxf(a, p1[r]), p1[r + 1]); b = fmaxf(fmaxf(b, p1[r + 2]), p1[r + 3]); }
    const float m = fmaxf(a, b);
    auto rr = __builtin_amdgcn_permlane32_swap(__float_as_uint(m), __float_as_uint(m), false, false);
    return fmaxf(__uint_as_float(rr[0]), __uint_as_float(rr[1]));
}
__device__ __forceinline__ float halves_sum(float v) { auto rr = __builtin_amdgcn_permlane32_swap(__float_as_uint(v), __float_as_uint(v), false, false); return __uint_as_float(rr[0]) + __uint_as_float(rr[1]); }
__device__ __forceinline__ void nsa_qk(f32x16& p0, f32x16& p1, const LAS unsigned char* kslot, const bf16x8v (&qr)[4], int r32, int hi) {
    const LAS unsigned char* kb = kslot + hi * 1024 + r32 * 16;
    f32x16 z;
#pragma unroll
    for (int r = 0; r < 16; ++r) z[r] = 0.f;
    p0 = z; p1 = z;
#pragma unroll
    for (int d0 = 0; d0 < 4; ++d0) { const bf16x8v b0 = *(const LAS bf16x8v*)(kb + d0 * 2048), b1 = *(const LAS bf16x8v*)(kb + d0 * 2048 + 512);
        p0 = __builtin_amdgcn_mfma_f32_32x32x16_bf16(b0, qr[d0], p0, 0, 0, 0); p1 = __builtin_amdgcn_mfma_f32_32x32x16_bf16(b1, qr[d0], p1, 0, 0, 0); }
}
__device__ __forceinline__ void nsa_scores(f32x16& p0, f32x16& p1, float Ap, float slk, int thrp, bool flip) {
#pragma unroll
    for (int r = 0; r < 16; ++r) { const int cr = (r & 3) + 8 * (r >> 2);
        const bool v0 = (cr <= thrp) != flip, v1 = (cr + 32 <= thrp) != flip;
        p0[r] = v0 ? fmaf(p0[r], C2S, fmaf(slk, (float)cr, Ap)) : SNEG; p1[r] = v1 ? fmaf(p1[r], C2S, fmaf(slk, (float)(cr + 32), Ap)) : SNEG; }
}
__device__ __forceinline__ void nsa_pv(f32x16& o0, f32x16& o1, const f32x16& p0, const f32x16& p1, const LAS unsigned char* vslot, int lane, int hi) {
    u32x4 pw[4];
#pragma unroll
    for (int k = 0; k < 4; ++k) { pw[0][k] = cvtpk(p0[2 * k], p0[2 * k + 1]); pw[1][k] = cvtpk(p0[8 + 2 * k], p0[9 + 2 * k]); pw[2][k] = cvtpk(p1[2 * k], p1[2 * k + 1]); pw[3][k] = cvtpk(p1[8 + 2 * k], p1[9 + 2 * k]); }
    const LAS unsigned char* vp = vslot + ((lane >> 4) & 1) * 32 + (lane & 3) * 8 + (4 * hi + ((lane & 15) >> 2)) * 64;
#pragma unroll
    for (int ks = 0; ks < 4; ++ks) {
        const s16x4v a0 = __builtin_bit_cast(s16x4v, __builtin_amdgcn_ds_read_tr16_b64_v4i16((LAS s16x4v*)(vp + ks * 1024)));
        const s16x4v a1 = __builtin_bit_cast(s16x4v, __builtin_amdgcn_ds_read_tr16_b64_v4i16((LAS s16x4v*)(vp + ks * 1024 + 512)));
        const s16x4v b0 = __builtin_bit_cast(s16x4v, __builtin_amdgcn_ds_read_tr16_b64_v4i16((LAS s16x4v*)(vp + 4096 + ks * 1024)));
        const s16x4v b1 = __builtin_bit_cast(s16x4v, __builtin_amdgcn_ds_read_tr16_b64_v4i16((LAS s16x4v*)(vp + 4096 + ks * 1024 + 512)));
        const bf16x8v va = {a0[0], a0[1], a0[2], a0[3], a1[0], a1[1], a1[2], a1[3]}, vb = {b0[0], b0[1], b0[2], b0[3], b1[0], b1[1], b1[2], b1[3]};
        const bf16x8v pa = __builtin_bit_cast(bf16x8v, pw[ks]);
        o0 = __builtin_amdgcn_mfma_f32_32x32x16_bf16(pa, va, o0, 0, 0, 0); o1 = __builtin_amdgcn_mfma_f32_32x32x16_bf16(pa, vb, o1, 0, 0, 0); }
}
__device__ __forceinline__ void nsa_softmax_pv(NsaSm& st, f32x16& p0, f32x16& p1, const LAS unsigned char* vslot, LAS float* wsf, int lane, int r32, int hi) {
    const float rm = rowmax32(p0, p1); const float mn = fmaxf(st.m, rm); const float f = __builtin_amdgcn_exp2f(st.m - mn); st.m = mn;
    float s = 0.f;
#pragma unroll
    for (int r = 0; r < 16; ++r) { p0[r] = __builtin_amdgcn_exp2f(p0[r] - mn); p1[r] = __builtin_amdgcn_exp2f(p1[r] - mn); s += p0[r] + p1[r]; }
    st.l = st.l * f + s;
    if (__any(f != 1.0f)) { wave_lds_sync(); if (hi == 0) wsf[r32] = f; wave_lds_sync();
#pragma unroll
        for (int r = 0; r < 16; ++r) { const float fr = wsf[crow(r, hi)]; st.o0[r] *= fr; st.o1[r] *= fr; } }
    nsa_pv(st.o0, st.o1, p0, p1, vslot, lane, hi);
}
__device__ __forceinline__ void nsa_sm_init(NsaSm& st) { st.m = MCLAMP; st.l = 0.f;
#pragma unroll
    for (int r = 0; r < 16; ++r) { st.o0[r] = 0.f; st.o1[r] = 0.f; } }
__device__ __forceinline__ void nsa_fold(f32x16& f0, f32x16& f1, const f32x16& o0, const f32x16& o1, float fac, LAS float* wsf, int r32, int hi) {
    wave_lds_sync(); if (hi == 0) wsf[r32] = fac; wave_lds_sync();
#pragma unroll
    for (int r = 0; r < 16; ++r) { const float fr = wsf[crow(r, hi)]; f0[r] += o0[r] * fr; f1[r] += o1[r] * fr; }
}
#define NSA_LOADT(kb_, vb_, pitch_) do { int ln_ = lane; asm volatile("" : "+v"(ln_));   \
        kreg = *(const u32x4*)((kb_) + (unsigned)(ln_ * (pitch_) + wid * 8)); vreg = *(const u32x4*)((vb_) + (unsigned)((16 * (wid & 3) + (ln_ >> 2)) * (pitch_) + (wid >> 2) * 32 + (ln_ & 3) * 8)); } while (0)
#define NSA_STORET(slot_) do { *(LAS u32x4*)(lds + NL_KS + (slot_) * 8192 + wid * 1024 + lane * 16) = kreg; *(LAS u32x4*)(lds + NL_VS + (slot_) * 8192 + wid * 1024 + lane * 16) = vreg; } while (0)
__device__ __forceinline__ void nsa_unit(const Ctx& c, int l, int b, int n, int qt) {
    LAS unsigned char* lds = c.lds; const int lane = c.lane, wid = c.wave, r32 = lane & 31, hi = lane >> 5, g = wid >> 1, th = wid & 1;
    const int tq = th * 32 + r32, t0 = qt * 64, t = t0 + tq, hq = n * 4 + g;
    const float sl2 = exp2f(-(float)(hq + 1)) * LOG2E;
    LAS float* wsf = (LAS float*)(lds + NL_WSF + wid * 256); LAS float* imp = (LAS float*)(lds + NL_IMP); LAS unsigned long long* maskb = (LAS unsigned long long*)(lds + NL_MASK);
    const bf16* H = (const bf16*)(AWS + WS_H); const float* HS = (const float*)(AWS + WS_HS);
    const size_t rowbase = (size_t)b * SEQ;
    bf16x8v qr[4];
#pragma unroll
    for (int d0 = 0; d0 < 4; ++d0) qr[d0] = *(const bf16x8v*)(H + (rowbase + t) * HW + HQ + hq * 64 + d0 * 16 + hi * 8);
    const float* gp = HS + (rowbase + t) * 64 + hq * 3;
    const float gate0 = sigmoidf_(gp[0]), gate1 = sigmoidf_(gp[1]), gate2 = sigmoidf_(gp[2]);
    u32x4 kreg, vreg;
    f32x16 of0, of1;
    {
        const bf16* KCb = (const bf16*)(AWS + WS_KCB) + ((size_t)b * 128 * 2 + n) * 64; const bf16* VCb = (const bf16*)(AWS + WS_VCB) + ((size_t)b * 128 * 2 + n) * 64;
        const bool two = (t0 + 63 >= 64 * 32 + 31);
        NSA_LOADT(KCb, VCb, 128); NSA_STORET(0);
        if (two) { NSA_LOADT(KCb + 64 * 128, VCb + 64 * 128, 128); NSA_STORET(1); }
        __syncthreads();
        const int kq = (t >= 31) ? ((t - 31) >> 5) : -1; const float slk = 32.f * sl2;
        f32x16 a0, a1, b0, b1;
        nsa_qk(a0, a1, lds + NL_KS, qr, r32, hi);
        nsa_scores(a0, a1, -sl2 * ((float)t - 15.5f) + slk * (float)(4 * hi), slk, kq - 4 * hi, false);
        if (two) { nsa_qk(b0, b1, lds + NL_KS + 8192, qr, r32, hi); nsa_scores(b0, b1, -sl2 * ((float)t - 15.5f - 2048.f) + slk * (float)(4 * hi), slk, kq - 64 - 4 * hi, false); }
        else {
#pragma unroll
            for (int r = 0; r < 16; ++r) { b0[r] = SNEG; b1[r] = SNEG; } }
        const float mx = fmaxf(MCLAMP, fmaxf(rowmax32(a0, a1), rowmax32(b0, b1)));
        float s = 0.f;
#pragma unroll
        for (int r = 0; r < 16; ++r) { a0[r] = __builtin_amdgcn_exp2f(a0[r] - mx); a1[r] = __builtin_amdgcn_exp2f(a1[r] - mx); b0[r] = __builtin_amdgcn_exp2f(b0[r] - mx); b1[r] = __builtin_amdgcn_exp2f(b1[r] - mx); s += (a0[r] + a1[r]) + (b0[r] + b1[r]); }
        const float ltot = halves_sum(s); const float inv = ltot > 0.f ? 1.0f / ltot : 0.f;
        { LAS float* ip = imp + (size_t)(g * 64 + tq) * 65 + 2 * hi;
#pragma unroll
          for (int r = 0; r < 16; r += 2) { const int jb = ((r & 3) >> 1) + 4 * (r >> 2);
              ip[jb] = (a0[r] + a0[r + 1]) * inv; ip[16 + jb] = (a1[r] + a1[r + 1]) * inv; ip[32 + jb] = (b0[r] + b0[r + 1]) * inv; ip[48 + jb] = (b1[r] + b1[r + 1]) * inv; } }
        f32x16 o0, o1;
#pragma unroll
        for (int r = 0; r < 16; ++r) { o0[r] = 0.f; o1[r] = 0.f; of0[r] = 0.f; of1[r] = 0.f; }
        nsa_pv(o0, o1, a0, a1, lds + NL_VS, lane, hi);
        if (two) nsa_pv(o0, o1, b0, b1, lds + NL_VS + 8192, lane, hi);
        nsa_fold(of0, of1, o0, o1, gate0 * inv, wsf, r32, hi);
    }
    __syncthreads();
    {
#pragma unroll 1
        for (int i = 0; i < 8; ++i) { const int q = wid * 8 + i;
            const float iv = ((imp[(size_t)(0 * 64 + q) * 65 + lane] + imp[(size_t)(1 * 64 + q) * 65 + lane]) + imp[(size_t)(2 * 64 + q) * 65 + lane]) + imp[(size_t)(3 * 64 + q) * 65 + lane];
            const bool excl = lane > qt; const bool forced = (lane == 0) || (lane == qt) || (lane + 1 == qt);
            const float sc = excl ? -__builtin_inff() : (forced ? __builtin_inff() : iv);
            int cnt = 0; const int sci = __float_as_int(sc);
#pragma unroll 8
            for (int k = 0; k < 64; ++k) { const float si = __int_as_float(__builtin_amdgcn_readlane(sci, k)); cnt += ((si > sc) || (si == sc && k < lane)) ? 1 : 0; }
            const unsigned long long mk = __ballot(!excl && cnt < 16);
            if (lane == 0) maskb[q] = mk; }
    }
    __syncthreads();
    const unsigned long long mq = maskb[tq];
    unsigned long long uni;
    { unsigned lo = (unsigned)maskb[lane], hi32 = (unsigned)(maskb[lane] >> 32);
#pragma unroll
      for (int o = 1; o < 64; o <<= 1) { lo |= (unsigned)__shfl_xor((int)lo, o); hi32 |= (unsigned)__shfl_xor((int)hi32, o); }
      uni = ((unsigned long long)(unsigned)__builtin_amdgcn_readfirstlane((int)hi32) << 32) | (unsigned)__builtin_amdgcn_readfirstlane((int)lo); }
    {
        NsaSm st; nsa_sm_init(st);
        const bf16* Kb = H + rowbase * HW + HKV + 256 + n * 64; const bf16* Vb = Kb + 128;
        unsigned long long rem = uni; int j = __builtin_ctzll(rem); rem &= rem - 1;
        NSA_LOADT(Kb + (size_t)j * 64 * HW, Vb + (size_t)j * 64 * HW, HW); NSA_STORET(0); __syncthreads();
        int cur = 0;
        for (;;) {
            const bool more = rem != 0ull; int jn = 0;
            if (more) { jn = __builtin_ctzll(rem); rem &= rem - 1; NSA_LOADT(Kb + (size_t)jn * 64 * HW, Vb + (size_t)jn * 64 * HW, HW); }
            f32x16 p0, p1;
            nsa_qk(p0, p1, lds + NL_KS + cur * 8192, qr, r32, hi);
            const bool sel = (mq >> j) & 1ull; const int thr = sel ? (j < qt ? 64 : tq) : -1;
            nsa_scores(p0, p1, -sl2 * (float)(t - 64 * j) + sl2 * (float)(4 * hi), sl2, thr - 4 * hi, false);
            nsa_softmax_pv(st, p0, p1, lds + NL_VS + cur * 8192, wsf, lane, r32, hi);
            if (more) NSA_STORET(cur ^ 1);
            __syncthreads();
            if (!more) break;
            cur ^= 1; j = jn;
        }
        const float ltot = halves_sum(st.l); nsa_fold(of0, of1, st.o0, st.o1, ltot > 0.f ? gate1 / ltot : 0.f, wsf, r32, hi);
    }
    {
        NsaSm st; nsa_sm_init(st);
        const bf16* Kb = H + rowbase * HW + HWIN + n * 64; const bf16* Vb = Kb + 128;
        const int klast = qt - 8 < 0 ? 0 : qt - 8;
        int kt = qt;
        NSA_LOADT(Kb + (size_t)kt * 64 * HW, Vb + (size_t)kt * 64 * HW, HW); NSA_STORET(0); __syncthreads();
        int cur = 0;
        for (;;) {
            const bool more = kt > klast;
            if (more) NSA_LOADT(Kb + (size_t)(kt - 1) * 64 * HW, Vb + (size_t)(kt - 1) * 64 * HW, HW);
            f32x16 p0, p1;
            nsa_qk(p0, p1, lds + NL_KS + cur * 8192, qr, r32, hi);
            const int dl = qt - kt; const bool flip = (dl == 8); const int thr = (dl == 0 || dl == 8) ? tq : 64;
            nsa_scores(p0, p1, -sl2 * (float)(64 * dl + tq) + sl2 * (float)(4 * hi), sl2, thr - 4 * hi, flip);
            nsa_softmax_pv(st, p0, p1, lds + NL_VS + cur * 8192, wsf, lane, r32, hi);
            if (more) NSA_STORET(cur ^ 1);
            __syncthreads();
            if (!more) break;
            cur ^= 1; --kt;
        }
        const float ltot = halves_sum(st.l); nsa_fold(of0, of1, st.o0, st.o1, ltot > 0.f ? gate2 / ltot : 0.f, wsf, r32, hi);
    }
    {
        LAS bf16* stg = (LAS bf16*)(lds + NL_IMP + wid * 4096);
#pragma unroll
        for (int r = 0; r < 16; ++r) { const int orow = crow(r, hi); stg[orow * 64 + r32] = (bf16)f2bf(of0[r]); stg[orow * 64 + 32 + r32] = (bf16)f2bf(of1[r]); }
        wave_lds_sync();
        bf16* MIX = (bf16*)(AWS + WS_MIX) + (rowbase + t0 + th * 32) * DM + hq * 64;
#pragma unroll
        for (int i = 0; i < 4; ++i) { const int row = i * 8 + (lane >> 3), ch = lane & 7; const u32x4 v = *(const LAS u32x4*)(stg + row * 64 + ch * 8); *(u32x4*)(MIX + (size_t)row * DM + ch * 8) = v; }
    }
    __syncthreads();
}
__device__ __forceinline__ void p4_mixers(const Ctx& c0, int l) {
    const Ctx c = relaunder(c0);
    LAS float* wl = (LAS float*)(c.lds + c.wave * 4096);
    const int lane = c.lane;
    if (c.bid < 32) {
        if (c.wave == 0) gdn_item_prompt(c, l, c.bid >> 3, c.bid & 7, wl, lane);
        else {
            unsigned* head = c.ctl + (l ? CW_Q1 : CW_Q0);
            constexpr int N_GS = DB * 8, N_NS = DB * 2, N_ALL = N_GS + N_NS;
            for (;;) {
                unsigned it = 0;
                if (lane == 0) it = __hip_atomic_fetch_add(head, 1u, __ATOMIC_RELAXED, __HIP_MEMORY_SCOPE_AGENT);
                it = (unsigned)__builtin_amdgcn_readfirstlane((int)it);
                if (it >= (unsigned)N_ALL) break;
                if (it < (unsigned)N_GS) gdn_item_sample(c, l, (int)it >> 3, (int)it & 7, wl, lane);
                else { const int k = (int)it - N_GS; nsa_item(c, l, true, MPR + (k >> 1), k >> 1, PASTL, k & 1, wl, lane); }
            }
        }
        __syncthreads();
    }
    {
        unsigned* head = c.ctl + (l ? CW_U1 : CW_U0);
        volatile LAS unsigned* slot = (volatile LAS unsigned*)(c.lds - CTLB + MISC_OFF + 64);
        for (;;) {
            if (c.tid == 0) *slot = __hip_atomic_fetch_add(head, 1u, __ATOMIC_RELAXED, __HIP_MEMORY_SCOPE_AGENT);
            __syncthreads();
            const unsigned u = *slot;
            __syncthreads();
            if (u >= 512u) break;
            nsa_unit(c, l, (int)(u >> 1) & 3, (int)u & 1, 63 - (int)(u >> 3));
        }
    }
}

__device__ __forceinline__ void p_ln(const Ctx& c0, int l, int which, bool final_out) {
    const Ctx c = relaunder(c0);
    const int gw = c.bid * 8 + c.wave, NGW = c.G * 8, lane = c.lane;
    const float* T1 = (const float*)(AWS + WS_T1); float* XF = (float*)(AWS + WS_XF); bf16* XB = (bf16*)(AWS + WS_XB);
    const float* g = (const float*)AIN(I_LNG) + (size_t)(l * 3 + which) * DM; const float* bb = (const float*)AIN(I_LNB) + (size_t)(l * 3 + which) * DM;
    f32x4 gv[4], bv[4];
#pragma unroll
    for (int j = 0; j < 4; ++j) { gv[j] = *(const f32x4*)(g + lane * 4 + 256 * j); bv[j] = *(const f32x4*)(bb + lane * 4 + 256 * j); }
    for (int m = gw; m < MTOT; m += NGW) {
        const float* xr = T1 + (size_t)m * DM + lane * 4; f32x4 v[4]; float s = 0.f;
#pragma unroll
        for (int j = 0; j < 4; ++j) { v[j] = *(const f32x4*)(xr + 256 * j); s += (v[j][0] + v[j][1]) + (v[j][2] + v[j][3]); }
        const float mean = wave_sum(s) * (1.f / DM); float s2 = 0.f;
#pragma unroll
        for (int j = 0; j < 4; ++j) { v[j] = v[j] - mean; s2 += (v[j][0] * v[j][0] + v[j][1] * v[j][1]) + (v[j][2] * v[j][2] + v[j][3] * v[j][3]); }
        const float rstd = rsqrtf(wave_sum(s2) * (1.f / DM) + LN_EPS);
        float* of = final_out ? (m < MPR ? AOUT + O_YP + (size_t)m * DM : AOUT + O_YS + (size_t)(m - MPR) * DM) : XF + (size_t)m * DM;
#pragma unroll
        for (int j = 0; j < 4; ++j) { const f32x4 y = v[j] * rstd * gv[j] + bv[j]; *(f32x4*)(of + lane * 4 + 256 * j) = y;
            if (!final_out) { u32x2 w; w.x = pk2(y[0], y[1]); w.y = pk2(y[2], y[3]); *(u32x2*)(XB + (size_t)m * DM + lane * 4 + 256 * j) = w; } }
    }
}

__device__ __forceinline__ float gelu_erf(float x) { return 0.5f * x * (1.0f + erff(x * 0.70710678118654752f)); }
__device__ __forceinline__ void p8_act(const Ctx& c0, int l) {
    const Ctx c = relaunder(c0);
    const bf16* UP = (const bf16*)(AWS + WS_UP); bf16* ACT = (bf16*)(AWS + WS_ACT);
    const float* fw = (const float*)AIN(I_FCW) + (size_t)l * 3 * DFF; const float* sfc = (const float*)AIN(I_SFCONV) + (size_t)l * DB * 2 * DFF;
    const size_t gt = (size_t)c.bid * 512 + c.tid, GT = (size_t)c.G * 512;
    constexpr int CPR = DFF / 4;
    for (size_t i = gt; i < (size_t)MTOT * CPR; i += GT) { const int m = (int)(i / CPR), cc = (int)(i % CPR) * 4;
        const u32x2 u0 = *(const u32x2*)(UP + (size_t)m * UPW + cc); const u32x2 um = *(const u32x2*)(UP + (size_t)m * UPW + DFF + cc);
        float x0[4] = {__uint_as_float(u0.x << 16), __uint_as_float(u0.x & 0xffff0000u), __uint_as_float(u0.y << 16), __uint_as_float(u0.y & 0xffff0000u)};
        float mu[4] = {__uint_as_float(um.x << 16), __uint_as_float(um.x & 0xffff0000u), __uint_as_float(um.y << 16), __uint_as_float(um.y & 0xffff0000u)};
        float x1[4] = {0.f, 0.f, 0.f, 0.f}, x2[4] = {0.f, 0.f, 0.f, 0.f};
        if (m < MPR) { const int t = m & (SEQ - 1);
            if (t >= 1) { const u32x2 w = *(const u32x2*)(UP + (size_t)(m - 1) * UPW + cc); x1[0] = __uint_as_float(w.x << 16); x1[1] = __uint_as_float(w.x & 0xffff0000u); x1[2] = __uint_as_float(w.y << 16); x1[3] = __uint_as_float(w.y & 0xffff0000u); }
            if (t >= 2) { const u32x2 w = *(const u32x2*)(UP + (size_t)(m - 2) * UPW + cc); x2[0] = __uint_as_float(w.x << 16); x2[1] = __uint_as_float(w.x & 0xffff0000u); x2[2] = __uint_as_float(w.y << 16); x2[3] = __uint_as_float(w.y & 0xffff0000u); } }
        else { const int b = m - MPR; const f32x4 s0 = *(const f32x4*)(sfc + ((size_t)b * 2 + 0) * DFF + cc), s1 = *(const f32x4*)(sfc + ((size_t)b * 2 + 1) * DFF + cc);
#pragma unroll
            for (int j = 0; j < 4; ++j) { x2[j] = s0[j]; x1[j] = s1[j]; } }
        const f32x4 w0 = *(const f32x4*)(fw + cc), w1 = *(const f32x4*)(fw + DFF + cc), w2 = *(const f32x4*)(fw + 2 * DFF + cc);
        float r[4];
#pragma unroll
        for (int j = 0; j < 4; ++j) r[j] = gelu_erf(w0[j] * x2[j] + w1[j] * x1[j] + w2[j] * x0[j]) * mu[j];
        u32x2 w; w.x = pk2(r[0], r[1]); w.y = pk2(r[2], r[3]); *(u32x2*)(ACT + (size_t)m * DFF + cc) = w; }
    { float* o = AOUT + O_FCP + (size_t)l * 4 * 2 * DFF;
      for (size_t i = gt; i < (size_t)4 * 2 * DFF; i += GT) { const int cc = (int)(i % DFF), r = (int)(i / DFF) & 1, b = (int)(i / (2 * DFF)); o[i] = bf2f(UP[(size_t)(b * SEQ + SEQ - 2 + r) * UPW + cc]); } }
    { float* o = AOUT + O_FCS + (size_t)l * DB * 2 * DFF;
      for (size_t i = gt; i < (size_t)DB * 2 * DFF; i += GT) { const int cc = (int)(i % DFF), r = (int)(i / DFF) & 1, b = (int)(i / (2 * DFF)); o[i] = (r == 0) ? sfc[i + DFF] : bf2f(UP[(size_t)(MPR + b) * UPW + cc]); } }
}

constexpr int NPH = 2 + 2 * 11;
__global__ void __launch_bounds__(512, 2) fwd_kernel(Args a) {
    extern __shared__ __attribute__((aligned(16))) unsigned char lds_raw[];
    Ctx c; c.lds = (LAS unsigned char*)lds_raw + CTLB; LAS unsigned char* lctl = (LAS unsigned char*)lds_raw; c.tid = threadIdx.x; c.lane = c.tid & 63; c.wave = __builtin_amdgcn_readfirstlane(c.tid >> 6); c.bid = blockIdx.x; c.G = gridDim.x;
    volatile LAS unsigned* MISC = (volatile LAS unsigned*)(lctl + MISC_OFF);
    if (c.tid < CTLB / 4) ((LAS unsigned*)lctl)[c.tid] = 0u;
    __syncthreads();
    { const unsigned* ap = (const unsigned*)&a; LAS unsigned* la = (LAS unsigned*)(lctl + ARGS_OFF); if (c.tid < 56) la[c.tid] = ap[c.tid]; c.la = la; }
    __syncthreads();
    c.ctl = (unsigned*)(AWS + WS_CTL);
    XcdBarrier bar; bar.bar = c.ctl + CW_BAR; bar.x = 0; bar.st = nullptr;
    const int lo = a.ph_lo, hi = a.ph_hi;
    if (hi - lo > 1) bar = xcd_barrier_post(c.ctl + CW_BAR, MISC + 8);
#define IN(k) (lo <= (k) && (k) < hi)
#define SEAM(k) do { if (IN(k) && IN((k) + 1)) xcd_barrier(bar); } while (0)
    const Ctx cb = c;
    LAS unsigned char* ring = cb.lds;
    if (IN(0)) { p0_prologue(cb); } SEAM(0);
    if (IN(1)) {
        const Ctx c = relaunder(cb);
        for (int l = 0; l < 2; ++l) {
            pg8::Gemm g{(const pg8::bf16_t*)(AWS + WS_PB) + (size_t)l * MPAD * PLED, (const pg8::bf16_t*)(AWS + WS_WPJ) + (size_t)l * DM * PLED, MPAD, DM, PLED};
            pg8::StaticOrder S; S.init(MPAD, DM, c.G, c.bid); pg8::EpiF32 E{(float*)(AWS + WS_PP) + (size_t)l * MPAD * DM, DM};
            pg8::gemm_phase<pg8::EpiF32, pg8::StaticOrder, false, false>(ring, g, S, E, c.wave); }
    } SEAM(1);
    for (int l = 0; l < 2; ++l) {
        const int p = 2 + l * 11;
        const Ctx c = relaunder(cb);
        if (IN(p + 0)) {
            pg8::Gemm g{(const pg8::bf16_t*)(AWS + WS_XB), (const pg8::bf16_t*)(AWS + WS_WIN) + (size_t)l * HW * DM, MPAD, HW, DM};
            pg8::StaticOrder S; S.init(MPAD, HW, c.G, c.bid);
            pg8::EpiIn E{(pg8::bf16_t*)(AWS + WS_H), (float*)(AWS + WS_HS), AOUT + O_KVP + (size_t)l * MPR * 512, AOUT + O_KVS + (size_t)l * DB * 512};
            pg8::gemm_phase<pg8::EpiIn, pg8::StaticOrder, false, false>(ring, g, S, E, c.wave);
        } SEAM(p + 0);
        if (IN(p + 1)) { p3_prep(c, l); } SEAM(p + 1);
        if (IN(p + 2)) { p4_mixers(c, l); } SEAM(p + 2);
        if (IN(p + 3)) {
            pg8::Gemm g{(const pg8::bf16_t*)(AWS + WS_MIX), (const pg8::bf16_t*)(AWS + WS_WOUT) + (size_t)l * DM * DM, MPAD, DM, DM};
            pg8::StaticOrder S; S.init(MPAD, DM, c.G, c.bid); pg8::EpiRes E{(const float*)(AWS + WS_XF), (float*)(AWS + WS_T1)};
            pg8::gemm_phase<pg8::EpiRes, pg8::StaticOrder, false, false>(ring, g, S, E, c.wave);
        } SEAM(p + 3);
        if (IN(p + 4)) { p_ln(c, l, 0, false); } SEAM(p + 4);
        if (IN(p + 5)) {
            pg8::Gemm g{(const pg8::bf16_t*)(AWS + WS_XB), (const pg8::bf16_t*)(AWS + WS_WUP) + (size_t)l * UPW * DM, MPAD, UPW, DM};
            pg8::StaticOrder S; S.init(MPAD, UPW, c.G, c.bid); pg8::EpiBf16<0> E{(pg8::bf16_t*)(AWS + WS_UP), UPW, nullptr, 0, 0, 1.f};
            pg8::gemm_phase<pg8::EpiBf16<0>, pg8::StaticOrder, false, false>(ring, g, S, E, c.wave);
        } SEAM(p + 5);
        if (IN(p + 6)) { p8_act(c, l); } SEAM(p + 6);
        if (IN(p + 7)) {
            pg8::Gemm g{(const pg8::bf16_t*)(AWS + WS_ACT), (const pg8::bf16_t*)(AWS + WS_WDN) + (size_t)l * DM * DFF, MPAD, DM, DFF};
            pg8::StaticOrder S; S.init(MPAD, DM, c.G, c.bid); pg8::EpiRes E{(const float*)(AWS + WS_XF), (float*)(AWS + WS_T1)};
            pg8::gemm_phase<pg8::EpiRes, pg8::StaticOrder, false, false>(ring, g, S, E, c.wave);
        } SEAM(p + 7);
        if (IN(p + 8)) { p_ln(c, l, 1, false); } SEAM(p + 8);
        if (IN(p + 9)) {
            pg8::Gemm g{(const pg8::bf16_t*)(AWS + WS_XB), (const pg8::bf16_t*)(AWS + WS_WGT) + (size_t)l * DM * DM, MPAD, DM, DM};
            pg8::StaticOrder S; S.init(MPAD, DM, c.G, c.bid); pg8::EpiGate E{(const float*)(AWS + WS_XF), (const float*)(AWS + WS_PP) + (size_t)l * MPAD * DM, (float*)(AWS + WS_T1)};
            pg8::gemm_phase<pg8::EpiGate, pg8::StaticOrder, false, false>(ring, g, S, E, c.wave);
        } SEAM(p + 9);
        if (IN(p + 10)) { p_ln(c, l, 2, l == 1); } SEAM(p + 10);
    }
#undef IN
#undef SEAM
}

extern "C" void kernel_launch(void* const* d_in, const int* in_sizes, int n_in, void* d_out, int out_size, void* d_ws, size_t ws_size, hipStream_t stream) {
    static int grid = 0;
    if (grid == 0) {
        if (n_in != 25 || (size_t)out_size != O_END || ws_size < WS_END) { fprintf(stderr, "kernel_launch: unexpected shapes (n_in %d out %d ws %zu)\n", n_in, out_size, ws_size); grid = -1; return; }
        int dev = 0, cus = 0;
        if (hipGetDevice(&dev) != hipSuccess || hipDeviceGetAttribute(&cus, hipDeviceAttributeMultiprocessorCount, dev) != hipSuccess) { grid = -1; return; }
        if (hipFuncSetAttribute((const void*)fwd_kernel, hipFuncAttributeMaxDynamicSharedMemorySize, LDS_BYTES) != hipSuccess) { fprintf(stderr, "kernel_launch: hipFuncSetAttribute failed\n"); grid = -1; return; }
        int per_cu = 0; (void)hipOccupancyMaxActiveBlocksPerMultiprocessor(&per_cu, (const void*)fwd_kernel, 512, LDS_BYTES); (void)hipGetLastError();
        grid = cus;
    }
    if (grid < 0) return;
    (void)hipMemsetAsync((char*)d_ws + WS_CTL, 0, CTL_BYTES, stream);
    Args a{};
    for (int i = 0; i < 25; ++i) a.in[i] = d_in[i];
    a.out = (float*)d_out; a.ws = (unsigned char*)d_ws;
#if MK_MULTI
    for (int p = 0; p < NPH; ++p) { a.ph_lo = p; a.ph_hi = p + 1; hipLaunchKernelGGL(fwd_kernel, dim3(grid), dim3(512), LDS_BYTES, stream, a); }
#else
    a.ph_lo = 0; a.ph_hi = NPH; hipLaunchKernelGGL(fwd_kernel, dim3(grid), dim3(512), LDS_BYTES, stream, a);
#endif
}
```

```cpp
#define PROBE_DBL 0
#include <hip/hip_runtime.h>
#include <cstdio>
#include <cstdint>
namespace pg8 {
#define PG8_LAS __attribute__((address_space(3)))
typedef unsigned short bf16_t;
typedef short bf16x8 __attribute__((ext_vector_type(8)));
typedef float f32x4 __attribute__((ext_vector_type(4)));
typedef unsigned u32x4 __attribute__((ext_vector_type(4)));
constexpr int BM = 256, BK = 64, HALF = 128, HTB = HALF * BK * 2  , STAGE_BYTES = 8 * HTB, NXCD = 8, WGM = 8;

__host__ __device__ __forceinline__ int lds_byte(int r, int c) { const int st = (r >> 4) * 2 + (c >> 5), rr = r & 15, cc = c & 31, ob = rr * 64 + cc * 2; return st * 1024 + (ob ^ (((ob >> 9) & 1) << 5)); }
__host__ __device__ __forceinline__ void stage_rc(int b, int& R, int& C) { const int st = b / 1024, sb = b % 1024, swz = sb ^ (((sb >> 9) & 1) << 5); R = (st >> 1) * 16 + swz / 64; C = (st & 1) * 32 + (swz % 64) / 2; }
__host__ __device__ __forceinline__ int perm32(int rho) { const int n = rho >> 4, i = rho & 15; return 8 * (i >> 2) + 4 * n + (i & 3); }

struct Unit { int pm, pn; };
struct Gemm { const bf16_t* A; const bf16_t* Bt; int M, N, K; };

struct StaticOrder {
    int nM, nN, nwg, G, c;
    __host__ __device__ void init(int M, int N, int G_, int c_) { nM = M / BM; nN = N / BM; nwg = nM * nN; G = G_; c = c_; }
    __host__ __device__ bool next(int i, Unit& u) const {
        const long L = (long)i * G + c; if (L >= nwg) return false;
        int wgid = (int)L; { const int q = nwg / NXCD, r = nwg % NXCD, xcd = wgid % NXCD, off = wgid / NXCD; wgid = (xcd < r ? xcd * (q + 1) : r * (q + 1) + (xcd - r) * q) + off; }
        const int nig = WGM * nN, gid = wgid / nig, fm = gid * WGM, gsz = (nM - fm) < WGM ? (nM - fm) : WGM;
        u.pm = fm + ((wgid % nig) % gsz); u.pn = (wgid % nig) / gsz; return true;
    }
    __device__ __forceinline__ void a_ready(const Unit&) const {}
    __device__ __forceinline__ void done(const Unit&) const {}
};

__device__ __forceinline__ unsigned cvt_pk_bf16(float lo, float hi) { unsigned r; asm volatile("v_cvt_pk_bf16_f32 %0, %1, %2" : "=v"(r) : "v"(lo), "v"(hi)); return r; }
typedef float f32x2 __attribute__((ext_vector_type(2)));
__device__ __forceinline__ f32x2 gelu_pk(f32x2 v) {
    const f32x2 av = __builtin_elementwise_abs(v), d = av * 0.2316418882f + 1.0f;
    f32x2 t; t.x = __builtin_amdgcn_rcpf(d.x); t.y = __builtin_amdgcn_rcpf(d.y);
    f32x2 q = t * 0.5307027145f + (-0.7265760135f); q = q * t + 0.7107068705f; q = q * t + (-0.142248368f); q = q * t + 0.127414796f; q = q * t;
    const f32x2 s = (v * v) * (-0.72134752044f);
    f32x2 e; e.x = __builtin_amdgcn_exp2f(s.x); e.y = __builtin_amdgcn_exp2f(s.y);
    const f32x2 m = v * (q * e), r = v - m;
    f32x2 o; o.x = v.x < 0.f ? m.x : r.x; o.y = v.y < 0.f ? m.y : r.y; return o;
}

template <int ACT  > struct EpiBf16 {
    static constexpr bool PERM = true, AFTER_DRAIN = false; static_assert(ACT == 0 || ACT == 1, "EpiBf16: ACT is 0 (none) or 1 (gelu_pk)");
    bf16_t* O; int ldc; const float* bias; int split_cols; size_t split_stride; float scale0;
    __device__ __forceinline__ void operator()(const f32x4 (&acc)[2][2][4][2], const Unit& u, int wr, int wc, int fr, int fq) const {
        const int row0 = u.pm * BM + wr * 64 + fr; int colt = u.pn * BM; bf16_t* base = O;
        float sc = 1.f; if (split_cols) { const int t = colt / split_cols; base += (size_t)t * split_stride; colt -= t * split_cols; if (t == 0) sc = scale0; }
        const int col0 = colt + wc * 32 + 8 * fq, bcol0 = u.pn * BM + wc * 32 + 8 * fq;
        f32x4 bv[2][2];
#pragma unroll
        for (int bj = 0; bj < 2; ++bj)
#pragma unroll
            for (int n = 0; n < 2; ++n) bv[bj][n] = bias ? *(const f32x4*)(bias + bcol0 + bj * HALF + 4 * n) : (f32x4){0.f, 0.f, 0.f, 0.f};
#pragma unroll
        for (int ai = 0; ai < 2; ++ai)
#pragma unroll
            for (int m = 0; m < 4; ++m) { bf16_t* rowp = base + (size_t)(row0 + ai * HALF + m * 16) * ldc + col0;
#pragma unroll
                for (int bj = 0; bj < 2; ++bj) { f32x4 v0 = acc[ai][bj][m][0] + bv[bj][0], v1 = acc[ai][bj][m][1] + bv[bj][1];
                    if (ACT == 1) { f32x2 a = gelu_pk((f32x2){v0[0], v0[1]}), b = gelu_pk((f32x2){v0[2], v0[3]}), c = gelu_pk((f32x2){v1[0], v1[1]}), d = gelu_pk((f32x2){v1[2], v1[3]});
                        v0 = (f32x4){a.x, a.y, b.x, b.y}; v1 = (f32x4){c.x, c.y, d.x, d.y}; }
                    v0 = v0 * sc; v1 = v1 * sc; u32x4 w; w.x = cvt_pk_bf16(v0[0], v0[1]); w.y = cvt_pk_bf16(v0[2], v0[3]); w.z = cvt_pk_bf16(v1[0], v1[1]); w.w = cvt_pk_bf16(v1[2], v1[3]);
                    *(u32x4*)(rowp + bj * HALF) = w; } }
    }
};
template <class Epi, class Sched, bool ALIGN_EPI = false, bool SP2 = false>
__device__ __forceinline__ void gemm_phase(PG8_LAS unsigned char* lds, const Gemm g, const Sched& S, const Epi& E, int wave_idx  ) {
    int tid_; asm volatile("v_mbcnt_lo_u32_b32 %0, -1, 0\n\tv_mbcnt_hi_u32_b32 %0, -1, %0" : "=v"(tid_)); tid_ += 64 * wave_idx;
    const int tid = tid_, wid = wave_idx, lane = tid & 63, wr = wid >> 2, wc = wid & 3, fr = lane & 15, fq = lane >> 4;
    const int K = g.K, nt = K / BK;
    unsigned voffA[2], voffB[2];
#pragma unroll
    for (int i = 0; i < 2; ++i) { int R, C; stage_rc(tid * 16 + i * 8192, R, C); const int Rb = Epi::PERM ? ((R & ~31) + perm32(R & 31)) : R;
        voffA[i] = (unsigned)(R * K + C) * 2u; voffB[i] = (unsigned)(Rb * K + C) * 2u; }
    const size_t kstep = (size_t)(BK * 2);
    const size_t hstep = (size_t)HALF * K * 2;
    const size_t tstep = 2 * hstep;
    const unsigned ldsw = (unsigned)wid * 1024u;
    const int aoff = lds_byte(wr * 64 + fr, fq * 8), boff = lds_byte(wc * 32 + fr, fq * 8);
#define PG8_SA(b, h) (((b) * 2 + (h)) * HTB)
#define PG8_SB(b, h) ((4 + (b) * 2 + (h)) * HTB)
#define PG8_STAGE(bufoff, gbase, voff) do { _Pragma("unroll") for (int _i = 0; _i < 2; ++_i) \
        __builtin_amdgcn_global_load_lds((const unsigned*)((const char*)(gbase) + (voff)[_i]), (PG8_LAS unsigned*)(lds + (bufoff) + ldsw + _i * 8192), 16, 0, 0); } while (0)
#define PG8_LDA(dst, b, h) do { _Pragma("unroll") for (int m = 0; m < 4; ++m) _Pragma("unroll") for (int k = 0; k < 2; ++k) dst[m][k] = *(const PG8_LAS bf16x8*)(lds + PG8_SA(b, h) + aoff + m * 2048 + k * 1024); } while (0)
#define PG8_LDB(dst, b, h) do { _Pragma("unroll") for (int n = 0; n < 2; ++n) _Pragma("unroll") for (int k = 0; k < 2; ++k) dst[n][k] = *(const PG8_LAS bf16x8*)(lds + PG8_SB(b, h) + boff + n * 2048 + k * 1024); } while (0)
#define PG8_MMA(ai, bj, At, Bt) do { __builtin_amdgcn_s_setprio(1); _Pragma("unroll") for (int m = 0; m < 4; ++m) _Pragma("unroll") for (int n = 0; n < 2; ++n) _Pragma("unroll") for (int k = 0; k < 2; ++k) \
        acc[ai][bj][m][n] = __builtin_amdgcn_mfma_f32_16x16x32_bf16(Bt[n][k], At[m][k], acc[ai][bj][m][n], 0, 0, 0); __builtin_amdgcn_s_setprio(0); } while (0)
#define PG8_WAIT_V(n) asm volatile("s_waitcnt vmcnt(" #n ")" ::: "memory")
#define PG8_WAIT_L(n) asm volatile("s_waitcnt lgkmcnt(" #n ")" ::: "memory")
#define PG8_BAR __builtin_amdgcn_s_barrier()
#define PG8_SCHED __builtin_amdgcn_sched_barrier(0)
    Unit cur, nxt; int ui = 0;
    if (!S.next(0, cur)) return;
    f32x4 acc[2][2][4][2];
#pragma unroll
    for (int a = 0; a < 2; ++a)
#pragma unroll
        for (int b = 0; b < 2; ++b)
#pragma unroll
            for (int m = 0; m < 4; ++m)
#pragma unroll
                for (int n = 0; n < 2; ++n) acc[a][b][m][n] = (f32x4){0.f, 0.f, 0.f, 0.f};
    bf16x8 At[4][2], B0[2][2], B1[2][2];
    const char* cA = (const char*)g.A + (size_t)cur.pm * tstep; const char* cB = (const char*)g.Bt + (size_t)cur.pn * tstep;
    S.a_ready(cur);
    if constexpr (SP2) {
        PG8_STAGE(PG8_SB(0, 0), cB, voffB); PG8_STAGE(PG8_SB(0, 1), cB + hstep, voffB); PG8_STAGE(PG8_SA(0, 0), cA, voffA); PG8_STAGE(PG8_SA(0, 1), cA + hstep, voffA);
        if (wr == 1) PG8_BAR;
        PG8_WAIT_V(2); PG8_BAR;
        PG8_STAGE(PG8_SB(1, 0), cB + kstep, voffB); PG8_STAGE(PG8_SA(1, 0), cA + kstep, voffA); PG8_STAGE(PG8_SB(1, 1), cB + hstep + kstep, voffB);
        PG8_WAIT_V(6); PG8_BAR;
    } else {
        PG8_STAGE(PG8_SB(0, 0), cB, voffB); PG8_STAGE(PG8_SA(0, 0), cA, voffA); PG8_STAGE(PG8_SB(0, 1), cB + hstep, voffB); PG8_STAGE(PG8_SA(0, 1), cA + hstep, voffA);
        if (wr == 1) PG8_BAR;
        PG8_WAIT_V(4); PG8_BAR;
        PG8_STAGE(PG8_SB(1, 0), cB + kstep, voffB); PG8_STAGE(PG8_SA(1, 0), cA + kstep, voffA); PG8_STAGE(PG8_SB(1, 1), cB + hstep + kstep, voffB);
        PG8_WAIT_V(6); PG8_BAR;
    }
    for (;;) {
        const bool has_next = S.next(ui + 1, nxt);
        const char* nA = has_next ? (const char*)g.A + (size_t)nxt.pm * tstep : cA; const char* nB = has_next ? (const char*)g.Bt + (size_t)nxt.pn * tstep : cB;
        for (int t = 0; t < nt; t += 2) {
            const bool last = (t == nt - 2);
            const char* a1 = cA + (size_t)(t + 1) * kstep;
            const char* a2 = last ? nA : cA + (size_t)(t + 2) * kstep; const char* b2 = last ? nB : cB + (size_t)(t + 2) * kstep;
            const char* a3 = a2 + kstep; const char* b3 = b2 + kstep;
            if (last && has_next) S.a_ready(nxt);
            if constexpr (SP2) {
            PG8_LDB(B0, 0, 0); PG8_LDB(B1, 0, 1); PG8_SCHED; PG8_LDA(At, 0, 0); PG8_STAGE(PG8_SA(1, 1), a1 + hstep, voffA);
            PG8_WAIT_V(8); PG8_WAIT_L(0); PG8_BAR; PG8_MMA(0, 0, At, B0); PG8_MMA(0, 1, At, B1); PG8_BAR; PG8_SCHED;
            PG8_LDA(At, 0, 1); PG8_STAGE(PG8_SB(0, 0), b2, voffB); PG8_STAGE(PG8_SB(0, 1), b2 + hstep, voffB); PG8_STAGE(PG8_SA(0, 0), a2, voffA);
            PG8_WAIT_V(8); PG8_WAIT_L(0); PG8_BAR; PG8_MMA(1, 0, At, B0); PG8_MMA(1, 1, At, B1); PG8_BAR; PG8_SCHED;
            PG8_LDB(B0, 1, 0); PG8_LDB(B1, 1, 1); PG8_SCHED; PG8_LDA(At, 1, 0); PG8_STAGE(PG8_SA(0, 1), a2 + hstep, voffA);
            PG8_WAIT_V(8); PG8_WAIT_L(0); PG8_BAR; PG8_MMA(0, 0, At, B0); PG8_MMA(0, 1, At, B1); PG8_BAR; PG8_SCHED;
            PG8_LDA(At, 1, 1); PG8_STAGE(PG8_SB(1, 0), b3, voffB); PG8_STAGE(PG8_SB(1, 1), b3 + hstep, voffB); PG8_STAGE(PG8_SA(1, 0), a3, voffA);
            PG8_WAIT_V(8); PG8_WAIT_L(0); PG8_BAR; PG8_MMA(1, 0, At, B0); PG8_MMA(1, 1, At, B1); PG8_BAR; PG8_SCHED;
            } else {
            PG8_LDB(B0, 0, 0); PG8_SCHED; PG8_LDA(At, 0, 0); PG8_STAGE(PG8_SA(1, 1), a1 + hstep, voffA);
            PG8_WAIT_L(8); PG8_BAR; PG8_WAIT_L(0); PG8_MMA(0, 0, At, B0); PG8_BAR; PG8_SCHED;
            PG8_LDB(B1, 0, 1); PG8_STAGE(PG8_SB(0, 0), b2, voffB);
            PG8_BAR; PG8_WAIT_L(0); PG8_MMA(0, 1, At, B1); PG8_BAR;
            PG8_LDA(At, 0, 1); PG8_STAGE(PG8_SA(0, 0), a2, voffA);
            PG8_BAR; PG8_WAIT_L(0); PG8_MMA(1, 0, At, B0); PG8_BAR; PG8_SCHED;
            PG8_STAGE(PG8_SB(0, 1), b2 + hstep, voffB);
            PG8_WAIT_V(6); PG8_BAR; PG8_MMA(1, 1, At, B1); PG8_BAR;
            PG8_LDB(B0, 1, 0); PG8_SCHED; PG8_LDA(At, 1, 0); PG8_STAGE(PG8_SA(0, 1), a2 + hstep, voffA);
            PG8_WAIT_L(8); PG8_BAR; PG8_WAIT_L(0); PG8_MMA(0, 0, At, B0); PG8_BAR; PG8_SCHED;
            PG8_LDB(B1, 1, 1); PG8_STAGE(PG8_SB(1, 0), b3, voffB);
            PG8_BAR; PG8_WAIT_L(0); PG8_MMA(0, 1, At, B1); PG8_BAR;
            PG8_LDA(At, 1, 1); PG8_STAGE(PG8_SA(1, 0), a3, voffA);
            PG8_BAR; PG8_WAIT_L(0); PG8_MMA(1, 0, At, B0); PG8_BAR; PG8_SCHED;
            PG8_STAGE(PG8_SB(1, 1), b3 + hstep, voffB);
            PG8_WAIT_V(6); PG8_BAR; PG8_MMA(1, 1, At, B1); PG8_BAR;
            }
        }
        if constexpr (ALIGN_EPI) { if (wr == 0) PG8_BAR; }
        if constexpr (!Epi::AFTER_DRAIN) { E(acc, cur, wr, wc, fr, fq); S.done(cur); }
        if (!has_next) break;
#pragma unroll
        for (int a = 0; a < 2; ++a)
#pragma unroll
            for (int b = 0; b < 2; ++b)
#pragma unroll
                for (int m = 0; m < 4; ++m)
#pragma unroll
                    for (int n = 0; n < 2; ++n) acc[a][b][m][n] = (f32x4){0.f, 0.f, 0.f, 0.f};
        cur = nxt; cA = nA; cB = nB; ++ui;
        if constexpr (ALIGN_EPI) { if (wr == 1) PG8_BAR; }
    }
    PG8_WAIT_V(0);
    if constexpr (!ALIGN_EPI) { if (wr == 0) PG8_BAR; }
    PG8_BAR;
    if constexpr (Epi::AFTER_DRAIN) { E.fused(acc, cur, wr, wc, fr, fq, lds, wid, lane); S.done(cur); }
#undef PG8_SA
#undef PG8_SB
#undef PG8_STAGE
#undef PG8_LDA
#undef PG8_LDB
#undef PG8_MMA
#undef PG8_WAIT_V
#undef PG8_WAIT_L
#undef PG8_BAR
#undef PG8_SCHED
}
}

#ifndef MK_MULTI
#define MK_MULTI 0
#endif
#ifndef PROBE_DBL
#define PROBE_DBL 0
#endif
#define LAS __attribute__((address_space(3)))
typedef unsigned short bf16;
typedef float f32x4 __attribute__((ext_vector_type(4)));
typedef unsigned u32x4 __attribute__((ext_vector_type(4)));
typedef unsigned u32x2 __attribute__((ext_vector_type(2)));

constexpr int DM = 1024, NBATCH = 4, SEQ = 4096, MPR = NBATCH * SEQ, DB = 128, MTOT = MPR + DB, MPAD = 16640;
constexpr int PASTL = 2048, NPOOL = 2560, NPG = 16;
constexpr int INW = 3368, HW = 3584, DFF = 2816, UPW = 5632, PLED = 256;
constexpr int HQ = 0, HKV = 512, HWIN = 1024, HGQKV = 1280, HGZ = 2816, HSM = 3328;
constexpr int GQKV = 1536;
constexpr float LN_EPS = 1e-5f, RMS_EPS = 1e-6f, NEGV = -1e30f;
constexpr float DN_ALPHA = 1.41421356237309515f;

constexpr size_t O_YP = 0, O_YS = O_YP + (size_t)MPR * DM, O_KVP = O_YS + (size_t)DB * DM, O_KVS = O_KVP + (size_t)2 * MPR * 512,
                 O_WINP = O_KVS + (size_t)2 * DB * 512, O_WINS = O_WINP + (size_t)2 * 4 * 512 * 256, O_GSP = O_WINS + (size_t)2 * DB * 512 * 256,
                 O_GSS = O_GSP + (size_t)2 * 4 * 8 * 4096, O_GCP = O_GSS + (size_t)2 * DB * 8 * 4096, O_GCS = O_GCP + (size_t)2 * 4 * 3 * GQKV,
                 O_FCP = O_GCS + (size_t)2 * DB * 3 * GQKV, O_FCS = O_FCP + (size_t)2 * 4 * 2 * DFF, O_END = O_FCS + (size_t)2 * DB * 2 * DFF;

constexpr size_t MiB = 1u << 20;
constexpr size_t alup(size_t x) { return (x + MiB - 1) & ~(MiB - 1); }
constexpr size_t WS_CTL = 0, CTL_BYTES = 1 * MiB;
constexpr size_t WS_WIN = WS_CTL + CTL_BYTES;
constexpr size_t WS_WOUT = WS_WIN + alup((size_t)2 * HW * DM * 2);
constexpr size_t WS_WUP = WS_WOUT + alup((size_t)2 * DM * DM * 2);
constexpr size_t WS_WDN = WS_WUP + alup((size_t)2 * UPW * DM * 2);
constexpr size_t WS_WGT = WS_WDN + alup((size_t)2 * DM * DFF * 2);
constexpr size_t WS_WPJ = WS_WGT + alup((size_t)2 * DM * DM * 2);
constexpr size_t WS_XF = WS_WPJ + alup((size_t)2 * DM * PLED * 2);
constexpr size_t WS_XB = WS_XF + alup((size_t)MPAD * DM * 4);
constexpr size_t WS_T1 = WS_XB + alup((size_t)MPAD * DM * 2);
constexpr size_t WS_H = WS_T1 + alup((size_t)MPAD * DM * 4);
constexpr size_t WS_HS = WS_H + alup((size_t)MPAD * HW * 2);
constexpr size_t WS_PB = WS_HS + alup((size_t)MPAD * 64 * 4);
constexpr size_t WS_PP = WS_PB + alup((size_t)2 * MPAD * PLED * 2);
constexpr size_t WS_MIX = WS_PP + alup((size_t)2 * MPAD * DM * 4);
constexpr size_t WS_UP = WS_MIX + alup((size_t)MPAD * DM * 2);
constexpr size_t WS_ACT = WS_UP + alup((size_t)MPAD * UPW * 2);
constexpr size_t WS_GQ = WS_ACT + alup((size_t)MPAD * DFF * 2);
constexpr size_t WS_GK = WS_GQ + alup((size_t)MTOT * 512 * 4);
constexpr size_t WS_GV = WS_GK + alup((size_t)MTOT * 512 * 4);
constexpr size_t WS_GG = WS_GV + alup((size_t)MTOT * 512 * 4);
constexpr size_t WS_GB = WS_GG + alup((size_t)MTOT * 8 * 4);
constexpr size_t WS_KCP = WS_GB + alup((size_t)MTOT * 8 * 4);
constexpr size_t WS_VCP = WS_KCP + alup((size_t)4 * 128 * 128 * 4);
constexpr size_t WS_KCS = WS_VCP + alup((size_t)4 * 128 * 128 * 4);
constexpr size_t WS_VCS = WS_KCS + alup((size_t)DB * 64 * 128 * 4);
constexpr size_t WS_KCB = WS_VCS + alup((size_t)DB * 64 * 128 * 4);
constexpr size_t WS_VCB = WS_KCB + alup((size_t)4 * 128 * 128 * 2);
constexpr size_t WS_SC = WS_VCB + alup((size_t)4 * 128 * 128 * 2);
constexpr size_t WS_OG = WS_SC + alup((size_t)MTOT * 8 * 4 * 4);
constexpr size_t WS_SMASK = WS_OG + alup((size_t)MPR * 512 * 4);
constexpr size_t WS_OCMP = WS_SMASK + alup((size_t)DB * 2 * 8);
constexpr size_t WS_PART = WS_OCMP + alup((size_t)DB * 2 * 256 * 4);
constexpr size_t WS_END = WS_PART + alup((size_t)DB * 2 * 25 * 264 * 4);
constexpr int CW_Q0 = 64, CW_Q1 = 128, CW_U0 = 192, CW_U1 = 256, CW_P0 = 320, CW_P1 = 384;
constexpr int CW_BAR = 4096;

constexpr int CTLB = 1024, RING_BYTES = 131072, MISC_OFF = 0, ARGS_OFF = 256, LDS_BYTES = 147456;

__device__ __forceinline__ float bf2f(bf16 v) { return __uint_as_float(((unsigned)v) << 16); }
__device__ __forceinline__ unsigned f2bf(float f) { unsigned u = __float_as_uint(f); return (u + 0x7fffu + ((u >> 16) & 1u)) >> 16; }
__device__ __forceinline__ unsigned pk2(float lo, float hi) { return f2bf(lo) | (f2bf(hi) << 16); }
__device__ __forceinline__ float wave_sum(float v) {
#pragma unroll
    for (int o = 1; o < 64; o <<= 1) v += __shfl_xor(v, o);
    return v;
}
__device__ __forceinline__ float wave_max(float v) {
#pragma unroll
    for (int o = 1; o < 64; o <<= 1) v = fmaxf(v, __shfl_xor(v, o));
    return v;
}
__device__ __forceinline__ void wave_lds_sync() { asm volatile("s_waitcnt lgkmcnt(0)" ::: "memory"); }
__device__ __forceinline__ float sigmoidf_(float x) { return 1.0f / (1.0f + __expf(-x)); }
__device__ __forceinline__ float siluf_(float x) { return x / (1.0f + __expf(-x)); }
__device__ __forceinline__ float softplusf_(float x) { return fmaxf(x, 0.f) + log1pf(__expf(-fabsf(x))); }

#define XB_TMO      128
#define XB_XCNT(j)  (256  + 64 * (j))
#define XB_XSUB(j)  (1280 + 64 * (j))
#define XB_XGEN(j)  (2304 + 64 * (j))
#define XB_TOP      3328
#define XB_TOPGEN   3392
#define XCD_BAR_WORDS 3456
#define XB_SPIN_CAP (1u << 18)
__device__ __forceinline__ unsigned xb_ld(unsigned* p)              { return __hip_atomic_load(p, __ATOMIC_RELAXED, __HIP_MEMORY_SCOPE_AGENT); }
__device__ __forceinline__ unsigned xb_add(unsigned* p, unsigned v) { return __hip_atomic_fetch_add(p, v, __ATOMIC_RELAXED, __HIP_MEMORY_SCOPE_AGENT); }
__device__ __forceinline__ unsigned xb_xcc_id() { return (unsigned)__builtin_amdgcn_s_getreg((3 << 11) | 20) & 0xFu; }
#define XB_SPIN(cond, bar) do { unsigned _sp = 0; while (cond) { __builtin_amdgcn_s_sleep(1); \
    if ((++_sp & 255u) == 0u) { if (xb_ld(&(bar)[XB_TMO])) break; if (_sp > XB_SPIN_CAP) { atomicAdd(&(bar)[XB_TMO], 1u); break; } } } } while (0)
__device__ __forceinline__ int xb_lane() { int ln; asm volatile("v_mbcnt_lo_u32_b32 %0, -1, 0\n\tv_mbcnt_hi_u32_b32 %0, -1, %0" : "=v"(ln)); return ln; }
struct XcdBarrier { unsigned* bar; unsigned x; volatile LAS unsigned* st; bool w0;   };
__device__ __forceinline__ XcdBarrier xcd_barrier_post(unsigned* bar, volatile LAS unsigned* st) {
    XcdBarrier b; b.bar = bar; b.x = xb_xcc_id(); b.st = st;
    if (threadIdx.x == 0) (void)xb_add(&bar[XB_XCNT(b.x)], 1u);
    return b;
}
__device__ __forceinline__ void xcd_barrier_complete(unsigned* bar, unsigned x, unsigned& nloc, unsigned& nx) {
    const unsigned G = gridDim.x * gridDim.y * gridDim.z;
    unsigned sum, cnt, mine, sp = 0u;
    for (;;) {
        sum = 0u; cnt = 0u; mine = 0u;
#pragma unroll
        for (unsigned j = 0; j < 16; ++j) { const unsigned c = xb_ld(&bar[XB_XCNT(j)]); sum += c; cnt += (c > 0u) ? 1u : 0u; mine = (j == x) ? c : mine; }
        if (sum == G) break;
        __builtin_amdgcn_s_sleep(1);
        if ((++sp & 255u) == 0u) { if (xb_ld(&bar[XB_TMO])) break; if (sp > XB_SPIN_CAP) { atomicAdd(&bar[XB_TMO], 1u); break; } }
    }
    nloc = mine > 0u ? mine : 1u; nx = cnt > 0u ? cnt : 1u;
}
__device__ __forceinline__ void xcd_barrier(const XcdBarrier& b) {
    asm volatile("s_waitcnt vmcnt(0)" ::: "memory");
    __syncthreads();
    if (b.w0 && xb_lane() == 0) {
        unsigned* bar = b.bar; asm volatile("" : "+s"(bar));
        __builtin_amdgcn_s_waitcnt(0);
        unsigned nloc = b.st[0], nx = b.st[1];
        if (nloc == 0u) { xcd_barrier_complete(bar, b.x, nloc, nx); b.st[0] = nloc; b.st[1] = nx; }
        const unsigned old = xb_add(&bar[XB_XSUB(b.x)], 1u);
        const unsigned gen = old / nloc;
        if (old + 1u == (gen + 1u) * nloc) {
            __builtin_amdgcn_fence(__ATOMIC_RELEASE, "agent");
            asm volatile("s_waitcnt vmcnt(0)" ::: "memory");
            const unsigned og = xb_add(&bar[XB_TOP], 1u);
            const unsigned tg = og / nx;
            if (og + 1u == (tg + 1u) * nx) xb_add(&bar[XB_TOPGEN], 1u);
            else XB_SPIN(xb_ld(&bar[XB_TOPGEN]) == tg, bar);
            __builtin_amdgcn_fence(__ATOMIC_ACQUIRE, "agent");
            xb_add(&bar[XB_XGEN(b.x)], 1u);
            asm volatile("s_waitcnt vmcnt(0)" ::: "memory");
        } else {
            XB_SPIN(xb_ld(&bar[XB_XGEN(b.x)]) == gen, bar);
            __builtin_amdgcn_fence(__ATOMIC_ACQUIRE, "agent");
            asm volatile("s_waitcnt vmcnt(0)" ::: "memory");
        }
    }
    __syncthreads();
}

struct Args { const void* in[25]; float* out; unsigned char* ws; int ph_lo, ph_hi, dbl, pad; };
enum { I_XP = 0, I_XS, I_CACHE, I_SWIN, I_SGDN, I_SGCONV, I_SFCONV, I_PTAB, I_PP, I_PS, I_WIN, I_PE, I_PHI, I_GCW, I_ALOG, I_DTB, I_GNW, I_WOUT, I_LNG, I_LNB, I_WUP, I_FCW, I_WDN, I_WPJ, I_WGT };

namespace pg8 {
struct EpiIn {
    static constexpr bool PERM = true, AFTER_DRAIN = false;
    bf16_t* H; float* HS; float* kvp; float* kvs;
    __device__ __forceinline__ void operator()(const f32x4 (&acc)[2][2][4][2], const Unit& u, int wr, int wc, int fr, int fq) const {
        const int row0 = u.pm * BM + wr * 64 + fr, col0 = u.pn * BM + wc * 32 + 8 * fq;
        const bool iskv = (u.pn == 2 || u.pn == 3), issm = (u.pn == 13);
#pragma unroll
        for (int ai = 0; ai < 2; ++ai)
#pragma unroll
            for (int m = 0; m < 4; ++m) { const int r = row0 + ai * HALF + m * 16;
#pragma unroll
                for (int bj = 0; bj < 2; ++bj) { const int c = col0 + bj * HALF; const f32x4 v0 = acc[ai][bj][m][0], v1 = acc[ai][bj][m][1];
                    u32x4 w; w.x = cvt_pk_bf16(v0[0], v0[1]); w.y = cvt_pk_bf16(v0[2], v0[3]); w.z = cvt_pk_bf16(v1[0], v1[1]); w.w = cvt_pk_bf16(v1[2], v1[3]);
                    *(u32x4*)(H + (size_t)r * HW + c) = w;
                    if (iskv) { float* dst = nullptr; if (r < MPR) dst = kvp + (size_t)r * 512 + (c - HKV); else if (r < MTOT) dst = kvs + (size_t)(r - MPR) * 512 + (c - HKV);
                        if (dst) { *(f32x4*)dst = v0; *(f32x4*)(dst + 4) = v1; } }
                    if (issm && (c - HSM) < 64) { float* dst = HS + (size_t)r * 64 + (c - HSM); *(f32x4*)dst = v0; *(f32x4*)(dst + 4) = v1; } } }
    }
};
struct EpiRes {
    static constexpr bool PERM = false, AFTER_DRAIN = false;
    const float* XF; float* T1;
    __device__ __forceinline__ void operator()(const f32x4 (&acc)[2][2][4][2], const Unit& u, int wr, int wc, int fr, int fq) const {
        const int row0 = u.pm * BM + wr * 64 + fr, col0 = u.pn * BM + wc * 32 + 4 * fq;
#pragma unroll
        for (int ai = 0; ai < 2; ++ai)
#pragma unroll
            for (int m = 0; m < 4; ++m) { const size_t off = (size_t)(row0 + ai * HALF + m * 16) * DM + col0;
#pragma unroll
                for (int bj = 0; bj < 2; ++bj)
#pragma unroll
                    for (int n = 0; n < 2; ++n) { const size_t o = off + bj * HALF + n * 16; const f32x4 xv = *(const f32x4*)(XF + o); *(f32x4*)(T1 + o) = xv * DN_ALPHA + acc[ai][bj][m][n]; } }
    }
};
struct EpiGate {
    static constexpr bool PERM = false, AFTER_DRAIN = false;
    const float* XF; const float* PP; float* T1;
    __device__ __forceinline__ void operator()(const f32x4 (&acc)[2][2][4][2], const Unit& u, int wr, int wc, int fr, int fq) const {
        const int row0 = u.pm * BM + wr * 64 + fr, col0 = u.pn * BM + wc * 32 + 4 * fq;
#pragma unroll
        for (int ai = 0; ai < 2; ++ai)
#pragma unroll
            for (int m = 0; m < 4; ++m) { const size_t off = (size_t)(row0 + ai * HALF + m * 16) * DM + col0;
#pragma unroll
                for (int bj = 0; bj < 2; ++bj)
#pragma unroll
                    for (int n = 0; n < 2; ++n) { const size_t o = off + bj * HALF + n * 16; const f32x4 xv = *(const f32x4*)(XF + o), pv = *(const f32x4*)(PP + o); const f32x4 a = acc[ai][bj][m][n]; f32x4 s;
#pragma unroll
                        for (int j = 0; j < 4; ++j) s[j] = 1.0f / (1.0f + __expf(-a[j]));
                        *(f32x4*)(T1 + o) = xv * DN_ALPHA + s * pv; } }
    }
};
struct EpiF32 {
    static constexpr bool PERM = false, AFTER_DRAIN = false;
    float* C; int ldc;
    __device__ __forceinline__ void operator()(const f32x4 (&acc)[2][2][4][2], const Unit& u, int wr, int wc, int fr, int fq) const {
        const int row0 = u.pm * BM + wr * 64 + fr, col0 = u.pn * BM + wc * 32 + 4 * fq;
#pragma unroll
        for (int ai = 0; ai < 2; ++ai)
#pragma unroll
            for (int m = 0; m < 4; ++m) { float* rowp = C + (size_t)(row0 + ai * HALF + m * 16) * ldc + col0;
#pragma unroll
                for (int bj = 0; bj < 2; ++bj)
#pragma unroll
                    for (int n = 0; n < 2; ++n) *(f32x4*)(rowp + bj * HALF + n * 16) = acc[ai][bj][m][n]; }
    }
};
}

struct Ctx { int tid, lane, wave, bid, G; LAS unsigned char* lds; unsigned* ctl; const LAS unsigned* la; };
#define GAS __attribute__((address_space(1)))
__device__ __forceinline__ const void* ld_ptr(const LAS unsigned* p0) { const volatile LAS unsigned* p = p0;
    const unsigned lo = (unsigned)__builtin_amdgcn_readfirstlane((int)p[0]), hi = (unsigned)__builtin_amdgcn_readfirstlane((int)p[1]);
    return (const void*)(const GAS void*)(uintptr_t)(((unsigned long long)hi << 32) | lo); }
__device__ __forceinline__ int hw_lane() { int ln; asm volatile("v_mbcnt_lo_u32_b32 %0, -1, 0\n\tv_mbcnt_hi_u32_b32 %0, -1, %0" : "=v"(ln)); return ln; }
__device__ __forceinline__ Ctx relaunder(const Ctx& c0) { Ctx c = c0; int w = c0.wave; asm volatile("" : "+s"(w) :: "memory"); int ln = hw_lane(); asm volatile("" : "+v"(ln) :: "memory"); c.wave = w; c.lane = ln; c.tid = w * 64 + ln; int b = c0.bid; asm volatile("" : "+s"(b) :: "memory"); c.bid = b; return c; }
#define AIN(i) ld_ptr(c.la + 2 * (i))
#define AOUT ((float*)ld_ptr(c.la + 50))
#define AWS ((unsigned char*)ld_ptr(c.la + 52))
#define AIN_DBL (__builtin_amdgcn_readfirstlane((int)((const volatile LAS unsigned*)c.la)[56]))

__device__ __forceinline__ int in_colmap(int n) {
    if (n < HGQKV) return n;
    if (n < HGZ) return 1304 + (n - HGQKV);
    if (n < HSM) return 2856 + (n - HGZ);
    if (n < HSM + 24) return 1280 + (n - HSM);
    if (n < HSM + 32) return 2840 + (n - HSM - 24);
    if (n < HSM + 40) return 2848 + (n - HSM - 32);
    return -1;
}
__device__ __forceinline__ void p0_prologue(const Ctx& c0) {
    const Ctx c = relaunder(c0);
    LAS float* tile = (LAS float*)c.lds;
    constexpr int T_IN = (HW / 64) * (DM / 64), T_OUT = 16 * 16, T_UP = (UPW / 64) * 16, T_DN = 16 * (DFF / 64), T_GT = 256, T_PJ = 16 * (PLED / 64);
    constexpr int T_L = T_IN + T_OUT + T_UP + T_DN + T_GT + T_PJ;
    for (int it = c.bid; it < 2 * T_L; it += c.G) {
        const int l = it / T_L; int r = it % T_L;
        const float* W; bf16* WT; int K, Ns, mode = 0;
        if (r < T_IN) { W = (const float*)AIN(I_WIN) + (size_t)l * DM * INW; K = DM; Ns = INW; WT = (bf16*)(AWS + WS_WIN) + (size_t)l * HW * DM; mode = 1; }
        else if ((r -= T_IN) < T_OUT) { W = (const float*)AIN(I_WOUT) + (size_t)l * DM * DM; K = DM; Ns = DM; WT = (bf16*)(AWS + WS_WOUT) + (size_t)l * DM * DM; }
        else if ((r -= T_OUT) < T_UP) { W = (const float*)AIN(I_WUP) + (size_t)l * DM * UPW; K = DM; Ns = UPW; WT = (bf16*)(AWS + WS_WUP) + (size_t)l * UPW * DM; }
        else if ((r -= T_UP) < T_DN) { W = (const float*)AIN(I_WDN) + (size_t)l * DFF * DM; K = DFF; Ns = DM; WT = (bf16*)(AWS + WS_WDN) + (size_t)l * DM * DFF; }
        else if ((r -= T_DN) < T_GT) { W = (const float*)AIN(I_WGT) + (size_t)l * DM * DM; K = DM; Ns = DM; WT = (bf16*)(AWS + WS_WGT) + (size_t)l * DM * DM; }
        else { r -= T_GT; W = (const float*)AIN(I_WPJ) + (size_t)l * PLED * DM; K = PLED; Ns = DM; WT = (bf16*)(AWS + WS_WPJ) + (size_t)l * DM * PLED; }
        const int nk = K / 64, tn = r / nk, tk = r % nk, n0 = tn * 64, k0 = tk * 64;
        { const int nn = c.tid & 63; const int nd = n0 + nn; const int sc = mode ? in_colmap(nd) : nd;
#pragma unroll
          for (int q = 0; q < 8; ++q) { const int kk = q * 8 + (c.tid >> 6); tile[kk * 65 + nn] = (sc >= 0) ? W[(size_t)(k0 + kk) * Ns + sc] : 0.f; } }
        __syncthreads();
        { const int n = c.tid >> 3, kc = (c.tid & 7) * 8; const LAS float* s = tile + kc * 65 + n;
          u32x4 o; o.x = pk2(s[0], s[65]); o.y = pk2(s[2 * 65], s[3 * 65]); o.z = pk2(s[4 * 65], s[5 * 65]); o.w = pk2(s[6 * 65], s[7 * 65]);
          *(u32x4*)(WT + (size_t)(n0 + n) * K + k0 + kc) = o; }
        __syncthreads();
    }
    const size_t gt = (size_t)c.bid * 512 + c.tid, GT = (size_t)c.G * 512;
    { float* XF = (float*)(AWS + WS_XF); bf16* XB = (bf16*)(AWS + WS_XB); const float* xp = (const float*)AIN(I_XP); const float* xs = (const float*)AIN(I_XS);
      for (size_t i = gt; i < (size_t)MPAD * DM / 4; i += GT) { const size_t e = i * 4; const size_t row = e / DM;
          f32x4 v = (f32x4){0.f, 0.f, 0.f, 0.f};
          if (row < (size_t)MPR) v = *(const f32x4*)(xp + e); else if (row < (size_t)MTOT) v = *(const f32x4*)(xs + (e - (size_t)MPR * DM));
          *(f32x4*)(XF + e) = v; u32x2 w; w.x = pk2(v[0], v[1]); w.y = pk2(v[2], v[3]); *(u32x2*)(XB + e) = w; } }
    for (int l = 0; l < 2; ++l) { bf16* PB = (bf16*)(AWS + WS_PB) + (size_t)l * MPAD * PLED; const float* pp = (const float*)AIN(I_PP) + (size_t)l * MPR * PLED; const float* ps = (const float*)AIN(I_PS) + (size_t)l * DB * PLED;
      for (size_t i = gt; i < (size_t)MPAD * PLED / 4; i += GT) { const size_t e = i * 4; const size_t row = e / PLED;
          f32x4 v = (f32x4){0.f, 0.f, 0.f, 0.f};
          if (row < (size_t)MPR) v = *(const f32x4*)(pp + e); else if (row < (size_t)MTOT) v = *(const f32x4*)(ps + (e - (size_t)MPR * PLED));
          u32x2 w; w.x = pk2(v[0], v[1]); w.y = pk2(v[2], v[3]); *(u32x2*)(PB + e) = w; } }
}

__device__ __forceinline__ float ldT(const bf16* p) { return bf2f(*p); }
__device__ __forceinline__ float ldT(const float* p) { return *p; }
__device__ __forceinline__ void qk4(const bf16* kp, const LAS float* qbuf, float (&dot)[4]) {
    dot[0] = dot[1] = dot[2] = dot[3] = 0.f;
#pragma unroll 2
    for (int cch = 0; cch < 8; ++cch) { const u32x4 w = *(const u32x4*)(kp + cch * 8);
#pragma unroll
        for (int j = 0; j < 4; ++j) { const unsigned ww = w[j]; const float k0 = __uint_as_float(ww << 16), k1 = __uint_as_float(ww & 0xffff0000u);
            const f32x4 q0 = *(const LAS f32x4*)(qbuf + (cch * 8 + j * 2) * 4), q1 = *(const LAS f32x4*)(qbuf + (cch * 8 + j * 2 + 1) * 4);
#pragma unroll
            for (int g = 0; g < 4; ++g) dot[g] += k0 * q0[g] + k1 * q1[g]; } }
}
__device__ __forceinline__ void qk4(const float* kp, const LAS float* qbuf, float (&dot)[4]) {
    dot[0] = dot[1] = dot[2] = dot[3] = 0.f;
#pragma unroll 4
    for (int cch = 0; cch < 16; ++cch) { const f32x4 w = *(const f32x4*)(kp + cch * 4);
#pragma unroll
        for (int j = 0; j < 4; ++j) { const f32x4 q0 = *(const LAS f32x4*)(qbuf + (cch * 4 + j) * 4);
#pragma unroll
            for (int g = 0; g < 4; ++g) dot[g] += w[j] * q0[g]; } }
}
template <typename T>
__device__ __forceinline__ void pv4(const T* vp_lane, const LAS float* pbuf, int lane, float (&o)[4]) {
    const unsigned long long pv = (unsigned long long)(uintptr_t)vp_lane; const int lo = (int)(unsigned)pv, hi = (int)(unsigned)(pv >> 32);
#pragma unroll 16
    for (int j = 0; j < 64; ++j) {
        const unsigned l2 = (unsigned)__builtin_amdgcn_readlane(lo, j), h2 = (unsigned)__builtin_amdgcn_readlane(hi, j);
        const T* vp = (const T*)(uintptr_t)(((unsigned long long)h2 << 32) | l2);
        const float v = ldT(vp + lane); const f32x4 p = *(const LAS f32x4*)(pbuf + j * 4);
#pragma unroll
        for (int g = 0; g < 4; ++g) o[g] += p[g] * v;
    }
}
struct OSm { float m[4], l[4], o[4]; };
__device__ __forceinline__ void os_init(OSm& s) {
#pragma unroll
    for (int g = 0; g < 4; ++g) { s.m[g] = NEGV; s.l[g] = 0.f; s.o[g] = 0.f; } }
template <typename T>
__device__ __forceinline__ void attend_block(OSm& st, const T* kp, const T* vp, bool valid, float dist, const LAS float* qbuf, LAS float* pbuf, int lane, const float (&slope)[4]) {
    float dot[4]; qk4(kp, qbuf, dot);
    f32x4 p; float c8 = 0.125f; asm volatile("" : "+v"(c8));
#pragma unroll
    for (int g = 0; g < 4; ++g) { const float s = valid ? (dot[g] * c8 - slope[g] * dist) : NEGV;
        const float mn = fmaxf(st.m[g], wave_max(s)); const float pg = valid ? __expf(s - mn) : 0.f; const float corr = __expf(st.m[g] - mn);
        st.l[g] = st.l[g] * corr + wave_sum(pg); st.o[g] *= corr; st.m[g] = mn; p[g] = pg; }
    *(LAS f32x4*)(pbuf + lane * 4) = p; wave_lds_sync();
    pv4(vp, pbuf, lane, st.o);
    wave_lds_sync();
}
__device__ __forceinline__ unsigned long long select_blocks(const LAS float* impbuf, int lane, int cur) {
    const bool excl = lane > cur; const bool forced = (lane == 0) || (lane == cur) || (lane + 1 == cur);
    const float imp = impbuf[2 * lane] + impbuf[2 * lane + 1];
    const float sc = excl ? -__builtin_inff() : (forced ? __builtin_inff() : imp);
    int cnt = 0; const int sci = __float_as_int(sc);
#pragma unroll 8
    for (int i = 0; i < 64; ++i) { const float si = __int_as_float(__builtin_amdgcn_readlane(sci, i)); cnt += ((si > sc) || (si == sc && i < lane)) ? 1 : 0; }
    return __ballot(!excl && cnt < 16);
}

__device__ __forceinline__ void nsa_item(const Ctx& c, int l, bool sample, int row  , int b, int t, int n, LAS float* wl, int lane) {
    LAS float* qbuf = wl; LAS float* pbuf = wl + 256; LAS float* impbuf = wl + 512;
    const bf16* H = (const bf16*)(AWS + WS_H); const float* HS = (const float*)(AWS + WS_HS);
    float slope[4];
#pragma unroll
    for (int g = 0; g < 4; ++g) slope[g] = exp2f(-(float)(n * 4 + g + 1));
    { f32x4 qv;
#pragma unroll
      for (int g = 0; g < 4; ++g) qv[g] = bf2f(H[(size_t)row * HW + HQ + (n * 4 + g) * 64 + lane]);
      wave_lds_sync(); *(LAS f32x4*)(qbuf + lane * 4) = qv; wave_lds_sync(); }
    const float tp = (float)t;
    const int ncb = sample ? 1 : 2;
    const float* KC = sample ? (const float*)(AWS + WS_KCS) + (size_t)b * 64 * 128 : (const float*)(AWS + WS_KCP) + (size_t)b * 128 * 128;
    const float* VC = sample ? (const float*)(AWS + WS_VCS) + (size_t)b * 64 * 128 : (const float*)(AWS + WS_VCP) + (size_t)b * 128 * 128;
    float sc[2][4]; bool cv[2];
#pragma unroll
    for (int blk = 0; blk < 2; ++blk) { const int cidx = blk * 64 + lane; cv[blk] = (blk < ncb) && (32 * cidx + 31 <= t);
        float dot[4] = {0.f, 0.f, 0.f, 0.f};
        if (blk < ncb) qk4(KC + ((size_t)cidx * 2 + n) * 64, qbuf, dot);
        const float dist = tp - (32.f * (float)cidx + 15.5f);
#pragma unroll
        for (int g = 0; g < 4; ++g) sc[blk][g] = cv[blk] ? (dot[g] * 0.125f - slope[g] * dist) : NEGV; }
    float ocmp[4] = {0.f, 0.f, 0.f, 0.f};
    { f32x4 p0, p1; float i0 = 0.f, i1 = 0.f;
#pragma unroll
      for (int g = 0; g < 4; ++g) { const float mx = wave_max(fmaxf(sc[0][g], sc[1][g]));
          const float e0 = cv[0] ? __expf(sc[0][g] - mx) : 0.f, e1 = cv[1] ? __expf(sc[1][g] - mx) : 0.f; const float sum = wave_sum(e0 + e1); const float inv = sum > 0.f ? 1.0f / sum : 0.f;
          p0[g] = e0 * inv; p1[g] = e1 * inv; i0 += p0[g]; i1 += p1[g]; }
      impbuf[lane] = i0; impbuf[64 + lane] = i1;
      *(LAS f32x4*)(pbuf + lane * 4) = p0; wave_lds_sync();
      pv4(VC + ((size_t)lane * 2 + n) * 64, pbuf, lane, ocmp); wave_lds_sync();
      if (ncb > 1) { *(LAS f32x4*)(pbuf + lane * 4) = p1; wave_lds_sync(); pv4(VC + ((size_t)(64 + lane) * 2 + n) * 64, pbuf, lane, ocmp); wave_lds_sync(); } }
    const int cur = t >> 6;
    unsigned long long mask = select_blocks(impbuf, lane, cur);
    OSm ss; os_init(ss);
    if (!sample) {
        while (mask) { const int j = __builtin_ctzll(mask); mask &= mask - 1;
            const int pos = j * 64 + lane; const bf16* kp = H + (size_t)(b * SEQ + pos) * HW + HKV + 256 + n * 64;
            attend_block<bf16>(ss, kp, kp + 128, pos <= t, (float)(t - pos), qbuf, pbuf, lane, slope); }
    } else {
        const int* ptab = (const int*)AIN(I_PTAB); const float* cache = (const float*)AIN(I_CACHE) + (size_t)l * NPOOL * 128 * 512;
        while (mask) { const int j = __builtin_ctzll(mask); mask &= mask - 1;
            if (j < 32) { const int page = ptab[b * NPG + (j >> 1)]; const float* kp = cache + ((size_t)page * 128 + (j & 1) * 64 + lane) * 512 + 256 + n * 64;
                attend_block<float>(ss, kp, kp + 128, true, (float)(t - (j * 64 + lane)), qbuf, pbuf, lane, slope); }
            else { const bf16* kp = H + (size_t)row * HW + HKV + 256 + n * 64; attend_block<bf16>(ss, kp, kp + 128, lane == 0, 0.f, qbuf, pbuf, lane, slope); } }
    }
    OSm sw; os_init(sw);
    if (!sample) {
        for (int blk = 0; blk < 8; ++blk) { const int p0 = t - 511 + blk * 64; if (p0 + 63 < 0) continue;
            const int pos = p0 + lane; const int pc = pos < 0 ? 0 : pos; const bf16* kp = H + (size_t)(b * SEQ + pc) * HW + HWIN + n * 64;
            attend_block<bf16>(sw, kp, kp + 128, pos >= 0, (float)(t - pos), qbuf, pbuf, lane, slope); }
    } else {
        const float* wst = (const float*)AIN(I_SWIN) + ((size_t)l * DB + b) * 512 * 256;
        for (int blk = 0; blk < 8; ++blk) { const int i = 1 + blk * 64 + lane; const int ic = i > 511 ? 511 : i; const float* kp = wst + (size_t)ic * 256 + n * 64;
            attend_block<float>(sw, kp, kp + 128, i <= 511, (float)(512 - i), qbuf, pbuf, lane, slope); }
        const bf16* kp = H + (size_t)row * HW + HWIN + n * 64; attend_block<bf16>(sw, kp, kp + 128, lane == 0, 0.f, qbuf, pbuf, lane, slope);
    }
    bf16* MIX = (bf16*)(AWS + WS_MIX);
#pragma unroll
    for (int g = 0; g < 4; ++g) { const int hq = n * 4 + g; const float* gp = HS + (size_t)row * 64 + hq * 3;
        const float g0 = sigmoidf_(gp[0]), g1 = sigmoidf_(gp[1]), g2 = sigmoidf_(gp[2]);
        const float osl = ss.l[g] > 0.f ? ss.o[g] / ss.l[g] : 0.f, owi = sw.l[g] > 0.f ? sw.o[g] / sw.l[g] : 0.f;
        MIX[(size_t)row * DM + hq * 64 + lane] = (bf16)f2bf(g0 * ocmp[g] + g1 * osl + g2 * owi); }
}

__device__ __forceinline__ void gdn_steps(const Ctx& c, int l, int row0, int nsteps, int hh, float (&S)[64], LAS float* wl, int lane) {
    const float* GQ = (const float*)(AWS + WS_GQ); const float* GK = (const float*)(AWS + WS_GK); const float* GV = (const float*)(AWS + WS_GV);
    const float* SC = (const float*)(AWS + WS_SC);
    const bf16* H = (const bf16*)(AWS + WS_H); bf16* MIX = (bf16*)(AWS + WS_MIX);
    const float nw = ((const float*)AIN(I_GNW))[l * 64 + lane];
    LAS float* kb = wl; LAS float* qb = wl + 64;
    size_t o = (size_t)row0 * 512 + hh * 64 + lane;
    float nk = GK[o], nq = GQ[o], nv = GV[o], ng = SC[((size_t)row0 * 8 + hh) * 4], nb = SC[((size_t)row0 * 8 + hh) * 4 + 1], nz = bf2f(H[(size_t)row0 * HW + HGZ + hh * 64 + lane]);
    for (int s = 0; s < nsteps; ++s) {
        const int m = row0 + s;
        const float kv = nk, qv = nq, vv = nv, gv = ng, bv = nb, zv = nz;
        if (s + 1 < nsteps) { const size_t o2 = (size_t)(m + 1) * 512 + hh * 64 + lane;
            nk = GK[o2]; nq = GQ[o2]; nv = GV[o2]; ng = SC[((size_t)(m + 1) * 8 + hh) * 4]; nb = SC[((size_t)(m + 1) * 8 + hh) * 4 + 1]; nz = bf2f(H[(size_t)(m + 1) * HW + HGZ + hh * 64 + lane]); }
        wave_lds_sync(); kb[lane] = kv; qb[lane] = qv; wave_lds_sync();
        const float al = gv;
        float u0 = 0.f, u1 = 0.f, u2 = 0.f, u3 = 0.f;
#pragma unroll
        for (int d = 0; d < 64; d += 4) { const f32x4 k4 = *(const LAS f32x4*)(kb + d); u0 += k4[0] * S[d]; u1 += k4[1] * S[d + 1]; u2 += k4[2] * S[d + 2]; u3 += k4[3] * S[d + 3]; }
        const float u = (u0 + u1) + (u2 + u3);
        const float w = bv * (vv - al * u);
        float o0 = 0.f, o1 = 0.f, o2 = 0.f, o3 = 0.f;
#pragma unroll
        for (int d = 0; d < 64; d += 4) { const f32x4 k4 = *(const LAS f32x4*)(kb + d); const f32x4 q4 = *(const LAS f32x4*)(qb + d);
            S[d] = al * S[d] + k4[0] * w; S[d + 1] = al * S[d + 1] + k4[1] * w; S[d + 2] = al * S[d + 2] + k4[2] * w; S[d + 3] = al * S[d + 3] + k4[3] * w;
            o0 += q4[0] * S[d]; o1 += q4[1] * S[d + 1]; o2 += q4[2] * S[d + 2]; o3 += q4[3] * S[d + 3]; }
        const float ov = (o0 + o1) + (o2 + o3);
        const float ms = wave_sum(ov * ov) * (1.f / 64.f);
        MIX[(size_t)m * DM + 512 + hh * 64 + lane] = (bf16)f2bf(ov * rsqrtf(ms + RMS_EPS) * nw * siluf_(zv));
    }
}

__device__ __forceinline__ float quad_sum(float v) {
    const float t = v + __int_as_float(__builtin_amdgcn_mov_dpp(__float_as_int(v), 0xB1, 0xF, 0xF, true));
    return t + __int_as_float(__builtin_amdgcn_mov_dpp(__float_as_int(t), 0x4E, 0xF, 0xF, true));
}
constexpr int GC_NS = 16, GC_KQ = 0, GC_SC = GC_NS * 128, GC_V = GC_SC + GC_NS * 4, GC_BUF = GC_V + GC_NS * 16;
typedef float f32x2 __attribute__((ext_vector_type(2)));
__device__ __forceinline__ void gdn_chain4(const Ctx& c, int l, int b, int hh, int wq, LAS float* st, int lane) {
    const float* GQ = (const float*)(AWS + WS_GQ); const float* GK = (const float*)(AWS + WS_GK); const float* GV = (const float*)(AWS + WS_GV); const float* SC = (const float*)(AWS + WS_SC);
    float* OG = (float*)(AWS + WS_OG);
    const int j = lane & 3, ec = lane >> 2, e = wq * 16 + ec;
    const size_t row0 = (size_t)b * SEQ;
    f32x2 S2[8];
#pragma unroll
    for (int i = 0; i < 8; ++i) S2[i] = (f32x2){0.f, 0.f};
    f32x4 kq[8], scv, vv;
    const int w31 = lane & 31;
    const float* kqsrc = ((w31 < 16) ? GK : GQ) + hh * 64 + 4 * (w31 & 15);
    float* ogp = OG + (row0 + j) * 512 + hh * 64 + e;
#define GC_GLOAD(s0_) do { _Pragma("unroll") for (int x = 0; x < 8; ++x) kq[x] = *(const f32x4*)(kqsrc + (row0 + (s0_) + 2 * x + (lane >> 5)) * 512); \
        scv = *(const f32x4*)(SC + ((row0 + (s0_) + (lane & 15)) * 8 + hh) * 4); vv = *(const f32x4*)(GV + (row0 + (s0_) + (lane >> 2)) * 512 + hh * 64 + wq * 16 + 4 * (lane & 3)); } while (0)
#define GC_LSTORE(buf_) do { LAS float* bb_ = st + (buf_) * GC_BUF; _Pragma("unroll") for (int x = 0; x < 8; ++x) *(LAS f32x4*)(bb_ + GC_KQ + (2 * x + (lane >> 5)) * 128 + 4 * w31) = kq[x]; \
        if (lane < 16) *(LAS f32x4*)(bb_ + GC_SC + lane * 4) = scv; *(LAS f32x4*)(bb_ + GC_V + (lane >> 2) * 16 + 4 * (lane & 3)) = vv; } while (0)
    GC_GLOAD(0); GC_LSTORE(0);
    for (int s0 = 0; s0 < SEQ; s0 += GC_NS) {
        const int buf = (s0 >> 4) & 1; const bool more = s0 + GC_NS < SEQ;
        if (more) GC_GLOAD(s0 + GC_NS);
        wave_lds_sync();
        const LAS float* bb = st + buf * GC_BUF;
        float osel = 0.f;
        f32x4 kA[4], qA[4], kB[4], qB[4], scA, scB; float vA, vB;
#define GC_RD(K_, Q_, SC_, V_, sp_) do { const LAS float* kr_ = bb + GC_KQ + (sp_) * 128 + 16 * j; _Pragma("unroll") for (int i = 0; i < 4; ++i) { K_[i] = *(const LAS f32x4*)(kr_ + 4 * i); Q_[i] = *(const LAS f32x4*)(kr_ + 64 + 4 * i); } \
            SC_ = *(const LAS f32x4*)(bb + GC_SC + (sp_) * 4); V_ = bb[GC_V + (sp_) * 16 + ec]; } while (0)
#define GC_STEP(K_, Q_, SC_, V_, sp_) do { \
            f32x2 k2[8], q2[8]; _Pragma("unroll") for (int i = 0; i < 4; ++i) { k2[2 * i] = (f32x2){K_[i][0], K_[i][1]}; k2[2 * i + 1] = (f32x2){K_[i][2], K_[i][3]}; q2[2 * i] = (f32x2){Q_[i][0], Q_[i][1]}; q2[2 * i + 1] = (f32x2){Q_[i][2], Q_[i][3]}; } \
            const float al = SC_[0]; const f32x2 al2 = (f32x2){al, al}; \
            f32x2 ua = k2[0] * S2[0], ub = k2[1] * S2[1], uc = k2[2] * S2[2], ud = k2[3] * S2[3]; \
            ua = k2[4] * S2[4] + ua; ub = k2[5] * S2[5] + ub; uc = k2[6] * S2[6] + uc; ud = k2[7] * S2[7] + ud; \
            f32x2 ra = q2[0] * S2[0], rb = q2[1] * S2[1], rc = q2[2] * S2[2], rd = q2[3] * S2[3]; \
            ra = q2[4] * S2[4] + ra; rb = q2[5] * S2[5] + rb; rc = q2[6] * S2[6] + rc; rd = q2[7] * S2[7] + rd; \
            f32x2 aS[8]; _Pragma("unroll") for (int i = 0; i < 8; ++i) aS[i] = al2 * S2[i]; \
            const f32x2 us = (ua + ub) + (uc + ud); const float u = quad_sum(us[0] + us[1]); \
            const float w = SC_[1] * (V_ - al * u); const f32x2 w2 = (f32x2){w, w}; \
            _Pragma("unroll") for (int i = 0; i < 8; ++i) S2[i] = k2[i] * w2 + aS[i]; \
            const f32x2 rs = (ra + rb) + (rc + rd); const float r = quad_sum(rs[0] + rs[1]); \
            const float o = fmaf(al, r, SC_[2] * w); \
            osel = (((sp_) & 3) == j) ? o : osel; \
            if (((sp_) & 3) == 3) ogp[(size_t)(s0 + ((sp_) & ~3)) * 512] = osel; asm volatile("" :: "v"(SC_[3]));   } while (0)
        GC_RD(kA, qA, scA, vA, 0);
#pragma unroll
        for (int sp = 0; sp < GC_NS; sp += 2) {
            GC_RD(kB, qB, scB, vB, sp + 1); __builtin_amdgcn_sched_barrier(0);
            GC_STEP(kA, qA, scA, vA, sp); __builtin_amdgcn_sched_barrier(0);
            if (sp + 2 < GC_NS) { GC_RD(kA, qA, scA, vA, sp + 2); } __builtin_amdgcn_sched_barrier(0);
            GC_STEP(kB, qB, scB, vB, sp + 1); __builtin_amdgcn_sched_barrier(0);
        }
#undef GC_RD
#undef GC_STEP
        if (more) GC_LSTORE(buf ^ 1);
    }
#undef GC_GLOAD
#undef GC_LSTORE
    float* o = AOUT + O_GSP + (((size_t)l * 4 + b) * 8 + hh) * 4096;
#pragma unroll
    for (int i = 0; i < 8; ++i) { o[(16 * j + 2 * i) * 64 + e] = S2[i][0]; o[(16 * j + 2 * i + 1) * 64 + e] = S2[i][1]; }
}
__device__ __forceinline__ void sample_combine(const Ctx& c, int l, int bn, int lane);
__device__ __forceinline__ void p4b_gdn_norm(const Ctx& c0, int l) {
    const Ctx c = relaunder(c0);
    const int gw = c.bid * 8 + c.wave, NGW = c.G * 8, lane = c.lane;
    const float* OG = (const float*)(AWS + WS_OG); const bf16* H = (const bf16*)(AWS + WS_H); bf16* MIX = (bf16*)(AWS + WS_MIX);
    const float nw = ((const float*)AIN(I_GNW))[l * 64 + lane];
    for (int bn = gw; bn < DB * 2; bn += NGW) sample_combine(c, l, bn, lane);
    for (int it = gw; it < MPR * 8; it += NGW) { const int hh = it & 7, m = it >> 3;
        const float ov = OG[(size_t)m * 512 + hh * 64 + lane]; const float zv = bf2f(H[(size_t)m * HW + HGZ + hh * 64 + lane]);
        const float ms = wave_sum(ov * ov) * (1.f / 64.f);
        MIX[(size_t)m * DM + 512 + hh * 64 + lane] = (bf16)f2bf(ov * rsqrtf(ms + RMS_EPS) * nw * siluf_(zv)); }
}
__device__ __forceinline__ void gdn_item_prompt(const Ctx& c, int l, int b, int hh, LAS float* wl, int lane) {
    float S[64];
#pragma unroll
    for (int d = 0; d < 64; ++d) S[d] = 0.f;
    gdn_steps(c, l, b * SEQ, SEQ, hh, S, wl, lane);
    float* o = AOUT + O_GSP + (((size_t)l * 4 + b) * 8 + hh) * 4096;
#pragma unroll
    for (int d = 0; d < 64; ++d) o[d * 64 + lane] = S[d];
}
__device__ __forceinline__ void gdn_item_sample(const Ctx& c, int l, int b, int hh, LAS float* wl, int lane) {
    const float* s0 = (const float*)AIN(I_SGDN) + (((size_t)l * DB + b) * 8 + hh) * 4096;
    float S[64];
#pragma unroll
    for (int d = 0; d < 64; ++d) S[d] = s0[d * 64 + lane];
    gdn_steps(c, l, MPR + b, 1, hh, S, wl, lane);
    float* o = AOUT + O_GSS + (((size_t)l * DB + b) * 8 + hh) * 4096;
#pragma unroll
    for (int d = 0; d < 64; ++d) o[d * 64 + lane] = S[d];
}

typedef short bf16x8v __attribute__((ext_vector_type(8)));
typedef float f32x16 __attribute__((ext_vector_type(16)));
typedef short s16x4v __attribute__((ext_vector_type(4)));
typedef float f32x2v_ __attribute__((ext_vector_type(2))); typedef __bf16 bf16x2v_ __attribute__((ext_vector_type(2)));
__device__ __forceinline__ unsigned cvtpk(float lo, float hi) { f32x2v_ v = {lo, hi}; bf16x2v_ b = __builtin_convertvector(v, bf16x2v_); return __builtin_bit_cast(unsigned, b); }
__device__ __forceinline__ int crow(int r, int hi) { return (r & 3) + 8 * (r >> 2) + 4 * hi; }
constexpr int NL_KS = 0, NL_VS = 16384, NL_IMP = 32768, NL_IMPB = 4 * 64 * 65 * 4, NL_MASK = NL_IMP + NL_IMPB, NL_WSF = NL_MASK + 512, NL_END = NL_WSF + 8 * 256;
static_assert(NL_END <= RING_BYTES && CTLB + RING_BYTES <= LDS_BYTES, "nsa unit LDS");
constexpr float LOG2E = 1.4426950408889634f, C2S = 0.125f * 1.4426950408889634f, MCLAMP = -1.0e4f, SNEG = -1.0e30f;
struct NsaSm { float m, l; f32x16 o0, o1; };
__device__ __forceinline__ float rowmax32(const f32x16& p0, const f32x16& p1) {
    float a = fmaxf(fmaxf(p0[0], p0[1]), p1[0]), b = fmaxf(fmaxf(p0[2], p0[3]), p1[1]); a = fmaxf(fmaxf(a, p1[2]), p1[3]);
#pragma unroll
    for (int r = 4; r < 16; r += 4) { a = fmaxf(fmaxf(a, p0[r]), p0[r + 1]); b = fmaxf(fmaxf(b, p0[r + 2]), p0[r + 3]); a = fmaxf(fmaxf(a, p1[r]), p1[r + 1]); b = fmaxf(fmaxf(b, p1[r + 2]), p1[r + 3]); }
    const float m = fmaxf(a, b);
    auto rr = __builtin_amdgcn_permlane32_swap(__float_as_uint(m), __float_as_uint(m), false, false);
    return fmaxf(__uint_as_float(rr[0]), __uint_as_float(rr[1]));
}
__device__ __forceinline__ float halves_sum(float v) { auto rr = __builtin_amdgcn_permlane32_swap(__float_as_uint(v), __float_as_uint(v), false, false); return __uint_as_float(rr[0]) + __uint_as_float(rr[1]); }
__device__ __forceinline__ void nsa_qk(f32x16& p0, f32x16& p1, const LAS unsigned char* kslot, const bf16x8v (&qr)[4], int r32, int hi) {
    const LAS unsigned char* kb = kslot + hi * 1024 + r32 * 16;
    f32x16 z;
#pragma unroll
    for (int r = 0; r < 16; ++r) z[r] = 0.f;
    p0 = z; p1 = z;
#pragma unroll
    for (int d0 = 0; d0 < 4; ++d0) { const bf16x8v b0 = *(const LAS bf16x8v*)(kb + d0 * 2048), b1 = *(const LAS bf16x8v*)(kb + d0 * 2048 + 512);
        p0 = __builtin_amdgcn_mfma_f32_32x32x16_bf16(b0, qr[d0], p0, 0, 0, 0); p1 = __builtin_amdgcn_mfma_f32_32x32x16_bf16(b1, qr[d0], p1, 0, 0, 0); }
}
__device__ __forceinline__ void nsa_scores(f32x16& p0, f32x16& p1, float Ap, float slk, int thrp, bool flip) {
#pragma unroll
    for (int r = 0; r < 16; ++r) { const int cr = (r & 3) + 8 * (r >> 2);
        const bool v0 = (cr <= thrp) != flip, v1 = (cr + 32 <= thrp) != flip;
        p0[r] = v0 ? fmaf(p0[r], C2S, fmaf(slk, (float)cr, Ap)) : SNEG; p1[r] = v1 ? fmaf(p1[r], C2S, fmaf(slk, (float)(cr + 32), Ap)) : SNEG; }
}
__device__ __forceinline__ void nsa_pv(f32x16& o0, f32x16& o1, const f32x16& p0, const f32x16& p1, const LAS unsigned char* vslot, int lane, int hi) {
    u32x4 pw[4];
#pragma unroll
    for (int k = 0; k < 4; ++k) { pw[0][k] = cvtpk(p0[2 * k], p0[2 * k + 1]); pw[1][k] = cvtpk(p0[8 + 2 * k], p0[9 + 2 * k]); pw[2][k] = cvtpk(p1[2 * k], p1[2 * k + 1]); pw[3][k] = cvtpk(p1[8 + 2 * k], p1[9 + 2 * k]); }
    const LAS unsigned char* vp = vslot + ((lane >> 4) & 1) * 32 + (lane & 3) * 8 + (4 * hi + ((lane & 15) >> 2)) * 64;
#pragma unroll
    for (int ks = 0; ks < 4; ++ks) {
        const s16x4v a0 = __builtin_bit_cast(s16x4v, __builtin_amdgcn_ds_read_tr16_b64_v4i16((LAS s16x4v*)(vp + ks * 1024)));
        const s16x4v a1 = __builtin_bit_cast(s16x4v, __builtin_amdgcn_ds_read_tr16_b64_v4i16((LAS s16x4v*)(vp + ks * 1024 + 512)));
        const s16x4v b0 = __builtin_bit_cast(s16x4v, __builtin_amdgcn_ds_read_tr16_b64_v4i16((LAS s16x4v*)(vp + 4096 + ks * 1024)));
        const s16x4v b1 = __builtin_bit_cast(s16x4v, __builtin_amdgcn_ds_read_tr16_b64_v4i16((LAS s16x4v*)(vp + 4096 + ks * 1024 + 512)));
        const bf16x8v va = {a0[0], a0[1], a0[2], a0[3], a1[0], a1[1], a1[2], a1[3]}, vb = {b0[0], b0[1], b0[2], b0[3], b1[0], b1[1], b1[2], b1[3]};
        const bf16x8v pa = __builtin_bit_cast(bf16x8v, pw[ks]);
        o0 = __builtin_amdgcn_mfma_f32_32x32x16_bf16(pa, va, o0, 0, 0, 0); o1 = __builtin_amdgcn_mfma_f32_32x32x16_bf16(pa, vb, o1, 0, 0, 0); }
}
__device__ __forceinline__ void nsa_softmax_pv(NsaSm& st, f32x16& p0, f32x16& p1, const LAS unsigned char* vslot, LAS float* wsf, int lane, int r32, int hi) {
    const float rm = rowmax32(p0, p1); const float mn = fmaxf(st.m, rm); const float f = __builtin_amdgcn_exp2f(st.m - mn); st.m = mn;
    float s = 0.f;
#pragma unroll
    for (int r = 0; r < 16; ++r) { p0[r] = __builtin_amdgcn_exp2f(p0[r] - mn); p1[r] = __builtin_amdgcn_exp2f(p1[r] - mn); s += p0[r] + p1[r]; }
    st.l = st.l * f + s;
    if (__any(f != 1.0f)) { wave_lds_sync(); if (hi == 0) wsf[r32] = f; wave_lds_sync();
#pragma unroll
        for (int r = 0; r < 16; ++r) { const float fr = wsf[crow(r, hi)]; st.o0[r] *= fr; st.o1[r] *= fr; } }
    nsa_pv(st.o0, st.o1, p0, p1, vslot, lane, hi);
}
__device__ __forceinline__ void nsa_sm_init(NsaSm& st) { st.m = MCLAMP; st.l = 0.f;
#pragma unroll
    for (int r = 0; r < 16; ++r) { st.o0[r] = 0.f; st.o1[r] = 0.f; } }
__device__ __forceinline__ void nsa_fold(f32x16& f0, f32x16& f1, const f32x16& o0, const f32x16& o1, float fac, LAS float* wsf, int r32, int hi) {
    wave_lds_sync(); if (hi == 0) wsf[r32] = fac; wave_lds_sync();
#pragma unroll
    for (int r = 0; r < 16; ++r) { const float fr = wsf[crow(r, hi)]; f0[r] += o0[r] * fr; f1[r] += o1[r] * fr; }
}
#define NSA_LOADT(kb_, vb_, pitch_) do { int ln_ = lane; asm volatile("" : "+v"(ln_));   \
        kreg = *(const u32x4*)((kb_) + (unsigned)(ln_ * (pitch_) + wid * 8)); vreg = *(const u32x4*)((vb_) + (unsigned)((16 * (wid & 3) + (ln_ >> 2)) * (pitch_) + (wid >> 2) * 32 + (ln_ & 3) * 8)); } while (0)
#define NSA_STORET(slot_) do { *(LAS u32x4*)(lds + NL_KS + (slot_) * 8192 + wid * 1024 + lane * 16) = kreg; *(LAS u32x4*)(lds + NL_VS + (slot_) * 8192 + wid * 1024 + lane * 16) = vreg; } while (0)
__device__ __forceinline__ void nsa_unit(const Ctx& c, int l, int b, int n, int qt) {
    LAS unsigned char* lds = c.lds; const int lane = c.lane, wid = c.wave, r32 = lane & 31, hi = lane >> 5, g = wid >> 1, th = wid & 1;
    const int tq = th * 32 + r32, t0 = qt * 64, t = t0 + tq, hq = n * 4 + g;
    const float sl2 = exp2f(-(float)(hq + 1)) * LOG2E;
    LAS float* wsf = (LAS float*)(lds + NL_WSF + wid * 256); LAS float* imp = (LAS float*)(lds + NL_IMP); LAS unsigned long long* maskb = (LAS unsigned long long*)(lds + NL_MASK);
    const bf16* H = (const bf16*)(AWS + WS_H); const float* HS = (const float*)(AWS + WS_HS);
    const size_t rowbase = (size_t)b * SEQ;
    bf16x8v qr[4];
#pragma unroll
    for (int d0 = 0; d0 < 4; ++d0) qr[d0] = *(const bf16x8v*)(H + (rowbase + t) * HW + HQ + hq * 64 + d0 * 16 + hi * 8);
    const float* gp = HS + (rowbase + t) * 64 + hq * 3;
    const float gate0 = sigmoidf_(gp[0]), gate1 = sigmoidf_(gp[1]), gate2 = sigmoidf_(gp[2]);
    u32x4 kreg, vreg;
    f32x16 of0, of1;
    {
        const bf16* KCb = (const bf16*)(AWS + WS_KCB) + ((size_t)b * 128 * 2 + n) * 64; const bf16* VCb = (const bf16*)(AWS + WS_VCB) + ((size_t)b * 128 * 2 + n) * 64;
        const bool two = (t0 + 63 >= 64 * 32 + 31);
        NSA_LOADT(KCb, VCb, 128); NSA_STORET(0);
        if (two) { NSA_LOADT(KCb + 64 * 128, VCb + 64 * 128, 128); NSA_STORET(1); }
        __syncthreads();
        const int kq = (t >= 31) ? ((t - 31) >> 5) : -1; const float slk = 32.f * sl2;
        f32x16 a0, a1, b0, b1;
        nsa_qk(a0, a1, lds + NL_KS, qr, r32, hi);
        nsa_scores(a0, a1, -sl2 * ((float)t - 15.5f) + slk * (float)(4 * hi), slk, kq - 4 * hi, false);
        if (two) { nsa_qk(b0, b1, lds + NL_KS + 8192, qr, r32, hi); nsa_scores(b0, b1, -sl2 * ((float)t - 15.5f - 2048.f) + slk * (float)(4 * hi), slk, kq - 64 - 4 * hi, false); }
        else {
#pragma unroll
            for (int r = 0; r < 16; ++r) { b0[r] = SNEG; b1[r] = SNEG; } }
        const float mx = fmaxf(MCLAMP, fmaxf(rowmax32(a0, a1), rowmax32(b0, b1)));
        float s = 0.f;
#pragma unroll
        for (int r = 0; r < 16; ++r) { a0[r] = __builtin_amdgcn_exp2f(a0[r] - mx); a1[r] = __builtin_amdgcn_exp2f(a1[r] - mx); b0[r] = __builtin_amdgcn_exp2f(b0[r] - mx); b1[r] = __builtin_amdgcn_exp2f(b1[r] - mx); s += (a0[r] + a1[r]) + (b0[r] + b1[r]); }
        const float ltot = halves_sum(s); const float inv = ltot > 0.f ? 1.0f / ltot : 0.f;
        { LAS float* ip = imp + (size_t)(g * 64 + tq) * 65 + 2 * hi;
#pragma unroll
          for (int r = 0; r < 16; r += 2) { const int jb = ((r & 3) >> 1) + 4 * (r >> 2);
              ip[jb] = (a0[r] + a0[r + 1]) * inv; ip[16 + jb] = (a1[r] + a1[r + 1]) * inv; ip[32 + jb] = (b0[r] + b0[r + 1]) * inv; ip[48 + jb] = (b1[r] + b1[r + 1]) * inv; } }
        f32x16 o0, o1;
#pragma unroll
        for (int r = 0; r < 16; ++r) { o0[r] = 0.f; o1[r] = 0.f; of0[r] = 0.f; of1[r] = 0.f; }
        nsa_pv(o0, o1, a0, a1, lds + NL_VS, lane, hi);
        if (two) nsa_pv(o0, o1, b0, b1, lds + NL_VS + 8192, lane, hi);
        nsa_fold(of0, of1, o0, o1, gate0 * inv, wsf, r32, hi);
    }
    __syncthreads();
    {
#pragma unroll 1
        for (int i = 0; i < 8; ++i) { const int q = wid * 8 + i;
            const float iv = ((imp[(size_t)(0 * 64 + q) * 65 + lane] + imp[(size_t)(1 * 64 + q) * 65 + lane]) + imp[(size_t)(2 * 64 + q) * 65 + lane]) + imp[(size_t)(3 * 64 + q) * 65 + lane];
            const bool excl = lane > qt; const bool forced = (lane == 0) || (lane == qt) || (lane + 1 == qt);
            const float sc = excl ? -__builtin_inff() : (forced ? __builtin_inff() : iv);
            int cnt = 0; const int sci = __float_as_int(sc);
#pragma unroll 8
            for (int k = 0; k < 64; ++k) { const float si = __int_as_float(__builtin_amdgcn_readlane(sci, k)); cnt += ((si > sc) || (si == sc && k < lane)) ? 1 : 0; }
            const unsigned long long mk = __ballot(!excl && cnt < 16);
            if (lane == 0) maskb[q] = mk; }
    }
    __syncthreads();
    const unsigned long long mq = maskb[tq];
    unsigned long long uni;
    { unsigned lo = (unsigned)maskb[lane], hi32 = (unsigned)(maskb[lane] >> 32);
#pragma unroll
      for (int o = 1; o < 64; o <<= 1) { lo |= (unsigned)__shfl_xor((int)lo, o); hi32 |= (unsigned)__shfl_xor((int)hi32, o); }
      uni = ((unsigned long long)(unsigned)__builtin_amdgcn_readfirstlane((int)hi32) << 32) | (unsigned)__builtin_amdgcn_readfirstlane((int)lo); }
    {
        NsaSm st; nsa_sm_init(st);
        const bf16* Kb = H + rowbase * HW + HKV + 256 + n * 64; const bf16* Vb = Kb + 128;
        unsigned long long rem = uni; int j = __builtin_ctzll(rem); rem &= rem - 1;
        NSA_LOADT(Kb + (size_t)j * 64 * HW, Vb + (size_t)j * 64 * HW, HW); NSA_STORET(0); __syncthreads();
        int cur = 0;
        for (;;) {
            const bool more = rem != 0ull; int jn = 0;
            if (more) { jn = __builtin_ctzll(rem); rem &= rem - 1; NSA_LOADT(Kb + (size_t)jn * 64 * HW, Vb + (size_t)jn * 64 * HW, HW); }
            f32x16 p0, p1;
            nsa_qk(p0, p1, lds + NL_KS + cur * 8192, qr, r32, hi);
            const bool sel = (mq >> j) & 1ull; const int thr = sel ? (j < qt ? 64 : tq) : -1;
            nsa_scores(p0, p1, -sl2 * (float)(t - 64 * j) + sl2 * (float)(4 * hi), sl2, thr - 4 * hi, false);
            nsa_softmax_pv(st, p0, p1, lds + NL_VS + cur * 8192, wsf, lane, r32, hi);
            if (more) NSA_STORET(cur ^ 1);
            __syncthreads();
            if (!more) break;
            cur ^= 1; j = jn;
        }
        const float ltot = halves_sum(st.l); nsa_fold(of0, of1, st.o0, st.o1, ltot > 0.f ? gate1 / ltot : 0.f, wsf, r32, hi);
    }
    {
        NsaSm st; nsa_sm_init(st);
        const bf16* Kb = H + rowbase * HW + HWIN + n * 64; const bf16* Vb = Kb + 128;
        const int klast = qt - 8 < 0 ? 0 : qt - 8;
        int kt = qt;
        NSA_LOADT(Kb + (size_t)kt * 64 * HW, Vb + (size_t)kt * 64 * HW, HW); NSA_STORET(0); __syncthreads();
        int cur = 0;
        for (;;) {
            const bool more = kt > klast;
            if (more) NSA_LOADT(Kb + (size_t)(kt - 1) * 64 * HW, Vb + (size_t)(kt - 1) * 64 * HW, HW);
            f32x16 p0, p1;
            nsa_qk(p0, p1, lds + NL_KS + cur * 8192, qr, r32, hi);
            const int dl = qt - kt; const bool flip = (dl == 8); const int thr = (dl == 0 || dl == 8) ? tq : 64;
            nsa_scores(p0, p1, -sl2 * (float)(64 * dl + tq) + sl2 * (float)(4 * hi), sl2, thr - 4 * hi, flip);
            nsa_softmax_pv(st, p0, p1, lds + NL_VS + cur * 8192, wsf, lane, r32, hi);
            if (more) NSA_STORET(cur ^ 1);
            __syncthreads();
            if (!more) break;
            cur ^= 1; --kt;
        }
        const float ltot = halves_sum(st.l); nsa_fold(of0, of1, st.o0, st.o1, ltot > 0.f ? gate2 / ltot : 0.f, wsf, r32, hi);
    }
    {
        LAS bf16* stg = (LAS bf16*)(lds + NL_IMP + wid * 4096);
#pragma unroll
        for (int r = 0; r < 16; ++r) { const int orow = crow(r, hi); stg[orow * 64 + r32] = (bf16)f2bf(of0[r]); stg[orow * 64 + 32 + r32] = (bf16)f2bf(of1[r]); }
        wave_lds_sync();
        bf16* MIX = (bf16*)(AWS + WS_MIX) + (rowbase + t0 + th * 32) * DM + hq * 64;
#pragma unroll
        for (int i = 0; i < 4; ++i) { const int row = i * 8 + (lane >> 3), ch = lane & 7; const u32x4 v = *(const LAS u32x4*)(stg + row * 64 + ch * 8); *(u32x4*)(MIX + (size_t)row * DM + ch * 8) = v; }
    }
    __syncthreads();
}

__device__ __forceinline__ void unpack8(const u32x4 w, float (&x)[8]) {
#pragma unroll
    for (int j = 0; j < 4; ++j) { x[2 * j] = __uint_as_float(w[j] << 16); x[2 * j + 1] = __uint_as_float(w[j] & 0xffff0000u); } }
__device__ __forceinline__ float xor4_sum(float v) { return v + __shfl_xor(v, 4); }
__device__ __forceinline__ float oct_sum(float v) { return xor4_sum(quad_sum(v)); }
__device__ __forceinline__ void p3_gdn_rows(const Ctx& c, int l, int rg, int lane) {
    const int m0 = rg * 8; const bool first = (m0 & (SEQ - 1)) == 0;
    const bf16* H = (const bf16*)(AWS + WS_H); const float* HS = (const float*)(AWS + WS_HS);
    const float* cw = (const float*)AIN(I_GCW) + (size_t)l * 4 * GQKV;
    float gq[8][8]; float qk[8];
#pragma unroll
    for (int j = 0; j < 3; ++j) {
        const int col0 = j * 512 + lane * 8;
        u32x4 xr[11];
#pragma unroll
        for (int r = 0; r < 11; ++r) { if (r < 3 && first) xr[r] = (u32x4){0u, 0u, 0u, 0u}; else xr[r] = *(const u32x4*)(H + (size_t)(m0 + r - 3) * HW + HGQKV + col0); }
        float w[4][8];
#pragma unroll
        for (int i = 0; i < 4; ++i) { const f32x4 a = *(const f32x4*)(cw + i * GQKV + col0), b = *(const f32x4*)(cw + i * GQKV + col0 + 4);
#pragma unroll
            for (int q = 0; q < 4; ++q) { w[i][q] = a[q]; w[i][4 + q] = b[q]; } }
        float* dst = (float*)(AWS + (j == 0 ? WS_GQ : (j == 1 ? WS_GK : WS_GV)));
#pragma unroll
        for (int r = 0; r < 8; ++r) {
            float x0[8], x1[8], x2[8], x3[8]; unpack8(xr[r], x0); unpack8(xr[r + 1], x1); unpack8(xr[r + 2], x2); unpack8(xr[r + 3], x3);
            float y[8]; float ss = 0.f;
#pragma unroll
            for (int q = 0; q < 8; ++q) { const float a = w[0][q] * x0[q] + w[1][q] * x1[q] + w[2][q] * x2[q] + w[3][q] * x3[q]; y[q] = siluf_(a); ss += y[q] * y[q]; }
            if (j < 2) { const float sc = rsqrtf(oct_sum(ss) + RMS_EPS) * (j == 0 ? 0.125f : 1.0f);
#pragma unroll
                for (int q = 0; q < 8; ++q) y[q] *= sc; }
            if (j == 0) {
#pragma unroll
                for (int q = 0; q < 8; ++q) gq[r][q] = y[q]; }
            if (j == 1) { float d = 0.f;
#pragma unroll
                for (int q = 0; q < 8; ++q) d += gq[r][q] * y[q];
                qk[r] = oct_sum(d); }
            float* o = dst + (size_t)(m0 + r) * 512 + lane * 8;
            *(f32x4*)o = (f32x4){y[0], y[1], y[2], y[3]}; *(f32x4*)(o + 4) = (f32x4){y[4], y[5], y[6], y[7]};
        }
    }
    { const int hh = lane >> 3; const float al = -__expf(((const float*)AIN(I_ALOG))[l * 8 + hh]), dt = ((const float*)AIN(I_DTB))[l * 8 + hh];
      float* SC = (float*)(AWS + WS_SC);
#pragma unroll
      for (int r = 0; r < 8; ++r) { const float ai = HS[(size_t)(m0 + r) * 64 + 24 + hh], bi = HS[(size_t)(m0 + r) * 64 + 32 + hh];
          if ((lane & 7) == 0) *(f32x4*)(SC + ((size_t)(m0 + r) * 8 + hh) * 4) = (f32x4){__expf(al * softplusf_(ai + dt)), sigmoidf_(bi), qk[r], 0.f}; } }
}
__device__ __forceinline__ void p3_gdn_sample(const Ctx& c, int l, int it, int lane) {
    const int hh = it & 7, b = it >> 3, m = MPR + b;
    const bf16* H = (const bf16*)(AWS + WS_H); const float* HS = (const float*)(AWS + WS_HS);
    const float* cw = (const float*)AIN(I_GCW) + (size_t)l * 4 * GQKV; const float* sgc = (const float*)AIN(I_SGCONV) + (size_t)l * DB * 3 * GQKV;
    float y[3];
#pragma unroll
    for (int j = 0; j < 3; ++j) { const int cc = j * 512 + hh * 64 + lane;
        float acc = cw[3 * GQKV + cc] * bf2f(H[(size_t)m * HW + HGQKV + cc]);
#pragma unroll
        for (int i = 0; i < 3; ++i) acc += cw[i * GQKV + cc] * sgc[((size_t)b * 3 + i) * GQKV + cc];
        y[j] = siluf_(acc); }
    const float sq = wave_sum(y[0] * y[0]), sk = wave_sum(y[1] * y[1]);
    const size_t o = (size_t)m * 512 + hh * 64 + lane;
    const float gq = y[0] * rsqrtf(sq + RMS_EPS) * 0.125f, gk = y[1] * rsqrtf(sk + RMS_EPS);
    ((float*)(AWS + WS_GQ))[o] = gq; ((float*)(AWS + WS_GK))[o] = gk; ((float*)(AWS + WS_GV))[o] = y[2];
    const float qk = wave_sum(gq * gk);
    if (lane == 0) { const float ai = HS[(size_t)m * 64 + 24 + hh], bi = HS[(size_t)m * 64 + 32 + hh];
        const float gg = -__expf(((const float*)AIN(I_ALOG))[l * 8 + hh]) * softplusf_(ai + ((const float*)AIN(I_DTB))[l * 8 + hh]);
        *(f32x4*)((float*)(AWS + WS_SC) + ((size_t)m * 8 + hh) * 4) = (f32x4){__expf(gg), sigmoidf_(bi), qk, 0.f}; }
}
#define P3_MATVEC(o_, mean_, PHIEXPR_) do { _Pragma("unroll") for (int g_ = 0; g_ < 4; ++g_) o_[g_] = 0.f; \
        _Pragma("unroll 4") for (int d4 = 0; d4 < 16; ++d4) { f32x4 mv[4]; _Pragma("unroll") for (int g_ = 0; g_ < 4; ++g_) mv[g_] = *(const LAS f32x4*)((mean_) + g_ * 64 + 4 * d4); \
            _Pragma("unroll") for (int q_ = 0; q_ < 4; ++q_) { const int d = 4 * d4 + q_; const float p0 = PHIEXPR_(0, d), p1 = PHIEXPR_(1, d); \
                o_[0] += mv[0][q_] * p0; o_[1] += mv[1][q_] * p0; o_[2] += mv[2][q_] * p1; o_[3] += mv[3][q_] * p1; } } } while (0)
__device__ __forceinline__ void p3_cmp_prompt(const Ctx& c, int l, int it, LAS float* meanb, int lane) {
    const int cb = it & 127, b = it >> 7;
    const bf16* H = (const bf16*)(AWS + WS_H);
    const float* pe = (const float*)AIN(I_PE) + (size_t)l * 2 * 32 * 64; const float* phi = (const float*)AIN(I_PHI) + (size_t)l * 2 * 64 * 64;
    const int type = lane >> 5, d0 = (lane & 15) * 4;
    f32x4 acc = (f32x4){0.f, 0.f, 0.f, 0.f};
    u32x2 xr[32];
#pragma unroll
    for (int i = 0; i < 32; ++i) xr[i] = *(const u32x2*)(H + (size_t)(b * SEQ + cb * 32 + i) * HW + HKV + lane * 4);
#pragma unroll
    for (int i = 0; i < 32; ++i) { const f32x4 pv = *(const f32x4*)(pe + (type * 32 + i) * 64 + d0);
        acc[0] += __uint_as_float(xr[i].x << 16) + pv[0]; acc[1] += __uint_as_float(xr[i].x & 0xffff0000u) + pv[1]; acc[2] += __uint_as_float(xr[i].y << 16) + pv[2]; acc[3] += __uint_as_float(xr[i].y & 0xffff0000u) + pv[3]; }
    wave_lds_sync(); *(LAS f32x4*)(meanb + lane * 4) = acc * (1.f / 32.f); wave_lds_sync();
    float o[4];
#define PHIG(t_, d_) phi[((t_) * 64 + (d_)) * 64 + lane]
    P3_MATVEC(o, meanb, PHIG);
#undef PHIG
    bf16* KCB = (bf16*)(AWS + WS_KCB); bf16* VCB = (bf16*)(AWS + WS_VCB); const size_t ob = ((size_t)(b * 128 + cb) * 2) * 64 + lane;
    KCB[ob] = (bf16)f2bf(o[0]); KCB[ob + 64] = (bf16)f2bf(o[1]); VCB[ob] = (bf16)f2bf(o[2]); VCB[ob + 64] = (bf16)f2bf(o[3]);
}
__device__ __forceinline__ void p3_copy_chunk(const Ctx& c, int l, int kind, int chunk, int lane) {
    const bf16* H = (const bf16*)(AWS + WS_H);
    const int nun = kind == 0 ? DB * 512 : (kind == 1 ? 4 * 512 : (kind == 2 ? DB * 3 * 6 : 4 * 3 * 6));
    float* dstb = AOUT + (kind == 0 ? O_WINS + (size_t)l * DB * 512 * 256 : (kind == 1 ? O_WINP + (size_t)l * 4 * 512 * 256 : (kind == 2 ? O_GCS + (size_t)l * DB * 3 * GQKV : O_GCP + (size_t)l * 4 * 3 * GQKV)));
    const float* sw = (const float*)AIN(I_SWIN) + (size_t)l * DB * 512 * 256; const float* sgc = (const float*)AIN(I_SGCONV) + (size_t)l * DB * 3 * GQKV;
    f32x4 v[8];
#pragma unroll 1
    for (int h8 = 0; h8 < 4; ++h8) {
#pragma unroll
        for (int i = 0; i < 8; ++i) { const int u = chunk * 32 + h8 * 8 + i; v[i] = (f32x4){0.f, 0.f, 0.f, 0.f};
            if (u < nun) {
                const float* fs = nullptr; const bf16* bs = nullptr;
                if (kind == 0) { const int r = u & 511, b = u >> 9; if (r < 511) fs = sw + (size_t)(u + 1) * 256; else bs = H + (size_t)(MPR + b) * HW + HWIN; }
                else if (kind == 1) { const int r = u & 511, b = u >> 9; bs = H + (size_t)(b * SEQ + SEQ - 512 + r) * HW + HWIN; }
                else if (kind == 2) { const int seg = u % 6, row = u / 6, r = row % 3, b = row / 3; if (r < 2) fs = sgc + ((size_t)b * 3 + r + 1) * GQKV + seg * 256; else bs = H + (size_t)(MPR + b) * HW + HGQKV + seg * 256; }
                else { const int seg = u % 6, row = u / 6, r = row % 3, b = row / 3; bs = H + (size_t)(b * SEQ + SEQ - 3 + r) * HW + HGQKV + seg * 256; }
                if (fs) v[i] = *(const f32x4*)(fs + lane * 4);
                else { const u32x2 w = *(const u32x2*)(bs + lane * 4); v[i] = (f32x4){__uint_as_float(w.x << 16), __uint_as_float(w.x & 0xffff0000u), __uint_as_float(w.y << 16), __uint_as_float(w.y & 0xffff0000u)}; } } }
#pragma unroll
        for (int i = 0; i < 8; ++i) { const int u = chunk * 32 + h8 * 8 + i; if (u < nun) *(f32x4*)(dstb + (size_t)u * 256 + lane * 4) = v[i]; }
    }
}
constexpr int P3L_KC = 0, P3L_VC = 64 * 2 * 65 * 4, P3L_PHI = 2 * P3L_VC, P3L_MEAN = P3L_PHI + 32768, P3L_WV = P3L_MEAN + 8 * 1024, P3L_END = P3L_WV + 2 * 4096;
static_assert(P3L_END <= RING_BYTES, "p3 LDS");
__device__ __forceinline__ void p3_sample_seq(const Ctx& c, int l, int b) {
    LAS unsigned char* lds = c.lds; const int lane = c.lane, wid = c.wave;
    LAS float* KCl = (LAS float*)(lds + P3L_KC); LAS float* VCl = (LAS float*)(lds + P3L_VC); LAS float* PHI = (LAS float*)(lds + P3L_PHI); LAS float* meanb = (LAS float*)(lds + P3L_MEAN + wid * 1024);
    const float* pe = (const float*)AIN(I_PE) + (size_t)l * 2 * 32 * 64; const float* phi = (const float*)AIN(I_PHI) + (size_t)l * 2 * 64 * 64;
    const int* ptab = (const int*)AIN(I_PTAB); const float* cache = (const float*)AIN(I_CACHE) + (size_t)l * NPOOL * 128 * 512;
    for (int i = c.tid; i < 2048; i += 512) *(LAS f32x4*)(PHI + 4 * i) = *(const f32x4*)(phi + 4 * i);
    const int type = lane >> 5, d0 = (lane & 15) * 4;
    f32x4 pes = (f32x4){0.f, 0.f, 0.f, 0.f};
#pragma unroll 8
    for (int i = 0; i < 32; ++i) pes += *(const f32x4*)(pe + (type * 32 + i) * 64 + d0);
    __syncthreads();
#pragma unroll 1
    for (int cb = wid; cb < 64; cb += 8) {
        const int page = ptab[b * NPG + (cb >> 2)]; const float* src = cache + ((size_t)page * 128 + (cb & 3) * 32) * 512 + lane * 4;
        f32x4 acc = pes;
#pragma unroll 1
        for (int h = 0; h < 2; ++h) { f32x4 xr[16];
#pragma unroll
            for (int i = 0; i < 16; ++i) xr[i] = *(const f32x4*)(src + (size_t)(h * 16 + i) * 512);
#pragma unroll
            for (int i = 0; i < 16; ++i) acc += xr[i]; }
        wave_lds_sync(); *(LAS f32x4*)(meanb + lane * 4) = acc * (1.f / 32.f); wave_lds_sync();
        float o[4];
#define PHIL(t_, d_) PHI[((t_) * 64 + (d_)) * 64 + lane]
        P3_MATVEC(o, meanb, PHIL);
#undef PHIL
        KCl[(cb * 2 + 0) * 65 + lane] = o[0]; KCl[(cb * 2 + 1) * 65 + lane] = o[1]; VCl[(cb * 2 + 0) * 65 + lane] = o[2]; VCl[(cb * 2 + 1) * 65 + lane] = o[3];
    }
    __syncthreads();
    if (wid < 2) {
        const int n = wid, row = MPR + b; LAS float* wl = (LAS float*)(lds + P3L_WV + wid * 4096); LAS float* qbuf = wl; LAS float* pbuf = wl + 256; LAS float* impbuf = wl + 512;
        const bf16* H = (const bf16*)(AWS + WS_H);
        { f32x4 qv;
#pragma unroll
          for (int g = 0; g < 4; ++g) qv[g] = bf2f(H[(size_t)row * HW + HQ + (n * 4 + g) * 64 + lane]);
          *(LAS f32x4*)(qbuf + lane * 4) = qv; wave_lds_sync(); }
        float dot[4] = {0.f, 0.f, 0.f, 0.f}; const LAS float* kr = KCl + (lane * 2 + n) * 65;
#pragma unroll 8
        for (int d = 0; d < 64; ++d) { const float kv = kr[d]; const f32x4 q4 = *(const LAS f32x4*)(qbuf + d * 4);
#pragma unroll
            for (int g = 0; g < 4; ++g) dot[g] += kv * q4[g]; }
        const float dist = (float)PASTL - (32.f * (float)lane + 15.5f);
        f32x4 p; float imp = 0.f;
        float c8 = 0.125f; asm volatile("" : "+v"(c8));
#pragma unroll
        for (int g = 0; g < 4; ++g) { const float sv = dot[g] * c8 - exp2f(-(float)(n * 4 + g + 1)) * dist; const float mx = wave_max(sv); const float e = __expf(sv - mx); const float sum = wave_sum(e); p[g] = e / sum; imp += p[g]; }
        impbuf[lane] = imp; impbuf[64 + lane] = 0.f; *(LAS f32x4*)(pbuf + lane * 4) = p; wave_lds_sync();
        const unsigned long long mask = select_blocks(impbuf, lane, PASTL >> 6);
        float o[4] = {0.f, 0.f, 0.f, 0.f};
#pragma unroll 8
        for (int cc = 0; cc < 64; ++cc) { const float vv = VCl[(cc * 2 + n) * 65 + lane]; const f32x4 pc = *(const LAS f32x4*)(pbuf + cc * 4);
#pragma unroll
            for (int g = 0; g < 4; ++g) o[g] += pc[g] * vv; }
        if (lane == 0) ((unsigned long long*)(AWS + WS_SMASK))[b * 2 + n] = mask;
        float* oc = (float*)(AWS + WS_OCMP) + (size_t)(b * 2 + n) * 256;
#pragma unroll
        for (int g = 0; g < 4; ++g) oc[g * 64 + lane] = o[g];
    }
    __syncthreads();
}
__device__ __forceinline__ void p3_prep(const Ctx& c0, int l, int rep = 0) {
    const Ctx c = relaunder(c0);
    const int lane = c.lane;
    for (int b = c.bid; b < DB; b += c.G) p3_sample_seq(c, l, b);
    constexpr int N_A = MPR / 8, N_B = DB * 8, N_C = 4 * 128, N_D0 = DB * 512 / 32, N_D1 = 4 * 512 / 32, N_D2 = (DB * 3 * 6 + 31) / 32, N_D3 = (4 * 3 * 6 + 31) / 32;
    constexpr int E_A = N_A, E_B = E_A + N_B, E_C = E_B + N_C, E_D0 = E_C + N_D0, E_D1 = E_D0 + N_D1, E_D2 = E_D1 + N_D2, E_D3 = E_D2 + N_D3;
    unsigned* head = c.ctl + (l ? CW_P1 : CW_P0) + rep * 1024;
    LAS float* meanb = (LAS float*)(c.lds + c.wave * 4096);
    for (;;) {
        unsigned base = 0;
        if (lane == 0) base = __hip_atomic_fetch_add(head, 2u, __ATOMIC_RELAXED, __HIP_MEMORY_SCOPE_AGENT);
        base = (unsigned)__builtin_amdgcn_readfirstlane((int)base);
        if (base >= (unsigned)E_D3) break;
#pragma unroll 1
        for (int k = 0; k < 2; ++k) { const int it = (int)base + k; if (it >= E_D3) break;
            if (it < E_A) p3_gdn_rows(c, l, it, lane);
            else if (it < E_B) p3_gdn_sample(c, l, it - E_A, lane);
            else if (it < E_C) p3_cmp_prompt(c, l, it - E_B, meanb, lane);
            else if (it < E_D0) p3_copy_chunk(c, l, 0, it - E_C, lane);
            else if (it < E_D1) p3_copy_chunk(c, l, 1, it - E_D0, lane);
            else if (it < E_D2) p3_copy_chunk(c, l, 2, it - E_D1, lane);
            else p3_copy_chunk(c, l, 3, it - E_D2, lane); }
    }
}
__device__ __forceinline__ void sample_part(const Ctx& c, int l, int it, LAS float* wl, int lane) {
    const int p = it % 25, bn = it / 25, n = bn & 1, b = bn >> 1, row = MPR + b;
    LAS float* qbuf = wl; LAS float* pbuf = wl + 256;
    const bf16* H = (const bf16*)(AWS + WS_H);
    float slope[4];
#pragma unroll
    for (int g = 0; g < 4; ++g) slope[g] = exp2f(-(float)(n * 4 + g + 1));
    { f32x4 qv;
#pragma unroll
      for (int g = 0; g < 4; ++g) qv[g] = bf2f(H[(size_t)row * HW + HQ + (n * 4 + g) * 64 + lane]);
      wave_lds_sync(); *(LAS f32x4*)(qbuf + lane * 4) = qv; wave_lds_sync(); }
    OSm st; os_init(st);
    bool active = true, isb = false, valid = true; float dist = 0.f; const float* kpf = nullptr; const bf16* kpb = nullptr;
    if (p < 16) {
        const unsigned long long* mp = (const unsigned long long*)(AWS + WS_SMASK) + bn; unsigned long long mask = *mp;
        mask = ((unsigned long long)(unsigned)__builtin_amdgcn_readfirstlane((int)(unsigned)(mask >> 32)) << 32) | (unsigned)__builtin_amdgcn_readfirstlane((int)(unsigned)mask);
        for (int k = 0; k < p; ++k) mask &= mask - 1;
        if (!mask) active = false;
        else { const int j = __builtin_ctzll(mask);
            if (j < 32) { const int page = ((const int*)AIN(I_PTAB))[b * NPG + (j >> 1)]; kpf = (const float*)AIN(I_CACHE) + (size_t)l * NPOOL * 128 * 512 + ((size_t)page * 128 + (j & 1) * 64 + lane) * 512 + 256 + n * 64; dist = (float)(PASTL - (j * 64 + lane)); }
            else { isb = true; kpb = H + (size_t)row * HW + HKV + 256 + n * 64; valid = (lane == 0); } }
    } else if (p < 24) {
        const int i = 1 + (p - 16) * 64 + lane; const int ic = i > 511 ? 511 : i;
        kpf = (const float*)AIN(I_SWIN) + ((size_t)l * DB + b) * 512 * 256 + (size_t)ic * 256 + n * 64; valid = (i <= 511); dist = (float)(512 - i);
    } else { isb = true; kpb = H + (size_t)row * HW + HWIN + n * 64; valid = (lane == 0); }
    if (active) { if (isb) attend_block<bf16>(st, kpb, kpb + 128, valid, dist, qbuf, pbuf, lane, slope); else attend_block<float>(st, kpf, kpf + 128, valid, dist, qbuf, pbuf, lane, slope); }
    float* pt = (float*)(AWS + WS_PART) + (size_t)it * 264;
    if (lane == 0) { *(f32x4*)pt = (f32x4){st.m[0], st.m[1], st.m[2], st.m[3]}; *(f32x4*)(pt + 4) = (f32x4){st.l[0], st.l[1], st.l[2], st.l[3]}; }
#pragma unroll
    for (int g = 0; g < 4; ++g) pt[8 + g * 64 + lane] = st.o[g];
}
__device__ __forceinline__ void sample_combine(const Ctx& c, int l, int bn, int lane) {
    const int n = bn & 1, b = bn >> 1, row = MPR + b;
    const float* pt = (const float*)(AWS + WS_PART) + (size_t)bn * 25 * 264; const float* HS = (const float*)(AWS + WS_HS); const float* oc = (const float*)(AWS + WS_OCMP) + (size_t)bn * 256;
    float res[2][4];
#pragma unroll
    for (int br = 0; br < 2; ++br) { const int p0 = br ? 16 : 0, np = br ? 9 : 16;
        float M[4] = {NEGV, NEGV, NEGV, NEGV};
#pragma unroll 4
        for (int k = 0; k < np; ++k) { const f32x4 mv = *(const f32x4*)(pt + (size_t)(p0 + k) * 264);
#pragma unroll
            for (int g = 0; g < 4; ++g) M[g] = fmaxf(M[g], mv[g]); }
        float L[4] = {0.f, 0.f, 0.f, 0.f}, O[4] = {0.f, 0.f, 0.f, 0.f};
#pragma unroll 4
        for (int k = 0; k < np; ++k) { const float* pp = pt + (size_t)(p0 + k) * 264; const f32x4 mv = *(const f32x4*)pp, lv = *(const f32x4*)(pp + 4);
#pragma unroll
            for (int g = 0; g < 4; ++g) { const float f = __expf(mv[g] - M[g]); L[g] += lv[g] * f; O[g] += pp[8 + g * 64 + lane] * f; } }
#pragma unroll
        for (int g = 0; g < 4; ++g) res[br][g] = L[g] > 0.f ? O[g] / L[g] : 0.f; }
    bf16* MIX = (bf16*)(AWS + WS_MIX);
#pragma unroll
    for (int g = 0; g < 4; ++g) { const int hq = n * 4 + g; const float* gp = HS + (size_t)row * 64 + hq * 3;
        MIX[(size_t)row * DM + hq * 64 + lane] = (bf16)f2bf(sigmoidf_(gp[0]) * oc[g * 64 + lane] + sigmoidf_(gp[1]) * res[0][g] + sigmoidf_(gp[2]) * res[1][g]); }
}
__device__ __forceinline__ void p4_mixers(const Ctx& c0, int l, int rep = 0) {
    const Ctx c = relaunder(c0);
    LAS float* wl = (LAS float*)(c.lds + c.wave * 4096);
    const int lane = c.lane;
    if (!(rep && (AIN_DBL & 32))) {
        if (c.bid < 64 && c.wave < 2) { const int ci = c.bid * 2 + c.wave; gdn_chain4(c, l, ci >> 5, (ci >> 2) & 7, ci & 3, (LAS float*)(c.lds + 32768 + c.wave * 20480), lane); }
        else if (c.bid >= 64 || (c.wave & 2) != 0) {
            unsigned* head = c.ctl + (l ? CW_Q1 : CW_Q0) + rep * 1024;
            constexpr int N_GS = DB * 8, N_NS = DB * 2 * 25, N_ALL = N_GS + N_NS;
            for (;;) {
                unsigned it = 0;
                if (lane == 0) it = __hip_atomic_fetch_add(head, 1u, __ATOMIC_RELAXED, __HIP_MEMORY_SCOPE_AGENT);
                it = (unsigned)__builtin_amdgcn_readfirstlane((int)it);
                if (it >= (unsigned)N_ALL) break;
                if (it < (unsigned)N_NS) sample_part(c, l, (int)it, wl, lane);
                else { const int k = (int)it - N_NS; gdn_item_sample(c, l, k >> 3, k & 7, wl, lane); }
            }
        }
        __syncthreads();
    }
    {
        volatile LAS unsigned* slot = (volatile LAS unsigned*)(c.lds - CTLB + MISC_OFF + 64);
        for (;;) {
            if (c.wave == 0 && hw_lane() == 0) { unsigned* head = c.ctl + (l ? CW_U1 : CW_U0) + rep * 1024; *slot = __hip_atomic_fetch_add(head, 1u, __ATOMIC_RELAXED, __HIP_MEMORY_SCOPE_AGENT); }
            __syncthreads();
            const unsigned u = *slot;
            __syncthreads();
            if (u >= 512u) break;
            nsa_unit(c, l, (int)(u >> 1) & 3, (int)u & 1, 63 - (int)(u >> 3));
        }
    }
}

__device__ __forceinline__ void p_ln(const Ctx& c0, int l, int which, bool final_out) {
    const Ctx c = relaunder(c0);
    const int gw = c.bid * 8 + c.wave, NGW = c.G * 8, lane = c.lane;
    const float* T1 = (const float*)(AWS + WS_T1); float* XF = (float*)(AWS + WS_XF); bf16* XB = (bf16*)(AWS + WS_XB);
    const float* g = (const float*)AIN(I_LNG) + (size_t)(l * 3 + which) * DM; const float* bb = (const float*)AIN(I_LNB) + (size_t)(l * 3 + which) * DM;
    f32x4 gv[4], bv[4];
#pragma unroll
    for (int j = 0; j < 4; ++j) { gv[j] = *(const f32x4*)(g + lane * 4 + 256 * j); bv[j] = *(const f32x4*)(bb + lane * 4 + 256 * j); }
    for (int m = gw; m < MTOT; m += NGW) {
        const float* xr = T1 + (size_t)m * DM + lane * 4; f32x4 v[4]; float s = 0.f;
#pragma unroll
        for (int j = 0; j < 4; ++j) { v[j] = *(const f32x4*)(xr + 256 * j); s += (v[j][0] + v[j][1]) + (v[j][2] + v[j][3]); }
        const float mean = wave_sum(s) * (1.f / DM); float s2 = 0.f;
#pragma unroll
        for (int j = 0; j < 4; ++j) { v[j] = v[j] - mean; s2 += (v[j][0] * v[j][0] + v[j][1] * v[j][1]) + (v[j][2] * v[j][2] + v[j][3] * v[j][3]); }
        const float rstd = rsqrtf(wave_sum(s2) * (1.f / DM) + LN_EPS);
        float* of = final_out ? (m < MPR ? AOUT + O_YP + (size_t)m * DM : AOUT + O_YS + (size_t)(m - MPR) * DM) : XF + (size_t)m * DM;
#pragma unroll
        for (int j = 0; j < 4; ++j) { const f32x4 y = v[j] * rstd * gv[j] + bv[j]; *(f32x4*)(of + lane * 4 + 256 * j) = y;
            if (!final_out) { u32x2 w; w.x = pk2(y[0], y[1]); w.y = pk2(y[2], y[3]); *(u32x2*)(XB + (size_t)m * DM + lane * 4 + 256 * j) = w; } }
    }
}

__device__ __forceinline__ float gelu_erf(float x) { return 0.5f * x * (1.0f + erff(x * 0.70710678118654752f)); }
__device__ __forceinline__ void p8_act(const Ctx& c0, int l) {
    const Ctx c = relaunder(c0);
    const bf16* UP = (const bf16*)(AWS + WS_UP); bf16* ACT = (bf16*)(AWS + WS_ACT);
    const float* fw = (const float*)AIN(I_FCW) + (size_t)l * 3 * DFF; const float* sfc = (const float*)AIN(I_SFCONV) + (size_t)l * DB * 2 * DFF;
    const size_t gt = (size_t)c.bid * 512 + c.tid, GT = (size_t)c.G * 512;
    constexpr int CPR = DFF / 4;
    for (size_t i = gt; i < (size_t)MTOT * CPR; i += GT) { const int m = (int)(i / CPR), cc = (int)(i % CPR) * 4;
        const u32x2 u0 = *(const u32x2*)(UP + (size_t)m * UPW + cc); const u32x2 um = *(const u32x2*)(UP + (size_t)m * UPW + DFF + cc);
        float x0[4] = {__uint_as_float(u0.x << 16), __uint_as_float(u0.x & 0xffff0000u), __uint_as_float(u0.y << 16), __uint_as_float(u0.y & 0xffff0000u)};
        float mu[4] = {__uint_as_float(um.x << 16), __uint_as_float(um.x & 0xffff0000u), __uint_as_float(um.y << 16), __uint_as_float(um.y & 0xffff0000u)};
        float x1[4] = {0.f, 0.f, 0.f, 0.f}, x2[4] = {0.f, 0.f, 0.f, 0.f};
        if (m < MPR) { const int t = m & (SEQ - 1);
            if (t >= 1) { const u32x2 w = *(const u32x2*)(UP + (size_t)(m - 1) * UPW + cc); x1[0] = __uint_as_float(w.x << 16); x1[1] = __uint_as_float(w.x & 0xffff0000u); x1[2] = __uint_as_float(w.y << 16); x1[3] = __uint_as_float(w.y & 0xffff0000u); }
            if (t >= 2) { const u32x2 w = *(const u32x2*)(UP + (size_t)(m - 2) * UPW + cc); x2[0] = __uint_as_float(w.x << 16); x2[1] = __uint_as_float(w.x & 0xffff0000u); x2[2] = __uint_as_float(w.y << 16); x2[3] = __uint_as_float(w.y & 0xffff0000u); } }
        else { const int b = m - MPR; const f32x4 s0 = *(const f32x4*)(sfc + ((size_t)b * 2 + 0) * DFF + cc), s1 = *(const f32x4*)(sfc + ((size_t)b * 2 + 1) * DFF + cc);
#pragma unroll
            for (int j = 0; j < 4; ++j) { x2[j] = s0[j]; x1[j] = s1[j]; } }
        const f32x4 w0 = *(const f32x4*)(fw + cc), w1 = *(const f32x4*)(fw + DFF + cc), w2 = *(const f32x4*)(fw + 2 * DFF + cc);
        float r[4];
#pragma unroll
        for (int j = 0; j < 4; ++j) r[j] = gelu_erf(w0[j] * x2[j] + w1[j] * x1[j] + w2[j] * x0[j]) * mu[j];
        u32x2 w; w.x = pk2(r[0], r[1]); w.y = pk2(r[2], r[3]); *(u32x2*)(ACT + (size_t)m * DFF + cc) = w; }
    { float* o = AOUT + O_FCP + (size_t)l * 4 * 2 * DFF;
      for (size_t i = gt; i < (size_t)4 * 2 * DFF; i += GT) { const int cc = (int)(i % DFF), r = (int)(i / DFF) & 1, b = (int)(i / (2 * DFF)); o[i] = bf2f(UP[(size_t)(b * SEQ + SEQ - 2 + r) * UPW + cc]); } }
    { float* o = AOUT + O_FCS + (size_t)l * DB * 2 * DFF;
      for (size_t i = gt; i < (size_t)DB * 2 * DFF; i += GT) { const int cc = (int)(i % DFF), r = (int)(i / DFF) & 1, b = (int)(i / (2 * DFF)); o[i] = (r == 0) ? sfc[i + DFF] : bf2f(UP[(size_t)(MPR + b) * UPW + cc]); } }
}

constexpr int NPH = 2 + 2 * 12;
__global__ void __launch_bounds__(512, 2) fwd_kernel(Args a) {
    extern __shared__ __attribute__((aligned(16))) unsigned char lds_raw[];
    Ctx c; c.lds = (LAS unsigned char*)lds_raw + CTLB; LAS unsigned char* lctl = (LAS unsigned char*)lds_raw; c.tid = threadIdx.x; c.lane = c.tid & 63; c.wave = __builtin_amdgcn_readfirstlane(c.tid >> 6); c.bid = blockIdx.x; c.G = gridDim.x;
    volatile LAS unsigned* MISC = (volatile LAS unsigned*)(lctl + MISC_OFF);
    if (c.tid < CTLB / 4) ((LAS unsigned*)lctl)[c.tid] = 0u;
    __syncthreads();
    { const unsigned* ap = (const unsigned*)&a; LAS unsigned* la = (LAS unsigned*)(lctl + ARGS_OFF); if (c.tid < 58) la[c.tid] = ap[c.tid]; c.la = la; }
    __syncthreads();
    c.ctl = (unsigned*)(AWS + WS_CTL);
    XcdBarrier bar; bar.bar = c.ctl + CW_BAR; bar.x = 0; bar.st = nullptr; bar.w0 = (c.wave == 0);
    const int lo = a.ph_lo, hi = a.ph_hi, dbl = a.dbl;
    if (hi - lo > 1 || dbl) { bar = xcd_barrier_post(c.ctl + CW_BAR, MISC + 8); bar.w0 = (c.wave == 0); }
#define GEMM_CALL(...) do { for (int rp = 0; rp <= ((dbl >> 4) & 1); ++rp) { if (rp) xcd_barrier(bar); __VA_ARGS__; } } while (0)
#define IN(k) (lo <= (k) && (k) < hi)
#define SEAM(k) do { if (IN(k) && IN((k) + 1)) xcd_barrier(bar); } while (0)
    const Ctx cb = c;
    LAS unsigned char* ring = cb.lds;
    if (IN(0)) { p0_prologue(cb); } SEAM(0);
    if (IN(1)) {
        const Ctx c = relaunder(cb);
        for (int l = 0; l < 2; ++l) {
            pg8::Gemm g{(const pg8::bf16_t*)(AWS + WS_PB) + (size_t)l * MPAD * PLED, (const pg8::bf16_t*)(AWS + WS_WPJ) + (size_t)l * DM * PLED, MPAD, DM, PLED};
            pg8::StaticOrder S; S.init(MPAD, DM, c.G, c.bid); pg8::EpiF32 E{(float*)(AWS + WS_PP) + (size_t)l * MPAD * DM, DM};
            pg8::gemm_phase<pg8::EpiF32, pg8::StaticOrder, false, false>(ring, g, S, E, c.wave); }
    } SEAM(1);
    for (int l = 0; l < 2; ++l) {
        const int p = 2 + l * 12;
        const Ctx c = relaunder(cb);
        if (IN(p + 0)) {
            pg8::Gemm g{(const pg8::bf16_t*)(AWS + WS_XB), (const pg8::bf16_t*)(AWS + WS_WIN) + (size_t)l * HW * DM, MPAD, HW, DM};
            pg8::StaticOrder S; S.init(MPAD, HW, c.G, c.bid);
            pg8::EpiIn E{(pg8::bf16_t*)(AWS + WS_H), (float*)(AWS + WS_HS), AOUT + O_KVP + (size_t)l * MPR * 512, AOUT + O_KVS + (size_t)l * DB * 512};
            GEMM_CALL(pg8::gemm_phase<pg8::EpiIn, pg8::StaticOrder, false, false>(ring, g, S, E, c.wave));
        } SEAM(p + 0);
        if (IN(p + 1)) { for (int rp = 0; rp <= (dbl & 1); ++rp) { if (rp) xcd_barrier(bar); p3_prep(c, l, rp); } } SEAM(p + 1);
        if (IN(p + 2)) { for (int rp = 0; rp <= ((dbl >> 1) & 1); ++rp) { if (rp) xcd_barrier(bar); p4_mixers(c, l, rp); } } SEAM(p + 2);
        if (IN(p + 3)) { p4b_gdn_norm(c, l); } SEAM(p + 3);
        if (IN(p + 4)) {
            pg8::Gemm g{(const pg8::bf16_t*)(AWS + WS_MIX), (const pg8::bf16_t*)(AWS + WS_WOUT) + (size_t)l * DM * DM, MPAD, DM, DM};
            pg8::StaticOrder S; S.init(MPAD, DM, c.G, c.bid); pg8::EpiRes E{(const float*)(AWS + WS_XF), (float*)(AWS + WS_T1)};
            GEMM_CALL(pg8::gemm_phase<pg8::EpiRes, pg8::StaticOrder, false, false>(ring, g, S, E, c.wave));
        } SEAM(p + 4);
        if (IN(p + 5)) { for (int rp = 0; rp <= ((dbl >> 2) & 1); ++rp) { if (rp) xcd_barrier(bar); p_ln(c, l, 0, false); } } SEAM(p + 5);
        if (IN(p + 6)) {
            pg8::Gemm g{(const pg8::bf16_t*)(AWS + WS_XB), (const pg8::bf16_t*)(AWS + WS_WUP) + (size_t)l * UPW * DM, MPAD, UPW, DM};
            pg8::StaticOrder S; S.init(MPAD, UPW, c.G, c.bid); pg8::EpiBf16<0> E{(pg8::bf16_t*)(AWS + WS_UP), UPW, nullptr, 0, 0, 1.f};
            GEMM_CALL(pg8::gemm_phase<pg8::EpiBf16<0>, pg8::StaticOrder, false, false>(ring, g, S, E, c.wave));
        } SEAM(p + 6);
        if (IN(p + 7)) { for (int rp = 0; rp <= ((dbl >> 3) & 1); ++rp) { if (rp) xcd_barrier(bar); p8_act(c, l); } } SEAM(p + 7);
        if (IN(p + 8)) {
            pg8::Gemm g{(const pg8::bf16_t*)(AWS + WS_ACT), (const pg8::bf16_t*)(AWS + WS_WDN) + (size_t)l * DM * DFF, MPAD, DM, DFF};
            pg8::StaticOrder S; S.init(MPAD, DM, c.G, c.bid); pg8::EpiRes E{(const float*)(AWS + WS_XF), (float*)(AWS + WS_T1)};
            GEMM_CALL(pg8::gemm_phase<pg8::EpiRes, pg8::StaticOrder, false, false>(ring, g, S, E, c.wave));
        } SEAM(p + 8);
        if (IN(p + 9)) { p_ln(c, l, 1, false); } SEAM(p + 9);
        if (IN(p + 10)) {
            pg8::Gemm g{(const pg8::bf16_t*)(AWS + WS_XB), (const pg8::bf16_t*)(AWS + WS_WGT) + (size_t)l * DM * DM, MPAD, DM, DM};
            pg8::StaticOrder S; S.init(MPAD, DM, c.G, c.bid); pg8::EpiGate E{(const float*)(AWS + WS_XF), (const float*)(AWS + WS_PP) + (size_t)l * MPAD * DM, (float*)(AWS + WS_T1)};
            GEMM_CALL(pg8::gemm_phase<pg8::EpiGate, pg8::StaticOrder, false, false>(ring, g, S, E, c.wave));
        } SEAM(p + 10);
        if (IN(p + 11)) { p_ln(c, l, 2, l == 1); } SEAM(p + 11);
    }
#undef IN
#undef SEAM
}

extern "C" void kernel_launch(void* const* d_in, const int* in_sizes, int n_in, void* d_out, int out_size, void* d_ws, size_t ws_size, hipStream_t stream) {
    static int grid = 0;
    if (grid == 0) {
        if (n_in != 25 || (size_t)out_size != O_END || ws_size < WS_END) { fprintf(stderr, "kernel_launch: unexpected shapes (n_in %d out %d ws %zu)\n", n_in, out_size, ws_size); grid = -1; return; }
        int dev = 0, cus = 0;
        if (hipGetDevice(&dev) != hipSuccess || hipDeviceGetAttribute(&cus, hipDeviceAttributeMultiprocessorCount, dev) != hipSuccess) { grid = -1; return; }
        if (hipFuncSetAttribute((const void*)fwd_kernel, hipFuncAttributeMaxDynamicSharedMemorySize, LDS_BYTES) != hipSuccess) { fprintf(stderr, "kernel_launch: hipFuncSetAttribute failed\n"); grid = -1; return; }
        int per_cu = 0; (void)hipOccupancyMaxActiveBlocksPerMultiprocessor(&per_cu, (const void*)fwd_kernel, 512, LDS_BYTES); (void)hipGetLastError();
        grid = cus;
    }
    if (grid < 0) return;
    (void)hipMemsetAsync((char*)d_ws + WS_CTL, 0, CTL_BYTES, stream);
    Args a{};
    for (int i = 0; i < 25; ++i) a.in[i] = d_in[i];
    a.out = (float*)d_out; a.ws = (unsigned char*)d_ws;
#if MK_MULTI
    for (int p = 0; p < NPH; ++p) { a.ph_lo = p; a.ph_hi = p + 1; hipLaunchKernelGGL(fwd_kernel, dim3(grid), dim3(512), LDS_BYTES, stream, a); }
#else
    a.ph_lo = 0; a.ph_hi = NPH; a.dbl = PROBE_DBL; hipLaunchKernelGGL(fwd_kernel, dim3(grid), dim3(512), LDS_BYTES, stream, a);
#endif
}
```

```cpp
#define PROBE_DBL 0
#include <hip/hip_runtime.h>
#include <cstdio>
#include <cstdint>
namespace pg8 {
#define PG8_LAS __attribute__((address_space(3)))
typedef unsigned short bf16_t;
typedef short bf16x8 __attribute__((ext_vector_type(8)));
typedef float f32x4 __attribute__((ext_vector_type(4)));
typedef unsigned u32x4 __attribute__((ext_vector_type(4)));
constexpr int BM = 256, BK = 64, HALF = 128, HTB = HALF * BK * 2  , STAGE_BYTES = 8 * HTB, NXCD = 8, WGM = 8;

__host__ __device__ __forceinline__ int lds_byte(int r, int c) { const int st = (r >> 4) * 2 + (c >> 5), rr = r & 15, cc = c & 31, ob = rr * 64 + cc * 2; return st * 1024 + (ob ^ (((ob >> 9) & 1) << 5)); }
__host__ __device__ __forceinline__ void stage_rc(int b, int& R, int& C) { const int st = b / 1024, sb = b % 1024, swz = sb ^ (((sb >> 9) & 1) << 5); R = (st >> 1) * 16 + swz / 64; C = (st & 1) * 32 + (swz % 64) / 2; }
__host__ __device__ __forceinline__ int perm32(int rho) { const int n = rho >> 4, i = rho & 15; return 8 * (i >> 2) + 4 * n + (i & 3); }

struct Unit { int pm, pn; };
struct Gemm { const bf16_t* A; const bf16_t* Bt; int M, N, K; };

struct StaticOrder {
    int nM, nN, nwg, G, c;
    __host__ __device__ void init(int M, int N, int G_, int c_) { nM = M / BM; nN = N / BM; nwg = nM * nN; G = G_; c = c_; }
    __host__ __device__ bool next(int i, Unit& u) const {
        const long L = (long)i * G + c; if (L >= nwg) return false;
        int wgid = (int)L; { const int q = nwg / NXCD, r = nwg % NXCD, xcd = wgid % NXCD, off = wgid / NXCD; wgid = (xcd < r ? xcd * (q + 1) : r * (q + 1) + (xcd - r) * q) + off; }
        const int nig = WGM * nN, gid = wgid / nig, fm = gid * WGM, gsz = (nM - fm) < WGM ? (nM - fm) : WGM;
        u.pm = fm + ((wgid % nig) % gsz); u.pn = (wgid % nig) / gsz; return true;
    }
    __device__ __forceinline__ void a_ready(const Unit&) const {}
    __device__ __forceinline__ void done(const Unit&) const {}
};

__device__ __forceinline__ unsigned cvt_pk_bf16(float lo, float hi) { unsigned r; asm volatile("v_cvt_pk_bf16_f32 %0, %1, %2" : "=v"(r) : "v"(lo), "v"(hi)); return r; }
typedef float f32x2 __attribute__((ext_vector_type(2)));
__device__ __forceinline__ f32x2 gelu_pk(f32x2 v) {
    const f32x2 av = __builtin_elementwise_abs(v), d = av * 0.2316418882f + 1.0f;
    f32x2 t; t.x = __builtin_amdgcn_rcpf(d.x); t.y = __builtin_amdgcn_rcpf(d.y);
    f32x2 q = t * 0.5307027145f + (-0.7265760135f); q = q * t + 0.7107068705f; q = q * t + (-0.142248368f); q = q * t + 0.127414796f; q = q * t;
    const f32x2 s = (v * v) * (-0.72134752044f);
    f32x2 e; e.x = __builtin_amdgcn_exp2f(s.x); e.y = __builtin_amdgcn_exp2f(s.y);
    const f32x2 m = v * (q * e), r = v - m;
    f32x2 o; o.x = v.x < 0.f ? m.x : r.x; o.y = v.y < 0.f ? m.y : r.y; return o;
}

template <int ACT  > struct EpiBf16 {
    static constexpr bool PERM = true, AFTER_DRAIN = false; static_assert(ACT == 0 || ACT == 1, "EpiBf16: ACT is 0 (none) or 1 (gelu_pk)");
    bf16_t* O; int ldc; const float* bias; int split_cols; size_t split_stride; float scale0;
    __device__ __forceinline__ void operator()(const f32x4 (&acc)[2][2][4][2], const Unit& u, int wr, int wc, int fr, int fq) const {
        const int row0 = u.pm * BM + wr * 64 + fr; int colt = u.pn * BM; bf16_t* base = O;
        float sc = 1.f; if (split_cols) { const int t = colt / split_cols; base += (size_t)t * split_stride; colt -= t * split_cols; if (t == 0) sc = scale0; }
        const int col0 = colt + wc * 32 + 8 * fq, bcol0 = u.pn * BM + wc * 32 + 8 * fq;
        f32x4 bv[2][2];
#pragma unroll
        for (int bj = 0; bj < 2; ++bj)
#pragma unroll
            for (int n = 0; n < 2; ++n) bv[bj][n] = bias ? *(const f32x4*)(bias + bcol0 + bj * HALF + 4 * n) : (f32x4){0.f, 0.f, 0.f, 0.f};
#pragma unroll
        for (int ai = 0; ai < 2; ++ai)
#pragma unroll
            for (int m = 0; m < 4; ++m) { bf16_t* rowp = base + (size_t)(row0 + ai * HALF + m * 16) * ldc + col0;
#pragma unroll
                for (int bj = 0; bj < 2; ++bj) { f32x4 v0 = acc[ai][bj][m][0] + bv[bj][0], v1 = acc[ai][bj][m][1] + bv[bj][1];
                    if (ACT == 1) { f32x2 a = gelu_pk((f32x2){v0[0], v0[1]}), b = gelu_pk((f32x2){v0[2], v0[3]}), c = gelu_pk((f32x2){v1[0], v1[1]}), d = gelu_pk((f32x2){v1[2], v1[3]});
                        v0 = (f32x4){a.x, a.y, b.x, b.y}; v1 = (f32x4){c.x, c.y, d.x, d.y}; }
                    v0 = v0 * sc; v1 = v1 * sc; u32x4 w; w.x = cvt_pk_bf16(v0[0], v0[1]); w.y = cvt_pk_bf16(v0[2], v0[3]); w.z = cvt_pk_bf16(v1[0], v1[1]); w.w = cvt_pk_bf16(v1[2], v1[3]);
                    *(u32x4*)(rowp + bj * HALF) = w; } }
    }
};
template <class Epi, class Sched, bool ALIGN_EPI = false, bool SP2 = false>
__device__ __forceinline__ void gemm_phase(PG8_LAS unsigned char* lds, const Gemm g, const Sched& S, const Epi& E, int wave_idx  ) {
    int tid_; asm volatile("v_mbcnt_lo_u32_b32 %0, -1, 0\n\tv_mbcnt_hi_u32_b32 %0, -1, %0" : "=v"(tid_)); tid_ += 64 * wave_idx;
    const int tid = tid_, wid = wave_idx, lane = tid & 63, wr = wid >> 2, wc = wid & 3, fr = lane & 15, fq = lane >> 4;
    const int K = g.K, nt = K / BK;
    unsigned voffA[2], voffB[2];
#pragma unroll
    for (int i = 0; i < 2; ++i) { int R, C; stage_rc(tid * 16 + i * 8192, R, C); const int Rb = Epi::PERM ? ((R & ~31) + perm32(R & 31)) : R;
        voffA[i] = (unsigned)(R * K + C) * 2u; voffB[i] = (unsigned)(Rb * K + C) * 2u; }
    const size_t kstep = (size_t)(BK * 2);
    const size_t hstep = (size_t)HALF * K * 2;
    const size_t tstep = 2 * hstep;
    const unsigned ldsw = (unsigned)wid * 1024u;
    const int aoff = lds_byte(wr * 64 + fr, fq * 8), boff = lds_byte(wc * 32 + fr, fq * 8);
#define PG8_SA(b, h) (((b) * 2 + (h)) * HTB)
#define PG8_SB(b, h) ((4 + (b) * 2 + (h)) * HTB)
#define PG8_STAGE(bufoff, gbase, voff) do { _Pragma("unroll") for (int _i = 0; _i < 2; ++_i) \
        __builtin_amdgcn_global_load_lds((const unsigned*)((const char*)(gbase) + (voff)[_i]), (PG8_LAS unsigned*)(lds + (bufoff) + ldsw + _i * 8192), 16, 0, 0); } while (0)
#define PG8_LDA(dst, b, h) do { _Pragma("unroll") for (int m = 0; m < 4; ++m) _Pragma("unroll") for (int k = 0; k < 2; ++k) dst[m][k] = *(const PG8_LAS bf16x8*)(lds + PG8_SA(b, h) + aoff + m * 2048 + k * 1024); } while (0)
#define PG8_LDB(dst, b, h) do { _Pragma("unroll") for (int n = 0; n < 2; ++n) _Pragma("unroll") for (int k = 0; k < 2; ++k) dst[n][k] = *(const PG8_LAS bf16x8*)(lds + PG8_SB(b, h) + boff + n * 2048 + k * 1024); } while (0)
#define PG8_MMA(ai, bj, At, Bt) do { __builtin_amdgcn_s_setprio(1); _Pragma("unroll") for (int m = 0; m < 4; ++m) _Pragma("unroll") for (int n = 0; n < 2; ++n) _Pragma("unroll") for (int k = 0; k < 2; ++k) \
        acc[ai][bj][m][n] = __builtin_amdgcn_mfma_f32_16x16x32_bf16(Bt[n][k], At[m][k], acc[ai][bj][m][n], 0, 0, 0); __builtin_amdgcn_s_setprio(0); } while (0)
#define PG8_WAIT_V(n) asm volatile("s_waitcnt vmcnt(" #n ")" ::: "memory")
#define PG8_WAIT_L(n) asm volatile("s_waitcnt lgkmcnt(" #n ")" ::: "memory")
#define PG8_BAR __builtin_amdgcn_s_barrier()
#define PG8_SCHED __builtin_amdgcn_sched_barrier(0)
    Unit cur, nxt; int ui = 0;
    if (!S.next(0, cur)) return;
    f32x4 acc[2][2][4][2];
#pragma unroll
    for (int a = 0; a < 2; ++a)
#pragma unroll
        for (int b = 0; b < 2; ++b)
#pragma unroll
            for (int m = 0; m < 4; ++m)
#pragma unroll
                for (int n = 0; n < 2; ++n) acc[a][b][m][n] = (f32x4){0.f, 0.f, 0.f, 0.f};
    bf16x8 At[4][2], B0[2][2], B1[2][2];
    const char* cA = (const char*)g.A + (size_t)cur.pm * tstep; const char* cB = (const char*)g.Bt + (size_t)cur.pn * tstep;
    S.a_ready(cur);
    if constexpr (SP2) {
        PG8_STAGE(PG8_SB(0, 0), cB, voffB); PG8_STAGE(PG8_SB(0, 1), cB + hstep, voffB); PG8_STAGE(PG8_SA(0, 0), cA, voffA); PG8_STAGE(PG8_SA(0, 1), cA + hstep, voffA);
        if (wr == 1) PG8_BAR;
        PG8_WAIT_V(2); PG8_BAR;
        PG8_STAGE(PG8_SB(1, 0), cB + kstep, voffB); PG8_STAGE(PG8_SA(1, 0), cA + kstep, voffA); PG8_STAGE(PG8_SB(1, 1), cB + hstep + kstep, voffB);
        PG8_WAIT_V(6); PG8_BAR;
    } else {
        PG8_STAGE(PG8_SB(0, 0), cB, voffB); PG8_STAGE(PG8_SA(0, 0), cA, voffA); PG8_STAGE(PG8_SB(0, 1), cB + hstep, voffB); PG8_STAGE(PG8_SA(0, 1), cA + hstep, voffA);
        if (wr == 1) PG8_BAR;
        PG8_WAIT_V(4); PG8_BAR;
        PG8_STAGE(PG8_SB(1, 0), cB + kstep, voffB); PG8_STAGE(PG8_SA(1, 0), cA + kstep, voffA); PG8_STAGE(PG8_SB(1, 1), cB + hstep + kstep, voffB);
        PG8_WAIT_V(6); PG8_BAR;
    }
    for (;;) {
        const bool has_next = S.next(ui + 1, nxt);
        const char* nA = has_next ? (const char*)g.A + (size_t)nxt.pm * tstep : cA; const char* nB = has_next ? (const char*)g.Bt + (size_t)nxt.pn * tstep : cB;
        for (int t = 0; t < nt; t += 2) {
            const bool last = (t == nt - 2);
            const char* a1 = cA + (size_t)(t + 1) * kstep;
            const char* a2 = last ? nA : cA + (size_t)(t + 2) * kstep; const char* b2 = last ? nB : cB + (size_t)(t + 2) * kstep;
            const char* a3 = a2 + kstep; const char* b3 = b2 + kstep;
            if (last && has_next) S.a_ready(nxt);
            if constexpr (SP2) {
            PG8_LDB(B0, 0, 0); PG8_LDB(B1, 0, 1); PG8_SCHED; PG8_LDA(At, 0, 0); PG8_STAGE(PG8_SA(1, 1), a1 + hstep, voffA);
            PG8_WAIT_V(8); PG8_WAIT_L(0); PG8_BAR; PG8_MMA(0, 0, At, B0); PG8_MMA(0, 1, At, B1); PG8_BAR; PG8_SCHED;
            PG8_LDA(At, 0, 1); PG8_STAGE(PG8_SB(0, 0), b2, voffB); PG8_STAGE(PG8_SB(0, 1), b2 + hstep, voffB); PG8_STAGE(PG8_SA(0, 0), a2, voffA);
            PG8_WAIT_V(8); PG8_WAIT_L(0); PG8_BAR; PG8_MMA(1, 0, At, B0); PG8_MMA(1, 1, At, B1); PG8_BAR; PG8_SCHED;
            PG8_LDB(B0, 1, 0); PG8_LDB(B1, 1, 1); PG8_SCHED; PG8_LDA(At, 1, 0); PG8_STAGE(PG8_SA(0, 1), a2 + hstep, voffA);
            PG8_WAIT_V(8); PG8_WAIT_L(0); PG8_BAR; PG8_MMA(0, 0, At, B0); PG8_MMA(0, 1, At, B1); PG8_BAR; PG8_SCHED;
            PG8_LDA(At, 1, 1); PG8_STAGE(PG8_SB(1, 0), b3, voffB); PG8_STAGE(PG8_SB(1, 1), b3 + hstep, voffB); PG8_STAGE(PG8_SA(1, 0), a3, voffA);
            PG8_WAIT_V(8); PG8_WAIT_L(0); PG8_BAR; PG8_MMA(1, 0, At, B0); PG8_MMA(1, 1, At, B1); PG8_BAR; PG8_SCHED;
            } else {
            PG8_LDB(B0, 0, 0); PG8_SCHED; PG8_LDA(At, 0, 0); PG8_STAGE(PG8_SA(1, 1), a1 + hstep, voffA);
            PG8_WAIT_L(8); PG8_BAR; PG8_WAIT_L(0); PG8_MMA(0, 0, At, B0); PG8_BAR; PG8_SCHED;
            PG8_LDB(B1, 0, 1); PG8_STAGE(PG8_SB(0, 0), b2, voffB);
            PG8_BAR; PG8_WAIT_L(0); PG8_MMA(0, 1, At, B1); PG8_BAR;
            PG8_LDA(At, 0, 1); PG8_STAGE(PG8_SA(0, 0), a2, voffA);
            PG8_BAR; PG8_WAIT_L(0); PG8_MMA(1, 0, At, B0); PG8_BAR; PG8_SCHED;
            PG8_STAGE(PG8_SB(0, 1), b2 + hstep, voffB);
            PG8_WAIT_V(6); PG8_BAR; PG8_MMA(1, 1, At, B1); PG8_BAR;
            PG8_LDB(B0, 1, 0); PG8_SCHED; PG8_LDA(At, 1, 0); PG8_STAGE(PG8_SA(0, 1), a2 + hstep, voffA);
            PG8_WAIT_L(8); PG8_BAR; PG8_WAIT_L(0); PG8_MMA(0, 0, At, B0); PG8_BAR; PG8_SCHED;
            PG8_LDB(B1, 1, 1); PG8_STAGE(PG8_SB(1, 0), b3, voffB);
            PG8_BAR; PG8_WAIT_L(0); PG8_MMA(0, 1, At, B1); PG8_BAR;
            PG8_LDA(At, 1, 1); PG8_STAGE(PG8_SA(1, 0), a3, voffA);
            PG8_BAR; PG8_WAIT_L(0); PG8_MMA(1, 0, At, B0); PG8_BAR; PG8_SCHED;
            PG8_STAGE(PG8_SB(1, 1), b3 + hstep, voffB);
            PG8_WAIT_V(6); PG8_BAR; PG8_MMA(1, 1, At, B1); PG8_BAR;
            }
        }
        if constexpr (ALIGN_EPI) { if (wr == 0) PG8_BAR; }
        if constexpr (!Epi::AFTER_DRAIN) { E(acc, cur, wr, wc, fr, fq); S.done(cur); }
        if (!has_next) break;
#pragma unroll
        for (int a = 0; a < 2; ++a)
#pragma unroll
            for (int b = 0; b < 2; ++b)
#pragma unroll
                for (int m = 0; m < 4; ++m)
#pragma unroll
                    for (int n = 0; n < 2; ++n) acc[a][b][m][n] = (f32x4){0.f, 0.f, 0.f, 0.f};
        cur = nxt; cA = nA; cB = nB; ++ui;
        if constexpr (ALIGN_EPI) { if (wr == 1) PG8_BAR; }
    }
    PG8_WAIT_V(0);
    if constexpr (!ALIGN_EPI) { if (wr == 0) PG8_BAR; }
    PG8_BAR;
    if constexpr (Epi::AFTER_DRAIN) { E.fused(acc, cur, wr, wc, fr, fq, lds, wid, lane); S.done(cur); }
#undef PG8_SA
#undef PG8_SB
#undef PG8_STAGE
#undef PG8_LDA
#undef PG8_LDB
#undef PG8_MMA
#undef PG8_WAIT_V
#undef PG8_WAIT_L
#undef PG8_BAR
#undef PG8_SCHED
}
}

#ifndef MK_MULTI
#define MK_MULTI 0
#endif
#ifndef PROBE_DBL
#define PROBE_DBL 0
#endif
#define LAS __attribute__((address_space(3)))
typedef unsigned short bf16;
typedef float f32x4 __attribute__((ext_vector_type(4)));
typedef unsigned u32x4 __attribute__((ext_vector_type(4)));
typedef unsigned u32x2 __attribute__((ext_vector_type(2)));

constexpr int DM = 1024, NBATCH = 4, SEQ = 4096, MPR = NBATCH * SEQ, DB = 128, MTOT = MPR + DB, MPAD = 16640;
constexpr int PASTL = 2048, NPOOL = 2560, NPG = 16;
constexpr int INW = 3368, HW = 3584, DFF = 2816, UPW = 5632, PLED = 256;
constexpr int HQ = 0, HKV = 512, HWIN = 1024, HGQKV = 1280, HGZ = 2816, HSM = 3328;
constexpr int GQKV = 1536;
constexpr float LN_EPS = 1e-5f, RMS_EPS = 1e-6f, NEGV = -1e30f;
constexpr float DN_ALPHA = 1.41421356237309515f;

constexpr size_t O_YP = 0, O_YS = O_YP + (size_t)MPR * DM, O_KVP = O_YS + (size_t)DB * DM, O_KVS = O_KVP + (size_t)2 * MPR * 512,
                 O_WINP = O_KVS + (size_t)2 * DB * 512, O_WINS = O_WINP + (size_t)2 * 4 * 512 * 256, O_GSP = O_WINS + (size_t)2 * DB * 512 * 256,
                 O_GSS = O_GSP + (size_t)2 * 4 * 8 * 4096, O_GCP = O_GSS + (size_t)2 * DB * 8 * 4096, O_GCS = O_GCP + (size_t)2 * 4 * 3 * GQKV,
                 O_FCP = O_GCS + (size_t)2 * DB * 3 * GQKV, O_FCS = O_FCP + (size_t)2 * 4 * 2 * DFF, O_END = O_FCS + (size_t)2 * DB * 2 * DFF;

constexpr size_t MiB = 1u << 20;
constexpr size_t alup(size_t x) { return (x + MiB - 1) & ~(MiB - 1); }
constexpr size_t WS_CTL = 0, CTL_BYTES = 1 * MiB;
constexpr size_t WS_WIN = WS_CTL + CTL_BYTES;
constexpr size_t WS_WOUT = WS_WIN + alup((size_t)2 * HW * DM * 2);
constexpr size_t WS_WUP = WS_WOUT + alup((size_t)2 * DM * DM * 2);
constexpr size_t WS_WDN = WS_WUP + alup((size_t)2 * UPW * DM * 2);
constexpr size_t WS_WGT = WS_WDN + alup((size_t)2 * DM * DFF * 2);
constexpr size_t WS_WPJ = WS_WGT + alup((size_t)2 * DM * DM * 2);
constexpr size_t WS_XF = WS_WPJ + alup((size_t)2 * DM * PLED * 2);
constexpr size_t WS_XB = WS_XF + alup((size_t)MPAD * DM * 4);
constexpr size_t WS_T1 = WS_XB + alup((size_t)MPAD * DM * 2);
constexpr size_t WS_H = WS_T1 + alup((size_t)MPAD * DM * 4);
constexpr size_t WS_HS = WS_H + alup((size_t)MPAD * HW * 2);
constexpr size_t WS_PB = WS_HS + alup((size_t)MPAD * 64 * 4);
constexpr size_t WS_PP = WS_PB + alup((size_t)2 * MPAD * PLED * 2);
constexpr size_t WS_MIX = WS_PP + alup((size_t)2 * MPAD * DM * 4);
constexpr size_t WS_UP = WS_MIX + alup((size_t)MPAD * DM * 2);
constexpr size_t WS_ACT = WS_UP + alup((size_t)MPAD * UPW * 2);
constexpr size_t WS_GQ = WS_ACT + alup((size_t)MPAD * DFF * 2);
constexpr size_t WS_GK = WS_GQ + alup((size_t)MTOT * 512 * 4);
constexpr size_t WS_GV = WS_GK + alup((size_t)MTOT * 512 * 4);
constexpr size_t WS_GG = WS_GV + alup((size_t)MTOT * 512 * 4);
constexpr size_t WS_GB = WS_GG + alup((size_t)MTOT * 8 * 4);
constexpr size_t WS_KCP = WS_GB + alup((size_t)MTOT * 8 * 4);
constexpr size_t WS_VCP = WS_KCP + alup((size_t)4 * 128 * 128 * 4);
constexpr size_t WS_KCS = WS_VCP + alup((size_t)4 * 128 * 128 * 4);
constexpr size_t WS_VCS = WS_KCS + alup((size_t)DB * 64 * 128 * 4);
constexpr size_t WS_KCB = WS_VCS + alup((size_t)DB * 64 * 128 * 4);
constexpr size_t WS_VCB = WS_KCB + alup((size_t)4 * 128 * 128 * 2);
constexpr size_t WS_SC = WS_VCB + alup((size_t)4 * 128 * 128 * 2);
constexpr size_t WS_OG = WS_SC + alup((size_t)MTOT * 8 * 4 * 4);
constexpr size_t WS_SMASK = WS_OG + alup((size_t)MPR * 512 * 4);
constexpr size_t WS_OCMP = WS_SMASK + alup((size_t)DB * 2 * 8);
constexpr size_t WS_PART = WS_OCMP + alup((size_t)DB * 2 * 256 * 4);
constexpr size_t WS_END = WS_PART + alup((size_t)DB * 2 * 25 * 264 * 4);
constexpr int CW_Q0 = 64, CW_Q1 = 128, CW_U0 = 192, CW_U1 = 256, CW_P0 = 320, CW_P1 = 384;
constexpr int CW_BAR = 4096;

constexpr int CTLB = 1024, RING_BYTES = 131072, MISC_OFF = 0, ARGS_OFF = 256, LDS_BYTES = 147456;

__device__ __forceinline__ float bf2f(bf16 v) { return __uint_as_float(((unsigned)v) << 16); }
__device__ __forceinline__ unsigned f2bf(float f) { unsigned u = __float_as_uint(f); return (u + 0x7fffu + ((u >> 16) & 1u)) >> 16; }
__device__ __forceinline__ unsigned pk2(float lo, float hi) { return f2bf(lo) | (f2bf(hi) << 16); }
__device__ __forceinline__ float wave_sum(float v) {
#pragma unroll
    for (int o = 1; o < 64; o <<= 1) v += __shfl_xor(v, o);
    return v;
}
__device__ __forceinline__ float wave_max(float v) {
#pragma unroll
    for (int o = 1; o < 64; o <<= 1) v = fmaxf(v, __shfl_xor(v, o));
    return v;
}
__device__ __forceinline__ float wave_sum_fast(float v) {
    float t = v + __int_as_float(__builtin_amdgcn_mov_dpp(__float_as_int(v), 0xB1, 0xF, 0xF, true));
    t = t + __int_as_float(__builtin_amdgcn_mov_dpp(__float_as_int(t), 0x4E, 0xF, 0xF, true));
    t = t + __int_as_float(__builtin_amdgcn_mov_dpp(__float_as_int(t), 0x141, 0xF, 0xF, true));
    t = t + __int_as_float(__builtin_amdgcn_mov_dpp(__float_as_int(t), 0x140, 0xF, 0xF, true));
    const int ti = __float_as_int(t);
    return (__int_as_float(__builtin_amdgcn_readlane(ti, 0)) + __int_as_float(__builtin_amdgcn_readlane(ti, 16))) + (__int_as_float(__builtin_amdgcn_readlane(ti, 32)) + __int_as_float(__builtin_amdgcn_readlane(ti, 48)));
}
__device__ __forceinline__ void wave_lds_sync() { asm volatile("s_waitcnt lgkmcnt(0)" ::: "memory"); }
__device__ __forceinline__ float sigmoidf_(float x) { return 1.0f / (1.0f + __expf(-x)); }
__device__ __forceinline__ float siluf_(float x) { return x / (1.0f + __expf(-x)); }
__device__ __forceinline__ float softplusf_(float x) { return fmaxf(x, 0.f) + log1pf(__expf(-fabsf(x))); }

#define XB_TMO      128
#define XB_XCNT(j)  (256  + 64 * (j))
#define XB_XSUB(j)  (1280 + 64 * (j))
#define XB_XGEN(j)  (2304 + 64 * (j))
#define XB_TOP      3328
#define XB_TOPGEN   3392
#define XCD_BAR_WORDS 3456
#define XB_SPIN_CAP (1u << 18)
__device__ __forceinline__ unsigned xb_ld(unsigned* p)              { return __hip_atomic_load(p, __ATOMIC_RELAXED, __HIP_MEMORY_SCOPE_AGENT); }
__device__ __forceinline__ unsigned xb_add(unsigned* p, unsigned v) { return __hip_atomic_fetch_add(p, v, __ATOMIC_RELAXED, __HIP_MEMORY_SCOPE_AGENT); }
__device__ __forceinline__ unsigned xb_xcc_id() { return (unsigned)__builtin_amdgcn_s_getreg((3 << 11) | 20) & 0xFu; }
#define XB_SPIN(cond, bar) do { unsigned _sp = 0; while (cond) { __builtin_amdgcn_s_sleep(1); \
    if ((++_sp & 255u) == 0u) { if (xb_ld(&(bar)[XB_TMO])) break; if (_sp > XB_SPIN_CAP) { atomicAdd(&(bar)[XB_TMO], 1u); break; } } } } while (0)
__device__ __forceinline__ int xb_lane() { int ln; asm volatile("v_mbcnt_lo_u32_b32 %0, -1, 0\n\tv_mbcnt_hi_u32_b32 %0, -1, %0" : "=v"(ln)); return ln; }
struct XcdBarrier { unsigned* bar; unsigned x; volatile LAS unsigned* st; bool w0;   };
__device__ __forceinline__ XcdBarrier xcd_barrier_post(unsigned* bar, volatile LAS unsigned* st) {
    XcdBarrier b; b.bar = bar; b.x = xb_xcc_id(); b.st = st;
    if (threadIdx.x == 0) (void)xb_add(&bar[XB_XCNT(b.x)], 1u);
    return b;
}
__device__ __forceinline__ void xcd_barrier_complete(unsigned* bar, unsigned x, unsigned& nloc, unsigned& nx) {
    const unsigned G = gridDim.x * gridDim.y * gridDim.z;
    unsigned sum, cnt, mine, sp = 0u;
    for (;;) {
        sum = 0u; cnt = 0u; mine = 0u;
#pragma unroll
        for (unsigned j = 0; j < 16; ++j) { const unsigned c = xb_ld(&bar[XB_XCNT(j)]); sum += c; cnt += (c > 0u) ? 1u : 0u; mine = (j == x) ? c : mine; }
        if (sum == G) break;
        __builtin_amdgcn_s_sleep(1);
        if ((++sp & 255u) == 0u) { if (xb_ld(&bar[XB_TMO])) break; if (sp > XB_SPIN_CAP) { atomicAdd(&bar[XB_TMO], 1u); break; } }
    }
    nloc = mine > 0u ? mine : 1u; nx = cnt > 0u ? cnt : 1u;
}
__device__ __forceinline__ void xcd_barrier(const XcdBarrier& b) {
    asm volatile("s_waitcnt vmcnt(0)" ::: "memory");
    __syncthreads();
    if (b.w0 && xb_lane() == 0) {
        unsigned* bar = b.bar; asm volatile("" : "+s"(bar));
        __builtin_amdgcn_s_waitcnt(0);
        unsigned nloc = b.st[0], nx = b.st[1];
        if (nloc == 0u) { xcd_barrier_complete(bar, b.x, nloc, nx); b.st[0] = nloc; b.st[1] = nx; }
        const unsigned old = xb_add(&bar[XB_XSUB(b.x)], 1u);
        const unsigned gen = old / nloc;
        if (old + 1u == (gen + 1u) * nloc) {
            __builtin_amdgcn_fence(__ATOMIC_RELEASE, "agent");
            asm volatile("s_waitcnt vmcnt(0)" ::: "memory");
            const unsigned og = xb_add(&bar[XB_TOP], 1u);
            const unsigned tg = og / nx;
            if (og + 1u == (tg + 1u) * nx) xb_add(&bar[XB_TOPGEN], 1u);
            else XB_SPIN(xb_ld(&bar[XB_TOPGEN]) == tg, bar);
            __builtin_amdgcn_fence(__ATOMIC_ACQUIRE, "agent");
            xb_add(&bar[XB_XGEN(b.x)], 1u);
            asm volatile("s_waitcnt vmcnt(0)" ::: "memory");
        } else {
            XB_SPIN(xb_ld(&bar[XB_XGEN(b.x)]) == gen, bar);
            __builtin_amdgcn_fence(__ATOMIC_ACQUIRE, "agent");
            asm volatile("s_waitcnt vmcnt(0)" ::: "memory");
        }
    }
    __syncthreads();
}

struct Args { const void* in[25]; float* out; unsigned char* ws; int ph_lo, ph_hi, dbl, pad; };
enum { I_XP = 0, I_XS, I_CACHE, I_SWIN, I_SGDN, I_SGCONV, I_SFCONV, I_PTAB, I_PP, I_PS, I_WIN, I_PE, I_PHI, I_GCW, I_ALOG, I_DTB, I_GNW, I_WOUT, I_LNG, I_LNB, I_WUP, I_FCW, I_WDN, I_WPJ, I_WGT };

namespace pg8 {
struct EpiIn {
    static constexpr bool PERM = true, AFTER_DRAIN = false;
    bf16_t* H; float* HS; float* kvp; float* kvs;
    __device__ __forceinline__ void operator()(const f32x4 (&acc)[2][2][4][2], const Unit& u, int wr, int wc, int fr, int fq) const {
        const int row0 = u.pm * BM + wr * 64 + fr, col0 = u.pn * BM + wc * 32 + 8 * fq;
        const bool iskv = (u.pn == 2 || u.pn == 3), issm = (u.pn == 13);
#pragma unroll
        for (int ai = 0; ai < 2; ++ai)
#pragma unroll
            for (int m = 0; m < 4; ++m) { const int r = row0 + ai * HALF + m * 16;
#pragma unroll
                for (int bj = 0; bj < 2; ++bj) { const int c = col0 + bj * HALF; const f32x4 v0 = acc[ai][bj][m][0], v1 = acc[ai][bj][m][1];
                    u32x4 w; w.x = cvt_pk_bf16(v0[0], v0[1]); w.y = cvt_pk_bf16(v0[2], v0[3]); w.z = cvt_pk_bf16(v1[0], v1[1]); w.w = cvt_pk_bf16(v1[2], v1[3]);
                    *(u32x4*)(H + (size_t)r * HW + c) = w;
                    if (iskv) { float* dst = nullptr; if (r < MPR) dst = kvp + (size_t)r * 512 + (c - HKV); else if (r < MTOT) dst = kvs + (size_t)(r - MPR) * 512 + (c - HKV);
                        if (dst) { *(f32x4*)dst = v0; *(f32x4*)(dst + 4) = v1; } }
                    if (issm && (c - HSM) < 64) { float* dst = HS + (size_t)r * 64 + (c - HSM); *(f32x4*)dst = v0; *(f32x4*)(dst + 4) = v1; } } }
    }
};
struct EpiRes {
    static constexpr bool PERM = false, AFTER_DRAIN = false;
    const float* XF; float* T1;
    __device__ __forceinline__ void operator()(const f32x4 (&acc)[2][2][4][2], const Unit& u, int wr, int wc, int fr, int fq) const {
        const int row0 = u.pm * BM + wr * 64 + fr, col0 = u.pn * BM + wc * 32 + 4 * fq;
#pragma unroll
        for (int ai = 0; ai < 2; ++ai)
#pragma unroll
            for (int m = 0; m < 4; ++m) { const size_t off = (size_t)(row0 + ai * HALF + m * 16) * DM + col0;
#pragma unroll
                for (int bj = 0; bj < 2; ++bj)
#pragma unroll
                    for (int n = 0; n < 2; ++n) { const size_t o = off + bj * HALF + n * 16; const f32x4 xv = *(const f32x4*)(XF + o); *(f32x4*)(T1 + o) = xv * DN_ALPHA + acc[ai][bj][m][n]; } }
    }
};
struct EpiGate {
    static constexpr bool PERM = false, AFTER_DRAIN = false;
    const float* XF; const float* PP; float* T1;
    __device__ __forceinline__ void operator()(const f32x4 (&acc)[2][2][4][2], const Unit& u, int wr, int wc, int fr, int fq) const {
        const int row0 = u.pm * BM + wr * 64 + fr, col0 = u.pn * BM + wc * 32 + 4 * fq;
#pragma unroll
        for (int ai = 0; ai < 2; ++ai)
#pragma unroll
            for (int m = 0; m < 4; ++m) { const size_t off = (size_t)(row0 + ai * HALF + m * 16) * DM + col0;
#pragma unroll
                for (int bj = 0; bj < 2; ++bj)
#pragma unroll
                    for (int n = 0; n < 2; ++n) { const size_t o = off + bj * HALF + n * 16; const f32x4 xv = *(const f32x4*)(XF + o), pv = *(const f32x4*)(PP + o); const f32x4 a = acc[ai][bj][m][n]; f32x4 s;
#pragma unroll
                        for (int j = 0; j < 4; ++j) s[j] = 1.0f / (1.0f + __expf(-a[j]));
                        *(f32x4*)(T1 + o) = xv * DN_ALPHA + s * pv; } }
    }
};
struct EpiF32 {
    static constexpr bool PERM = false, AFTER_DRAIN = false;
    float* C; int ldc;
    __device__ __forceinline__ void operator()(const f32x4 (&acc)[2][2][4][2], const Unit& u, int wr, int wc, int fr, int fq) const {
        const int row0 = u.pm * BM + wr * 64 + fr, col0 = u.pn * BM + wc * 32 + 4 * fq;
#pragma unroll
        for (int ai = 0; ai < 2; ++ai)
#pragma unroll
            for (int m = 0; m < 4; ++m) { float* rowp = C + (size_t)(row0 + ai * HALF + m * 16) * ldc + col0;
#pragma unroll
                for (int bj = 0; bj < 2; ++bj)
#pragma unroll
                    for (int n = 0; n < 2; ++n) *(f32x4*)(rowp + bj * HALF + n * 16) = acc[ai][bj][m][n]; }
    }
};
}

struct Ctx { int tid, lane, wave, bid, G; LAS unsigned char* lds; unsigned* ctl; const LAS unsigned* la; };
#define GAS __attribute__((address_space(1)))
__device__ __forceinline__ const void* ld_ptr(const LAS unsigned* p0) { const volatile LAS unsigned* p = p0;
    const unsigned lo = (unsigned)__builtin_amdgcn_readfirstlane((int)p[0]), hi = (unsigned)__builtin_amdgcn_readfirstlane((int)p[1]);
    return (const void*)(const GAS void*)(uintptr_t)(((unsigned long long)hi << 32) | lo); }
__device__ __forceinline__ int hw_lane() { int ln; asm volatile("v_mbcnt_lo_u32_b32 %0, -1, 0\n\tv_mbcnt_hi_u32_b32 %0, -1, %0" : "=v"(ln)); return ln; }
__device__ __forceinline__ Ctx relaunder(const Ctx& c0) { Ctx c = c0; int w = c0.wave; asm volatile("" : "+s"(w) :: "memory"); int ln = hw_lane(); asm volatile("" : "+v"(ln) :: "memory"); c.wave = w; c.lane = ln; c.tid = w * 64 + ln; int b = c0.bid; asm volatile("" : "+s"(b) :: "memory"); c.bid = b; return c; }
#define AIN(i) ld_ptr(c.la + 2 * (i))
#define AOUT ((float*)ld_ptr(c.la + 50))
#define AWS ((unsigned char*)ld_ptr(c.la + 52))
#define AIN_DBL (__builtin_amdgcn_readfirstlane((int)((const volatile LAS unsigned*)c.la)[56]))

__device__ __forceinline__ int in_colmap(int n) {
    if (n < HGQKV) return n;
    if (n < HGZ) return 1304 + (n - HGQKV);
    if (n < HSM) return 2856 + (n - HGZ);
    if (n < HSM + 24) return 1280 + (n - HSM);
    if (n < HSM + 32) return 2840 + (n - HSM - 24);
    if (n < HSM + 40) return 2848 + (n - HSM - 32);
    return -1;
}
__device__ __forceinline__ void p0_prologue(const Ctx& c0) {
    const Ctx c = relaunder(c0);
    LAS float* tile = (LAS float*)c.lds;
    constexpr int T_IN = (HW / 64) * (DM / 64), T_OUT = 16 * 16, T_UP = (UPW / 64) * 16, T_DN = 16 * (DFF / 64), T_GT = 256, T_PJ = 16 * (PLED / 64);
    constexpr int T_L = T_IN + T_OUT + T_UP + T_DN + T_GT + T_PJ;
    for (int it = c.bid; it < 2 * T_L; it += c.G) {
        const int l = it / T_L; int r = it % T_L;
        const float* W; bf16* WT; int K, Ns, mode = 0;
        if (r < T_IN) { W = (const float*)AIN(I_WIN) + (size_t)l * DM * INW; K = DM; Ns = INW; WT = (bf16*)(AWS + WS_WIN) + (size_t)l * HW * DM; mode = 1; }
        else if ((r -= T_IN) < T_OUT) { W = (const float*)AIN(I_WOUT) + (size_t)l * DM * DM; K = DM; Ns = DM; WT = (bf16*)(AWS + WS_WOUT) + (size_t)l * DM * DM; }
        else if ((r -= T_OUT) < T_UP) { W = (const float*)AIN(I_WUP) + (size_t)l * DM * UPW; K = DM; Ns = UPW; WT = (bf16*)(AWS + WS_WUP) + (size_t)l * UPW * DM; }
        else if ((r -= T_UP) < T_DN) { W = (const float*)AIN(I_WDN) + (size_t)l * DFF * DM; K = DFF; Ns = DM; WT = (bf16*)(AWS + WS_WDN) + (size_t)l * DM * DFF; }
        else if ((r -= T_DN) < T_GT) { W = (const float*)AIN(I_WGT) + (size_t)l * DM * DM; K = DM; Ns = DM; WT = (bf16*)(AWS + WS_WGT) + (size_t)l * DM * DM; }
        else { r -= T_GT; W = (const float*)AIN(I_WPJ) + (size_t)l * PLED * DM; K = PLED; Ns = DM; WT = (bf16*)(AWS + WS_WPJ) + (size_t)l * DM * PLED; }
        const int nk = K / 64, tn = r / nk, tk = r % nk, n0 = tn * 64, k0 = tk * 64;
        { const int nn = c.tid & 63; const int nd = n0 + nn; const int sc = mode ? in_colmap(nd) : nd;
#pragma unroll
          for (int q = 0; q < 8; ++q) { const int kk = q * 8 + (c.tid >> 6); tile[kk * 65 + nn] = (sc >= 0) ? W[(size_t)(k0 + kk) * Ns + sc] : 0.f; } }
        __syncthreads();
        { const int n = c.tid >> 3, kc = (c.tid & 7) * 8; const LAS float* s = tile + kc * 65 + n;
          u32x4 o; o.x = pk2(s[0], s[65]); o.y = pk2(s[2 * 65], s[3 * 65]); o.z = pk2(s[4 * 65], s[5 * 65]); o.w = pk2(s[6 * 65], s[7 * 65]);
          *(u32x4*)(WT + (size_t)(n0 + n) * K + k0 + kc) = o; }
        __syncthreads();
    }
    const size_t gt = (size_t)c.bid * 512 + c.tid, GT = (size_t)c.G * 512;
    { float* XF = (float*)(AWS + WS_XF); bf16* XB = (bf16*)(AWS + WS_XB); const float* xp = (const float*)AIN(I_XP); const float* xs = (const float*)AIN(I_XS);
      for (size_t i = gt; i < (size_t)MPAD * DM / 4; i += GT) { const size_t e = i * 4; const size_t row = e / DM;
          f32x4 v = (f32x4){0.f, 0.f, 0.f, 0.f};
          if (row < (size_t)MPR) v = *(const f32x4*)(xp + e); else if (row < (size_t)MTOT) v = *(const f32x4*)(xs + (e - (size_t)MPR * DM));
          *(f32x4*)(XF + e) = v; u32x2 w; w.x = pk2(v[0], v[1]); w.y = pk2(v[2], v[3]); *(u32x2*)(XB + e) = w; } }
    for (int l = 0; l < 2; ++l) { bf16* PB = (bf16*)(AWS + WS_PB) + (size_t)l * MPAD * PLED; const float* pp = (const float*)AIN(I_PP) + (size_t)l * MPR * PLED; const float* ps = (const float*)AIN(I_PS) + (size_t)l * DB * PLED;
      for (size_t i = gt; i < (size_t)MPAD * PLED / 4; i += GT) { const size_t e = i * 4; const size_t row = e / PLED;
          f32x4 v = (f32x4){0.f, 0.f, 0.f, 0.f};
          if (row < (size_t)MPR) v = *(const f32x4*)(pp + e); else if (row < (size_t)MTOT) v = *(const f32x4*)(ps + (e - (size_t)MPR * PLED));
          u32x2 w; w.x = pk2(v[0], v[1]); w.y = pk2(v[2], v[3]); *(u32x2*)(PB + e) = w; } }
}

__device__ __forceinline__ float ldT(const bf16* p) { return bf2f(*p); }
__device__ __forceinline__ float ldT(const float* p) { return *p; }
__device__ __forceinline__ void qk4(const bf16* kp, const LAS float* qbuf, float (&dot)[4]) {
    dot[0] = dot[1] = dot[2] = dot[3] = 0.f;
#pragma unroll 2
    for (int cch = 0; cch < 8; ++cch) { const u32x4 w = *(const u32x4*)(kp + cch * 8);
#pragma unroll
        for (int j = 0; j < 4; ++j) { const unsigned ww = w[j]; const float k0 = __uint_as_float(ww << 16), k1 = __uint_as_float(ww & 0xffff0000u);
            const f32x4 q0 = *(const LAS f32x4*)(qbuf + (cch * 8 + j * 2) * 4), q1 = *(const LAS f32x4*)(qbuf + (cch * 8 + j * 2 + 1) * 4);
#pragma unroll
            for (int g = 0; g < 4; ++g) dot[g] += k0 * q0[g] + k1 * q1[g]; } }
}
__device__ __forceinline__ void qk4(const float* kp, const LAS float* qbuf, float (&dot)[4]) {
    dot[0] = dot[1] = dot[2] = dot[3] = 0.f;
#pragma unroll 4
    for (int cch = 0; cch < 16; ++cch) { const f32x4 w = *(const f32x4*)(kp + cch * 4);
#pragma unroll
        for (int j = 0; j < 4; ++j) { const f32x4 q0 = *(const LAS f32x4*)(qbuf + (cch * 4 + j) * 4);
#pragma unroll
            for (int g = 0; g < 4; ++g) dot[g] += w[j] * q0[g]; } }
}
template <typename T>
__device__ __forceinline__ void pv4(const T* vp_lane, const LAS float* pbuf, int lane, float (&o)[4]) {
    const unsigned long long pv = (unsigned long long)(uintptr_t)vp_lane; const int lo = (int)(unsigned)pv, hi = (int)(unsigned)(pv >> 32);
#pragma unroll 16
    for (int j = 0; j < 64; ++j) {
        const unsigned l2 = (unsigned)__builtin_amdgcn_readlane(lo, j), h2 = (unsigned)__builtin_amdgcn_readlane(hi, j);
        const T* vp = (const T*)(uintptr_t)(((unsigned long long)h2 << 32) | l2);
        const float v = ldT(vp + lane); const f32x4 p = *(const LAS f32x4*)(pbuf + j * 4);
#pragma unroll
        for (int g = 0; g < 4; ++g) o[g] += p[g] * v;
    }
}
struct OSm { float m[4], l[4], o[4]; };
__device__ __forceinline__ void os_init(OSm& s) {
#pragma unroll
    for (int g = 0; g < 4; ++g) { s.m[g] = NEGV; s.l[g] = 0.f; s.o[g] = 0.f; } }
template <typename T>
__device__ __forceinline__ void attend_block(OSm& st, const T* kp, const T* vp, bool valid, float dist, const LAS float* qbuf, LAS float* pbuf, int lane, const float (&slope)[4]) {
    float dot[4]; qk4(kp, qbuf, dot);
    f32x4 p; float c8 = 0.125f; asm volatile("" : "+v"(c8));
#pragma unroll
    for (int g = 0; g < 4; ++g) { const float s = valid ? (dot[g] * c8 - slope[g] * dist) : NEGV;
        const float mn = fmaxf(st.m[g], wave_max(s)); const float pg = valid ? __expf(s - mn) : 0.f; const float corr = __expf(st.m[g] - mn);
        st.l[g] = st.l[g] * corr + wave_sum(pg); st.o[g] *= corr; st.m[g] = mn; p[g] = pg; }
    *(LAS f32x4*)(pbuf + lane * 4) = p; wave_lds_sync();
    pv4(vp, pbuf, lane, st.o);
    wave_lds_sync();
}
__device__ __forceinline__ unsigned long long select_blocks(const LAS float* impbuf, int lane, int cur) {
    const bool excl = lane > cur; const bool forced = (lane == 0) || (lane == cur) || (lane + 1 == cur);
    const float imp = impbuf[2 * lane] + impbuf[2 * lane + 1];
    const float sc = excl ? -__builtin_inff() : (forced ? __builtin_inff() : imp);
    int cnt = 0; const int sci = __float_as_int(sc);
#pragma unroll 8
    for (int i = 0; i < 64; ++i) { const float si = __int_as_float(__builtin_amdgcn_readlane(sci, i)); cnt += ((si > sc) || (si == sc && i < lane)) ? 1 : 0; }
    return __ballot(!excl && cnt < 16);
}

__device__ __forceinline__ void nsa_item(const Ctx& c, int l, bool sample, int row  , int b, int t, int n, LAS float* wl, int lane) {
    LAS float* qbuf = wl; LAS float* pbuf = wl + 256; LAS float* impbuf = wl + 512;
    const bf16* H = (const bf16*)(AWS + WS_H); const float* HS = (const float*)(AWS + WS_HS);
    float slope[4];
#pragma unroll
    for (int g = 0; g < 4; ++g) slope[g] = exp2f(-(float)(n * 4 + g + 1));
    { f32x4 qv;
#pragma unroll
      for (int g = 0; g < 4; ++g) qv[g] = bf2f(H[(size_t)row * HW + HQ + (n * 4 + g) * 64 + lane]);
      wave_lds_sync(); *(LAS f32x4*)(qbuf + lane * 4) = qv; wave_lds_sync(); }
    const float tp = (float)t;
    const int ncb = sample ? 1 : 2;
    const float* KC = sample ? (const float*)(AWS + WS_KCS) + (size_t)b * 64 * 128 : (const float*)(AWS + WS_KCP) + (size_t)b * 128 * 128;
    const float* VC = sample ? (const float*)(AWS + WS_VCS) + (size_t)b * 64 * 128 : (const float*)(AWS + WS_VCP) + (size_t)b * 128 * 128;
    float sc[2][4]; bool cv[2];
#pragma unroll
    for (int blk = 0; blk < 2; ++blk) { const int cidx = blk * 64 + lane; cv[blk] = (blk < ncb) && (32 * cidx + 31 <= t);
        float dot[4] = {0.f, 0.f, 0.f, 0.f};
        if (blk < ncb) qk4(KC + ((size_t)cidx * 2 + n) * 64, qbuf, dot);
        const float dist = tp - (32.f * (float)cidx + 15.5f);
#pragma unroll
        for (int g = 0; g < 4; ++g) sc[blk][g] = cv[blk] ? (dot[g] * 0.125f - slope[g] * dist) : NEGV; }
    float ocmp[4] = {0.f, 0.f, 0.f, 0.f};
    { f32x4 p0, p1; float i0 = 0.f, i1 = 0.f;
#pragma unroll
      for (int g = 0; g < 4; ++g) { const float mx = wave_max(fmaxf(sc[0][g], sc[1][g]));
          const float e0 = cv[0] ? __expf(sc[0][g] - mx) : 0.f, e1 = cv[1] ? __expf(sc[1][g] - mx) : 0.f; const float sum = wave_sum(e0 + e1); const float inv = sum > 0.f ? 1.0f / sum : 0.f;
          p0[g] = e0 * inv; p1[g] = e1 * inv; i0 += p0[g]; i1 += p1[g]; }
      impbuf[lane] = i0; impbuf[64 + lane] = i1;
      *(LAS f32x4*)(pbuf + lane * 4) = p0; wave_lds_sync();
      pv4(VC + ((size_t)lane * 2 + n) * 64, pbuf, lane, ocmp); wave_lds_sync();
      if (ncb > 1) { *(LAS f32x4*)(pbuf + lane * 4) = p1; wave_lds_sync(); pv4(VC + ((size_t)(64 + lane) * 2 + n) * 64, pbuf, lane, ocmp); wave_lds_sync(); } }
    const int cur = t >> 6;
    unsigned long long mask = select_blocks(impbuf, lane, cur);
    OSm ss; os_init(ss);
    if (!sample) {
        while (mask) { const int j = __builtin_ctzll(mask); mask &= mask - 1;
            const int pos = j * 64 + lane; const bf16* kp = H + (size_t)(b * SEQ + pos) * HW + HKV + 256 + n * 64;
            attend_block<bf16>(ss, kp, kp + 128, pos <= t, (float)(t - pos), qbuf, pbuf, lane, slope); }
    } else {
        const int* ptab = (const int*)AIN(I_PTAB); const float* cache = (const float*)AIN(I_CACHE) + (size_t)l * NPOOL * 128 * 512;
        while (mask) { const int j = __builtin_ctzll(mask); mask &= mask - 1;
            if (j < 32) { const int page = ptab[b * NPG + (j >> 1)]; const float* kp = cache + ((size_t)page * 128 + (j & 1) * 64 + lane) * 512 + 256 + n * 64;
                attend_block<float>(ss, kp, kp + 128, true, (float)(t - (j * 64 + lane)), qbuf, pbuf, lane, slope); }
            else { const bf16* kp = H + (size_t)row * HW + HKV + 256 + n * 64; attend_block<bf16>(ss, kp, kp + 128, lane == 0, 0.f, qbuf, pbuf, lane, slope); } }
    }
    OSm sw; os_init(sw);
    if (!sample) {
        for (int blk = 0; blk < 8; ++blk) { const int p0 = t - 511 + blk * 64; if (p0 + 63 < 0) continue;
            const int pos = p0 + lane; const int pc = pos < 0 ? 0 : pos; const bf16* kp = H + (size_t)(b * SEQ + pc) * HW + HWIN + n * 64;
            attend_block<bf16>(sw, kp, kp + 128, pos >= 0, (float)(t - pos), qbuf, pbuf, lane, slope); }
    } else {
        const float* wst = (const float*)AIN(I_SWIN) + ((size_t)l * DB + b) * 512 * 256;
        for (int blk = 0; blk < 8; ++blk) { const int i = 1 + blk * 64 + lane; const int ic = i > 511 ? 511 : i; const float* kp = wst + (size_t)ic * 256 + n * 64;
            attend_block<float>(sw, kp, kp + 128, i <= 511, (float)(512 - i), qbuf, pbuf, lane, slope); }
        const bf16* kp = H + (size_t)row * HW + HWIN + n * 64; attend_block<bf16>(sw, kp, kp + 128, lane == 0, 0.f, qbuf, pbuf, lane, slope);
    }
    bf16* MIX = (bf16*)(AWS + WS_MIX);
#pragma unroll
    for (int g = 0; g < 4; ++g) { const int hq = n * 4 + g; const float* gp = HS + (size_t)row * 64 + hq * 3;
        const float g0 = sigmoidf_(gp[0]), g1 = sigmoidf_(gp[1]), g2 = sigmoidf_(gp[2]);
        const float osl = ss.l[g] > 0.f ? ss.o[g] / ss.l[g] : 0.f, owi = sw.l[g] > 0.f ? sw.o[g] / sw.l[g] : 0.f;
        MIX[(size_t)row * DM + hq * 64 + lane] = (bf16)f2bf(g0 * ocmp[g] + g1 * osl + g2 * owi); }
}

__device__ __forceinline__ void gdn_steps(const Ctx& c, int l, int row0, int nsteps, int hh, float (&S)[64], LAS float* wl, int lane) {
    const float* GQ = (const float*)(AWS + WS_GQ); const float* GK = (const float*)(AWS + WS_GK); const float* GV = (const float*)(AWS + WS_GV);
    const float* SC = (const float*)(AWS + WS_SC);
    const bf16* H = (const bf16*)(AWS + WS_H); bf16* MIX = (bf16*)(AWS + WS_MIX);
    const float nw = ((const float*)AIN(I_GNW))[l * 64 + lane];
    LAS float* kb = wl; LAS float* qb = wl + 64;
    size_t o = (size_t)row0 * 512 + hh * 64 + lane;
    float nk = GK[o], nq = GQ[o], nv = GV[o], ng = SC[((size_t)row0 * 8 + hh) * 4], nb = SC[((size_t)row0 * 8 + hh) * 4 + 1], nz = bf2f(H[(size_t)row0 * HW + HGZ + hh * 64 + lane]);
    for (int s = 0; s < nsteps; ++s) {
        const int m = row0 + s;
        const float kv = nk, qv = nq, vv = nv, gv = ng, bv = nb, zv = nz;
        if (s + 1 < nsteps) { const size_t o2 = (size_t)(m + 1) * 512 + hh * 64 + lane;
            nk = GK[o2]; nq = GQ[o2]; nv = GV[o2]; ng = SC[((size_t)(m + 1) * 8 + hh) * 4]; nb = SC[((size_t)(m + 1) * 8 + hh) * 4 + 1]; nz = bf2f(H[(size_t)(m + 1) * HW + HGZ + hh * 64 + lane]); }
        wave_lds_sync(); kb[lane] = kv; qb[lane] = qv; wave_lds_sync();
        const float al = gv;
        float u0 = 0.f, u1 = 0.f, u2 = 0.f, u3 = 0.f;
#pragma unroll
        for (int d = 0; d < 64; d += 4) { const f32x4 k4 = *(const LAS f32x4*)(kb + d); u0 += k4[0] * S[d]; u1 += k4[1] * S[d + 1]; u2 += k4[2] * S[d + 2]; u3 += k4[3] * S[d + 3]; }
        const float u = (u0 + u1) + (u2 + u3);
        const float w = bv * (vv - al * u);
        float o0 = 0.f, o1 = 0.f, o2 = 0.f, o3 = 0.f;
#pragma unroll
        for (int d = 0; d < 64; d += 4) { const f32x4 k4 = *(const LAS f32x4*)(kb + d); const f32x4 q4 = *(const LAS f32x4*)(qb + d);
            S[d] = al * S[d] + k4[0] * w; S[d + 1] = al * S[d + 1] + k4[1] * w; S[d + 2] = al * S[d + 2] + k4[2] * w; S[d + 3] = al * S[d + 3] + k4[3] * w;
            o0 += q4[0] * S[d]; o1 += q4[1] * S[d + 1]; o2 += q4[2] * S[d + 2]; o3 += q4[3] * S[d + 3]; }
        const float ov = (o0 + o1) + (o2 + o3);
        const float ms = wave_sum(ov * ov) * (1.f / 64.f);
        MIX[(size_t)m * DM + 512 + hh * 64 + lane] = (bf16)f2bf(ov * rsqrtf(ms + RMS_EPS) * nw * siluf_(zv));
    }
}

__device__ __forceinline__ float quad_sum(float v) {
    const float t = v + __int_as_float(__builtin_amdgcn_mov_dpp(__float_as_int(v), 0xB1, 0xF, 0xF, true));
    return t + __int_as_float(__builtin_amdgcn_mov_dpp(__float_as_int(t), 0x4E, 0xF, 0xF, true));
}
constexpr int GC_NS = 16, GC_KQ = 0, GC_SC = GC_NS * 128, GC_V = GC_SC + GC_NS * 4, GC_BUF = GC_V + GC_NS * 8;
typedef float f32x2 __attribute__((ext_vector_type(2)));
__device__ __forceinline__ float oct_sum_dpp(float v) {
    const float t = quad_sum(v);
    return t + __int_as_float(__builtin_amdgcn_mov_dpp(__float_as_int(t), 0x141, 0xF, 0xF, true));
}
__device__ __forceinline__ void gdn_chain8(const Ctx& c, int l, int b, int hh, int wq, LAS float* st, int lane) {
    const float* GQ = (const float*)(AWS + WS_GQ); const float* GK = (const float*)(AWS + WS_GK); const float* GV = (const float*)(AWS + WS_GV); const float* SC = (const float*)(AWS + WS_SC);
    float* OG = (float*)(AWS + WS_OG);
    const int j = lane & 7, ec = lane >> 3, e = wq * 8 + ec;
    const size_t row0 = (size_t)b * SEQ;
    f32x2 S2[4];
#pragma unroll
    for (int i = 0; i < 4; ++i) S2[i] = (f32x2){0.f, 0.f};
    f32x4 kq[8], scv, vv;
    const int w31 = lane & 31;
    const float* kqsrc = ((w31 < 16) ? GK : GQ) + hh * 64 + 4 * (w31 & 15);
    float* ogp = OG + (row0 + j) * 512 + hh * 64 + e;
#define GC_GLOAD(s0_) do { _Pragma("unroll") for (int x = 0; x < 8; ++x) kq[x] = *(const f32x4*)(kqsrc + (row0 + (s0_) + 2 * x + (lane >> 5)) * 512); \
        scv = *(const f32x4*)(SC + ((row0 + (s0_) + (lane & 15)) * 8 + hh) * 4); vv = *(const f32x4*)(GV + (row0 + (s0_) + (w31 >> 1)) * 512 + hh * 64 + wq * 8 + 4 * (lane & 1)); } while (0)
#define GC_LSTORE(buf_) do { LAS float* bb_ = st + (buf_) * GC_BUF; _Pragma("unroll") for (int x = 0; x < 8; ++x) *(LAS f32x4*)(bb_ + GC_KQ + (2 * x + (lane >> 5)) * 128 + 4 * w31) = kq[x]; \
        if (lane < 16) *(LAS f32x4*)(bb_ + GC_SC + lane * 4) = scv; if (lane < 32) *(LAS f32x4*)(bb_ + GC_V + (lane >> 1) * 8 + 4 * (lane & 1)) = vv; } while (0)
    GC_GLOAD(0); GC_LSTORE(0);
    for (int s0 = 0; s0 < SEQ; s0 += GC_NS) {
        const int buf = (s0 >> 4) & 1; const bool more = s0 + GC_NS < SEQ;
        if (more) GC_GLOAD(s0 + GC_NS);
        wave_lds_sync();
        const LAS float* bb = st + buf * GC_BUF;
        float osel = 0.f;
        f32x4 kA[2], qA[2], kB[2], qB[2], scA, scB; float vA, vB;
#define GC_RD(K_, Q_, SC_, V_, sp_) do { const LAS float* kr_ = bb + GC_KQ + (sp_) * 128 + 8 * j; _Pragma("unroll") for (int i = 0; i < 2; ++i) { K_[i] = *(const LAS f32x4*)(kr_ + 4 * i); Q_[i] = *(const LAS f32x4*)(kr_ + 64 + 4 * i); } \
            SC_ = *(const LAS f32x4*)(bb + GC_SC + (sp_) * 4); V_ = bb[GC_V + (sp_) * 8 + ec]; } while (0)
#define GC_STEP(K_, Q_, SC_, V_, sp_) do { \
            f32x2 k2[4], q2[4]; _Pragma("unroll") for (int i = 0; i < 2; ++i) { k2[2 * i] = (f32x2){K_[i][0], K_[i][1]}; k2[2 * i + 1] = (f32x2){K_[i][2], K_[i][3]}; q2[2 * i] = (f32x2){Q_[i][0], Q_[i][1]}; q2[2 * i + 1] = (f32x2){Q_[i][2], Q_[i][3]}; } \
            const float al = SC_[0]; const f32x2 al2 = (f32x2){al, al}; \
            f32x2 ua = k2[0] * S2[0], ub = k2[1] * S2[1]; ua = k2[2] * S2[2] + ua; ub = k2[3] * S2[3] + ub; \
            f32x2 ra = q2[0] * S2[0], rb = q2[1] * S2[1]; ra = q2[2] * S2[2] + ra; rb = q2[3] * S2[3] + rb; \
            f32x2 aS[4]; _Pragma("unroll") for (int i = 0; i < 4; ++i) aS[i] = al2 * S2[i]; \
            const f32x2 us = ua + ub; const float u = oct_sum_dpp(us[0] + us[1]); \
            const float w = SC_[1] * (V_ - al * u); const f32x2 w2 = (f32x2){w, w}; \
            _Pragma("unroll") for (int i = 0; i < 4; ++i) S2[i] = k2[i] * w2 + aS[i]; \
            const f32x2 rs = ra + rb; const float r = oct_sum_dpp(rs[0] + rs[1]); \
            const float o = fmaf(al, r, SC_[2] * w); \
            osel = (((sp_) & 7) == j) ? o : osel; \
            if (((sp_) & 7) == 7) ogp[(size_t)(s0 + ((sp_) & ~7)) * 512] = osel; asm volatile("" :: "v"(SC_[3]));   } while (0)
        GC_RD(kA, qA, scA, vA, 0);
#pragma unroll
        for (int sp = 0; sp < GC_NS; sp += 2) {
            GC_RD(kB, qB, scB, vB, sp + 1); __builtin_amdgcn_sched_barrier(0);
            GC_STEP(kA, qA, scA, vA, sp); __builtin_amdgcn_sched_barrier(0);
            if (sp + 2 < GC_NS) { GC_RD(kA, qA, scA, vA, sp + 2); } __builtin_amdgcn_sched_barrier(0);
            GC_STEP(kB, qB, scB, vB, sp + 1); __builtin_amdgcn_sched_barrier(0);
        }
#undef GC_RD
#undef GC_STEP
        if (more) GC_LSTORE(buf ^ 1);
    }
#undef GC_GLOAD
#undef GC_LSTORE
    float* o = AOUT + O_GSP + (((size_t)l * 4 + b) * 8 + hh) * 4096;
#pragma unroll
    for (int i = 0; i < 4; ++i) { o[(8 * j + 2 * i) * 64 + e] = S2[i][0]; o[(8 * j + 2 * i + 1) * 64 + e] = S2[i][1]; }
}
__device__ __forceinline__ void sample_combine(const Ctx& c, int l, int bn, int lane);
__device__ __forceinline__ void p4b_gdn_norm(const Ctx& c0, int l) {
    const Ctx c = relaunder(c0);
    const int gw = c.bid * 8 + c.wave, NGW = c.G * 8, lane = c.lane;
    const float* OG = (const float*)(AWS + WS_OG); const bf16* H = (const bf16*)(AWS + WS_H); bf16* MIX = (bf16*)(AWS + WS_MIX);
    const float nw = ((const float*)AIN(I_GNW))[l * 64 + lane];
    for (int bn = gw; bn < DB * 2; bn += NGW) sample_combine(c, l, bn, lane);
    for (int it = gw; it < MPR * 8; it += NGW) { const int hh = it & 7, m = it >> 3;
        const float ov = OG[(size_t)m * 512 + hh * 64 + lane]; const float zv = bf2f(H[(size_t)m * HW + HGZ + hh * 64 + lane]);
        const float ms = wave_sum_fast(ov * ov) * (1.f / 64.f);
        MIX[(size_t)m * DM + 512 + hh * 64 + lane] = (bf16)f2bf(ov * rsqrtf(ms + RMS_EPS) * nw * siluf_(zv)); }
}
__device__ __forceinline__ void gdn_item_prompt(const Ctx& c, int l, int b, int hh, LAS float* wl, int lane) {
    float S[64];
#pragma unroll
    for (int d = 0; d < 64; ++d) S[d] = 0.f;
    gdn_steps(c, l, b * SEQ, SEQ, hh, S, wl, lane);
    float* o = AOUT + O_GSP + (((size_t)l * 4 + b) * 8 + hh) * 4096;
#pragma unroll
    for (int d = 0; d < 64; ++d) o[d * 64 + lane] = S[d];
}
__device__ __forceinline__ void gdn_item_sample(const Ctx& c, int l, int b, int hh, LAS float* wl, int lane) {
    const float* s0 = (const float*)AIN(I_SGDN) + (((size_t)l * DB + b) * 8 + hh) * 4096;
    float S[64];
#pragma unroll
    for (int d = 0; d < 64; ++d) S[d] = s0[d * 64 + lane];
    gdn_steps(c, l, MPR + b, 1, hh, S, wl, lane);
    float* o = AOUT + O_GSS + (((size_t)l * DB + b) * 8 + hh) * 4096;
#pragma unroll
    for (int d = 0; d < 64; ++d) o[d * 64 + lane] = S[d];
}

typedef short bf16x8v __attribute__((ext_vector_type(8)));
typedef float f32x16 __attribute__((ext_vector_type(16)));
typedef short s16x4v __attribute__((ext_vector_type(4)));
typedef float f32x2v_ __attribute__((ext_vector_type(2))); typedef __bf16 bf16x2v_ __attribute__((ext_vector_type(2)));
__device__ __forceinline__ unsigned cvtpk(float lo, float hi) { f32x2v_ v = {lo, hi}; bf16x2v_ b = __builtin_convertvector(v, bf16x2v_); return __builtin_bit_cast(unsigned, b); }
__device__ __forceinline__ int crow(int r, int hi) { return (r & 3) + 8 * (r >> 2) + 4 * hi; }
constexpr int NL_KS = 0, NL_VS = 16384, NL_IMP = 32768, NL_IMPB = 4 * 64 * 65 * 4, NL_MASK = NL_IMP + NL_IMPB, NL_WSF = NL_MASK + 512, NL_END = NL_WSF + 8 * 256;
static_assert(NL_END <= RING_BYTES && CTLB + RING_BYTES <= LDS_BYTES, "nsa unit LDS");
constexpr float LOG2E = 1.4426950408889634f, C2S = 0.125f * 1.4426950408889634f, MCLAMP = -1.0e4f, SNEG = -1.0e30f;
struct NsaSm { float m, l; f32x16 o0, o1; };
__device__ __forceinline__ float rowmax32(const f32x16& p0, const f32x16& p1) {
    float a = fmaxf(fmaxf(p0[0], p0[1]), p1[0]), b = fmaxf(fmaxf(p0[2], p0[3]), p1[1]); a = fmaxf(fmaxf(a, p1[2]), p1[3]);
#pragma unroll
    for (int r = 4; r < 16; r += 4) { a = fmaxf(fmaxf(a, p0[r]), p0[r + 1]); b = fmaxf(fmaxf(b, p0[r + 2]), p0[r + 3]); a = fmaxf(fmaxf(a, p1[r]), p1[r + 1]); b = fmaxf(fmaxf(b, p1[r + 2]), p1[r + 3]); }
    const float m = fmaxf(a, b);
    auto rr = __builtin_amdgcn_permlane32_swap(__float_as_uint(m), __float_as_uint(m), false, false);
    return fmaxf(__uint_as_float(rr[0]), __uint_as_float(rr[1]));
}
__device__ __forceinline__ float halves_sum(float v) { auto rr = __builtin_amdgcn_permlane32_swap(__float_as_uint(v), __float_as_uint(v), false, false); return __uint_as_float(rr[0]) + __uint_as_float(rr[1]); }
__device__ __forceinline__ void nsa_qk(f32x16& p0, f32x16& p1, const LAS unsigned char* kslot, const bf16x8v (&qr)[4], int r32, int hi) {
    const LAS unsigned char* kb = kslot + hi * 1024 + r32 * 16;
    f32x16 z;
#pragma unroll
    for (int r = 0; r < 16; ++r) z[r] = 0.f;
    p0 = z; p1 = z;
#pragma unroll
    for (int d0 = 0; d0 < 4; ++d0) { const bf16x8v b0 = *(const LAS bf16x8v*)(kb + d0 * 2048), b1 = *(const LAS bf16x8v*)(kb + d0 * 2048 + 512);
        p0 = __builtin_amdgcn_mfma_f32_32x32x16_bf16(b0, qr[d0], p0, 0, 0, 0); p1 = __builtin_amdgcn_mfma_f32_32x32x16_bf16(b1, qr[d0], p1, 0, 0, 0); }
}
__device__ __forceinline__ void nsa_scores(f32x16& p0, f32x16& p1, float Ap, float slk, int thrp, bool flip) {
#pragma unroll
    for (int r = 0; r < 16; ++r) { const int cr = (r & 3) + 8 * (r >> 2);
        const bool v0 = (cr <= thrp) != flip, v1 = (cr + 32 <= thrp) != flip;
        p0[r] = v0 ? fmaf(p0[r], C2S, fmaf(slk, (float)cr, Ap)) : SNEG; p1[r] = v1 ? fmaf(p1[r], C2S, fmaf(slk, (float)(cr + 32), Ap)) : SNEG; }
}
__device__ __forceinline__ void nsa_pv(f32x16& o0, f32x16& o1, const f32x16& p0, const f32x16& p1, const LAS unsigned char* vslot, int lane, int hi) {
    u32x4 pw[4];
#pragma unroll
    for (int k = 0; k < 4; ++k) { pw[0][k] = cvtpk(p0[2 * k], p0[2 * k + 1]); pw[1][k] = cvtpk(p0[8 + 2 * k], p0[9 + 2 * k]); pw[2][k] = cvtpk(p1[2 * k], p1[2 * k + 1]); pw[3][k] = cvtpk(p1[8 + 2 * k], p1[9 + 2 * k]); }
    const LAS unsigned char* vp = vslot + ((lane >> 4) & 1) * 32 + (lane & 3) * 8 + (4 * hi + ((lane & 15) >> 2)) * 64;
#pragma unroll
    for (int ks = 0; ks < 4; ++ks) {
        const s16x4v a0 = __builtin_bit_cast(s16x4v, __builtin_amdgcn_ds_read_tr16_b64_v4i16((LAS s16x4v*)(vp + ks * 1024)));
        const s16x4v a1 = __builtin_bit_cast(s16x4v, __builtin_amdgcn_ds_read_tr16_b64_v4i16((LAS s16x4v*)(vp + ks * 1024 + 512)));
        const s16x4v b0 = __builtin_bit_cast(s16x4v, __builtin_amdgcn_ds_read_tr16_b64_v4i16((LAS s16x4v*)(vp + 4096 + ks * 1024)));
        const s16x4v b1 = __builtin_bit_cast(s16x4v, __builtin_amdgcn_ds_read_tr16_b64_v4i16((LAS s16x4v*)(vp + 4096 + ks * 1024 + 512)));
        const bf16x8v va = {a0[0], a0[1], a0[2], a0[3], a1[0], a1[1], a1[2], a1[3]}, vb = {b0[0], b0[1], b0[2], b0[3], b1[0], b1[1], b1[2], b1[3]};
        const bf16x8v pa = __builtin_bit_cast(bf16x8v, pw[ks]);
        o0 = __builtin_amdgcn_mfma_f32_32x32x16_bf16(pa, va, o0, 0, 0, 0); o1 = __builtin_amdgcn_mfma_f32_32x32x16_bf16(pa, vb, o1, 0, 0, 0); }
}
__device__ __forceinline__ void nsa_softmax_pv(NsaSm& st, f32x16& p0, f32x16& p1, const LAS unsigned char* vslot, LAS float* wsf, int lane, int r32, int hi) {
    const float rm = rowmax32(p0, p1); const float mn = fmaxf(st.m, rm); const float f = __builtin_amdgcn_exp2f(st.m - mn); st.m = mn;
    float s = 0.f;
#pragma unroll
    for (int r = 0; r < 16; ++r) { p0[r] = __builtin_amdgcn_exp2f(p0[r] - mn); p1[r] = __builtin_amdgcn_exp2f(p1[r] - mn); s += p0[r] + p1[r]; }
    st.l = st.l * f + s;
    if (__any(f != 1.0f)) { wave_lds_sync(); if (hi == 0) wsf[r32] = f; wave_lds_sync();
#pragma unroll
        for (int r = 0; r < 16; ++r) { const float fr = wsf[crow(r, hi)]; st.o0[r] *= fr; st.o1[r] *= fr; } }
    nsa_pv(st.o0, st.o1, p0, p1, vslot, lane, hi);
}
__device__ __forceinline__ void nsa_sm_init(NsaSm& st) { st.m = MCLAMP; st.l = 0.f;
#pragma unroll
    for (int r = 0; r < 16; ++r) { st.o0[r] = 0.f; st.o1[r] = 0.f; } }
__device__ __forceinline__ void nsa_fold(f32x16& f0, f32x16& f1, const f32x16& o0, const f32x16& o1, float fac, LAS float* wsf, int r32, int hi) {
    wave_lds_sync(); if (hi == 0) wsf[r32] = fac; wave_lds_sync();
#pragma unroll
    for (int r = 0; r < 16; ++r) { const float fr = wsf[crow(r, hi)]; f0[r] += o0[r] * fr; f1[r] += o1[r] * fr; }
}
#define NSA_LOADT(kb_, vb_, pitch_) do { int ln_ = lane; asm volatile("" : "+v"(ln_));   \
        kreg = *(const u32x4*)((kb_) + (unsigned)(ln_ * (pitch_) + wid * 8)); vreg = *(const u32x4*)((vb_) + (unsigned)((16 * (wid & 3) + (ln_ >> 2)) * (pitch_) + (wid >> 2) * 32 + (ln_ & 3) * 8)); } while (0)
#define NSA_STORET(slot_) do { *(LAS u32x4*)(lds + NL_KS + (slot_) * 8192 + wid * 1024 + lane * 16) = kreg; *(LAS u32x4*)(lds + NL_VS + (slot_) * 8192 + wid * 1024 + lane * 16) = vreg; } while (0)
__device__ __forceinline__ void nsa_unit(const Ctx& c, int l, int b, int n, int qt) {
    LAS unsigned char* lds = c.lds; const int lane = c.lane, wid = c.wave, r32 = lane & 31, hi = lane >> 5, g = wid >> 1, th = wid & 1;
    const int tq = th * 32 + r32, t0 = qt * 64, t = t0 + tq, hq = n * 4 + g;
    const float sl2 = exp2f(-(float)(hq + 1)) * LOG2E;
    LAS float* wsf = (LAS float*)(lds + NL_WSF + wid * 256); LAS float* imp = (LAS float*)(lds + NL_IMP); LAS unsigned long long* maskb = (LAS unsigned long long*)(lds + NL_MASK);
    const bf16* H = (const bf16*)(AWS + WS_H); const float* HS = (const float*)(AWS + WS_HS);
    const size_t rowbase = (size_t)b * SEQ;
    bf16x8v qr[4];
#pragma unroll
    for (int d0 = 0; d0 < 4; ++d0) qr[d0] = *(const bf16x8v*)(H + (rowbase + t) * HW + HQ + hq * 64 + d0 * 16 + hi * 8);
    const float* gp = HS + (rowbase + t) * 64 + hq * 3;
    const float gate0 = sigmoidf_(gp[0]), gate1 = sigmoidf_(gp[1]), gate2 = sigmoidf_(gp[2]);
    u32x4 kreg, vreg;
    f32x16 of0, of1;
    {
        const bf16* KCb = (const bf16*)(AWS + WS_KCB) + ((size_t)b * 128 * 2 + n) * 64; const bf16* VCb = (const bf16*)(AWS + WS_VCB) + ((size_t)b * 128 * 2 + n) * 64;
        const bool two = (t0 + 63 >= 64 * 32 + 31);
        NSA_LOADT(KCb, VCb, 128); NSA_STORET(0);
        if (two) { NSA_LOADT(KCb + 64 * 128, VCb + 64 * 128, 128); NSA_STORET(1); }
        __syncthreads();
        const int kq = (t >= 31) ? ((t - 31) >> 5) : -1; const float slk = 32.f * sl2;
        f32x16 a0, a1, b0, b1;
        nsa_qk(a0, a1, lds + NL_KS, qr, r32, hi);
        nsa_scores(a0, a1, -sl2 * ((float)t - 15.5f) + slk * (float)(4 * hi), slk, kq - 4 * hi, false);
        if (two) { nsa_qk(b0, b1, lds + NL_KS + 8192, qr, r32, hi); nsa_scores(b0, b1, -sl2 * ((float)t - 15.5f - 2048.f) + slk * (float)(4 * hi), slk, kq - 64 - 4 * hi, false); }
        else {
#pragma unroll
            for (int r = 0; r < 16; ++r) { b0[r] = SNEG; b1[r] = SNEG; } }
        const float mx = fmaxf(MCLAMP, fmaxf(rowmax32(a0, a1), rowmax32(b0, b1)));
        float s = 0.f;
#pragma unroll
        for (int r = 0; r < 16; ++r) { a0[r] = __builtin_amdgcn_exp2f(a0[r] - mx); a1[r] = __builtin_amdgcn_exp2f(a1[r] - mx); b0[r] = __builtin_amdgcn_exp2f(b0[r] - mx); b1[r] = __builtin_amdgcn_exp2f(b1[r] - mx); s += (a0[r] + a1[r]) + (b0[r] + b1[r]); }
        const float ltot = halves_sum(s); const float inv = ltot > 0.f ? 1.0f / ltot : 0.f;
        { LAS float* ip = imp + (size_t)(g * 64 + tq) * 65 + 2 * hi;
#pragma unroll
          for (int r = 0; r < 16; r += 2) { const int jb = ((r & 3) >> 1) + 4 * (r >> 2);
              ip[jb] = (a0[r] + a0[r + 1]) * inv; ip[16 + jb] = (a1[r] + a1[r + 1]) * inv; ip[32 + jb] = (b0[r] + b0[r + 1]) * inv; ip[48 + jb] = (b1[r] + b1[r + 1]) * inv; } }
        f32x16 o0, o1;
#pragma unroll
        for (int r = 0; r < 16; ++r) { o0[r] = 0.f; o1[r] = 0.f; of0[r] = 0.f; of1[r] = 0.f; }
        nsa_pv(o0, o1, a0, a1, lds + NL_VS, lane, hi);
        if (two) nsa_pv(o0, o1, b0, b1, lds + NL_VS + 8192, lane, hi);
        nsa_fold(of0, of1, o0, o1, gate0 * inv, wsf, r32, hi);
    }
    __syncthreads();
    {
#pragma unroll 1
        for (int i = 0; i < 8; ++i) { const int q = wid * 8 + i;
            const float iv = ((imp[(size_t)(0 * 64 + q) * 65 + lane] + imp[(size_t)(1 * 64 + q) * 65 + lane]) + imp[(size_t)(2 * 64 + q) * 65 + lane]) + imp[(size_t)(3 * 64 + q) * 65 + lane];
            const bool excl = lane > qt; const bool forced = (lane == 0) || (lane == qt) || (lane + 1 == qt);
            const float sc = excl ? -__builtin_inff() : (forced ? __builtin_inff() : iv);
            int cnt = 0; const int sci = __float_as_int(sc);
#pragma unroll 8
            for (int k = 0; k < 64; ++k) { const float si = __int_as_float(__builtin_amdgcn_readlane(sci, k)); cnt += ((si > sc) || (si == sc && k < lane)) ? 1 : 0; }
            const unsigned long long mk = __ballot(!excl && cnt < 16);
            if (lane == 0) maskb[q] = mk; }
    }
    __syncthreads();
    const unsigned long long mq = maskb[tq];
    unsigned long long uni;
    { unsigned lo = (unsigned)maskb[lane], hi32 = (unsigned)(maskb[lane] >> 32);
#pragma unroll
      for (int o = 1; o < 64; o <<= 1) { lo |= (unsigned)__shfl_xor((int)lo, o); hi32 |= (unsigned)__shfl_xor((int)hi32, o); }
      uni = ((unsigned long long)(unsigned)__builtin_amdgcn_readfirstlane((int)hi32) << 32) | (unsigned)__builtin_amdgcn_readfirstlane((int)lo); }
    {
        NsaSm st; nsa_sm_init(st);
        const bf16* Kb = H + rowbase * HW + HKV + 256 + n * 64; const bf16* Vb = Kb + 128;
        unsigned long long rem = uni; int j = __builtin_ctzll(rem); rem &= rem - 1;
        NSA_LOADT(Kb + (size_t)j * 64 * HW, Vb + (size_t)j * 64 * HW, HW); NSA_STORET(0); __syncthreads();
        int cur = 0;
        for (;;) {
            const bool more = rem != 0ull; int jn = 0;
            if (more) { jn = __builtin_ctzll(rem); rem &= rem - 1; NSA_LOADT(Kb + (size_t)jn * 64 * HW, Vb + (size_t)jn * 64 * HW, HW); }
            f32x16 p0, p1;
            nsa_qk(p0, p1, lds + NL_KS + cur * 8192, qr, r32, hi);
            const bool sel = (mq >> j) & 1ull; const int thr = sel ? (j < qt ? 64 : tq) : -1;
            nsa_scores(p0, p1, -sl2 * (float)(t - 64 * j) + sl2 * (float)(4 * hi), sl2, thr - 4 * hi, false);
            nsa_softmax_pv(st, p0, p1, lds + NL_VS + cur * 8192, wsf, lane, r32, hi);
            if (more) NSA_STORET(cur ^ 1);
            __syncthreads();
            if (!more) break;
            cur ^= 1; j = jn;
        }
        const float ltot = halves_sum(st.l); nsa_fold(of0, of1, st.o0, st.o1, ltot > 0.f ? gate1 / ltot : 0.f, wsf, r32, hi);
    }
    {
        NsaSm st; nsa_sm_init(st);
        const bf16* Kb = H + rowbase * HW + HWIN + n * 64; const bf16* Vb = Kb + 128;
        const int klast = qt - 8 < 0 ? 0 : qt - 8;
        int kt = qt;
        NSA_LOADT(Kb + (size_t)kt * 64 * HW, Vb + (size_t)kt * 64 * HW, HW); NSA_STORET(0); __syncthreads();
        int cur = 0;
        for (;;) {
            const bool more = kt > klast;
            if (more) NSA_LOADT(Kb + (size_t)(kt - 1) * 64 * HW, Vb + (size_t)(kt - 1) * 64 * HW, HW);
            f32x16 p0, p1;
            nsa_qk(p0, p1, lds + NL_KS + cur * 8192, qr, r32, hi);
            const int dl = qt - kt; const bool flip = (dl == 8); const int thr = (dl == 0 || dl == 8) ? tq : 64;
            nsa_scores(p0, p1, -sl2 * (float)(64 * dl + tq) + sl2 * (float)(4 * hi), sl2, thr - 4 * hi, flip);
            nsa_softmax_pv(st, p0, p1, lds + NL_VS + cur * 8192, wsf, lane, r32, hi);
            if (more) NSA_STORET(cur ^ 1);
            __syncthreads();
            if (!more) break;
            cur ^= 1; --kt;
        }
        const float ltot = halves_sum(st.l); nsa_fold(of0, of1, st.o0, st.o1, ltot > 0.f ? gate2 / ltot : 0.f, wsf, r32, hi);
    }
    {
        LAS bf16* stg = (LAS bf16*)(lds + NL_IMP + wid * 4096);
#pragma unroll
        for (int r = 0; r < 16; ++r) { const int orow = crow(r, hi); stg[orow * 64 + r32] = (bf16)f2bf(of0[r]); stg[orow * 64 + 32 + r32] = (bf16)f2bf(of1[r]); }
        wave_lds_sync();
        bf16* MIX = (bf16*)(AWS + WS_MIX) + (rowbase + t0 + th * 32) * DM + hq * 64;
#pragma unroll
        for (int i = 0; i < 4; ++i) { const int row = i * 8 + (lane >> 3), ch = lane & 7; const u32x4 v = *(const LAS u32x4*)(stg + row * 64 + ch * 8); *(u32x4*)(MIX + (size_t)row * DM + ch * 8) = v; }
    }
    __syncthreads();
}

__device__ __forceinline__ void unpack8(const u32x4 w, float (&x)[8]) {
#pragma unroll
    for (int j = 0; j < 4; ++j) { x[2 * j] = __uint_as_float(w[j] << 16); x[2 * j + 1] = __uint_as_float(w[j] & 0xffff0000u); } }
__device__ __forceinline__ float xor4_sum(float v) { return v + __shfl_xor(v, 4); }
__device__ __forceinline__ float oct_sum(float v) { return xor4_sum(quad_sum(v)); }
__device__ __forceinline__ void p3_gdn_rows(const Ctx& c, int l, int rg, int lane) {
    const int m0 = rg * 8; const bool first = (m0 & (SEQ - 1)) == 0;
    const bf16* H = (const bf16*)(AWS + WS_H); const float* HS = (const float*)(AWS + WS_HS);
    const float* cw = (const float*)AIN(I_GCW) + (size_t)l * 4 * GQKV;
    float gq[8][8]; float qk[8];
#pragma unroll
    for (int j = 0; j < 3; ++j) {
        const int col0 = j * 512 + lane * 8;
        u32x4 xr[11];
#pragma unroll
        for (int r = 0; r < 11; ++r) { if (r < 3 && first) xr[r] = (u32x4){0u, 0u, 0u, 0u}; else xr[r] = *(const u32x4*)(H + (size_t)(m0 + r - 3) * HW + HGQKV + col0); }
        float w[4][8];
#pragma unroll
        for (int i = 0; i < 4; ++i) { const f32x4 a = *(const f32x4*)(cw + i * GQKV + col0), b = *(const f32x4*)(cw + i * GQKV + col0 + 4);
#pragma unroll
            for (int q = 0; q < 4; ++q) { w[i][q] = a[q]; w[i][4 + q] = b[q]; } }
        float* dst = (float*)(AWS + (j == 0 ? WS_GQ : (j == 1 ? WS_GK : WS_GV)));
#pragma unroll
        for (int r = 0; r < 8; ++r) {
            float x0[8], x1[8], x2[8], x3[8]; unpack8(xr[r], x0); unpack8(xr[r + 1], x1); unpack8(xr[r + 2], x2); unpack8(xr[r + 3], x3);
            float y[8]; float ss = 0.f;
#pragma unroll
            for (int q = 0; q < 8; ++q) { const float a = w[0][q] * x0[q] + w[1][q] * x1[q] + w[2][q] * x2[q] + w[3][q] * x3[q]; y[q] = siluf_(a); ss += y[q] * y[q]; }
            if (j < 2) { const float sc = rsqrtf(oct_sum(ss) + RMS_EPS) * (j == 0 ? 0.125f : 1.0f);
#pragma unroll
                for (int q = 0; q < 8; ++q) y[q] *= sc; }
            if (j == 0) {
#pragma unroll
                for (int q = 0; q < 8; ++q) gq[r][q] = y[q]; }
            if (j == 1) { float d = 0.f;
#pragma unroll
                for (int q = 0; q < 8; ++q) d += gq[r][q] * y[q];
                qk[r] = oct_sum(d); }
            float* o = dst + (size_t)(m0 + r) * 512 + lane * 8;
            *(f32x4*)o = (f32x4){y[0], y[1], y[2], y[3]}; *(f32x4*)(o + 4) = (f32x4){y[4], y[5], y[6], y[7]};
        }
    }
    { const int hh = lane >> 3; const float al = -__expf(((const float*)AIN(I_ALOG))[l * 8 + hh]), dt = ((const float*)AIN(I_DTB))[l * 8 + hh];
      float* SC = (float*)(AWS + WS_SC);
#pragma unroll
      for (int r = 0; r < 8; ++r) { const float ai = HS[(size_t)(m0 + r) * 64 + 24 + hh], bi = HS[(size_t)(m0 + r) * 64 + 32 + hh];
          if ((lane & 7) == 0) *(f32x4*)(SC + ((size_t)(m0 + r) * 8 + hh) * 4) = (f32x4){__expf(al * softplusf_(ai + dt)), sigmoidf_(bi), qk[r], 0.f}; } }
}
__device__ __forceinline__ void p3_gdn_sample(const Ctx& c, int l, int it, int lane) {
    const int hh = it & 7, b = it >> 3, m = MPR + b;
    const bf16* H = (const bf16*)(AWS + WS_H); const float* HS = (const float*)(AWS + WS_HS);
    const float* cw = (const float*)AIN(I_GCW) + (size_t)l * 4 * GQKV; const float* sgc = (const float*)AIN(I_SGCONV) + (size_t)l * DB * 3 * GQKV;
    float y[3];
#pragma unroll
    for (int j = 0; j < 3; ++j) { const int cc = j * 512 + hh * 64 + lane;
        float acc = cw[3 * GQKV + cc] * bf2f(H[(size_t)m * HW + HGQKV + cc]);
#pragma unroll
        for (int i = 0; i < 3; ++i) acc += cw[i * GQKV + cc] * sgc[((size_t)b * 3 + i) * GQKV + cc];
        y[j] = siluf_(acc); }
    const float sq = wave_sum(y[0] * y[0]), sk = wave_sum(y[1] * y[1]);
    const size_t o = (size_t)m * 512 + hh * 64 + lane;
    const float gq = y[0] * rsqrtf(sq + RMS_EPS) * 0.125f, gk = y[1] * rsqrtf(sk + RMS_EPS);
    ((float*)(AWS + WS_GQ))[o] = gq; ((float*)(AWS + WS_GK))[o] = gk; ((float*)(AWS + WS_GV))[o] = y[2];
    const float qk = wave_sum(gq * gk);
    if (lane == 0) { const float ai = HS[(size_t)m * 64 + 24 + hh], bi = HS[(size_t)m * 64 + 32 + hh];
        const float gg = -__expf(((const float*)AIN(I_ALOG))[l * 8 + hh]) * softplusf_(ai + ((const float*)AIN(I_DTB))[l * 8 + hh]);
        *(f32x4*)((float*)(AWS + WS_SC) + ((size_t)m * 8 + hh) * 4) = (f32x4){__expf(gg), sigmoidf_(bi), qk, 0.f}; }
}
#define P3_MATVEC(o_, mean_, PHIEXPR_) do { _Pragma("unroll") for (int g_ = 0; g_ < 4; ++g_) o_[g_] = 0.f; \
        _Pragma("unroll 4") for (int d4 = 0; d4 < 16; ++d4) { f32x4 mv[4]; _Pragma("unroll") for (int g_ = 0; g_ < 4; ++g_) mv[g_] = *(const LAS f32x4*)((mean_) + g_ * 64 + 4 * d4); \
            _Pragma("unroll") for (int q_ = 0; q_ < 4; ++q_) { const int d = 4 * d4 + q_; const float p0 = PHIEXPR_(0, d), p1 = PHIEXPR_(1, d); \
                o_[0] += mv[0][q_] * p0; o_[1] += mv[1][q_] * p0; o_[2] += mv[2][q_] * p1; o_[3] += mv[3][q_] * p1; } } } while (0)
__device__ __forceinline__ void p3_cmp_prompt(const Ctx& c, int l, int it, LAS float* meanb, int lane) {
    const int cb = it & 127, b = it >> 7;
    const bf16* H = (const bf16*)(AWS + WS_H);
    const float* pe = (const float*)AIN(I_PE) + (size_t)l * 2 * 32 * 64; const float* phi = (const float*)AIN(I_PHI) + (size_t)l * 2 * 64 * 64;
    const int type = lane >> 5, d0 = (lane & 15) * 4;
    f32x4 acc = (f32x4){0.f, 0.f, 0.f, 0.f};
    u32x2 xr[32];
#pragma unroll
    for (int i = 0; i < 32; ++i) xr[i] = *(const u32x2*)(H + (size_t)(b * SEQ + cb * 32 + i) * HW + HKV + lane * 4);
#pragma unroll
    for (int i = 0; i < 32; ++i) { const f32x4 pv = *(const f32x4*)(pe + (type * 32 + i) * 64 + d0);
        acc[0] += __uint_as_float(xr[i].x << 16) + pv[0]; acc[1] += __uint_as_float(xr[i].x & 0xffff0000u) + pv[1]; acc[2] += __uint_as_float(xr[i].y << 16) + pv[2]; acc[3] += __uint_as_float(xr[i].y & 0xffff0000u) + pv[3]; }
    wave_lds_sync(); *(LAS f32x4*)(meanb + lane * 4) = acc * (1.f / 32.f); wave_lds_sync();
    float o[4];
#define PHIG(t_, d_) phi[((t_) * 64 + (d_)) * 64 + lane]
    P3_MATVEC(o, meanb, PHIG);
#undef PHIG
    bf16* KCB = (bf16*)(AWS + WS_KCB); bf16* VCB = (bf16*)(AWS + WS_VCB); const size_t ob = ((size_t)(b * 128 + cb) * 2) * 64 + lane;
    KCB[ob] = (bf16)f2bf(o[0]); KCB[ob + 64] = (bf16)f2bf(o[1]); VCB[ob] = (bf16)f2bf(o[2]); VCB[ob + 64] = (bf16)f2bf(o[3]);
}
__device__ __forceinline__ void p3_copy_chunk(const Ctx& c, int l, int kind, int chunk, int lane) {
    const bf16* H = (const bf16*)(AWS + WS_H);
    const int nun = kind == 0 ? DB * 512 : (kind == 1 ? 4 * 512 : (kind == 2 ? DB * 3 * 6 : 4 * 3 * 6));
    float* dstb = AOUT + (kind == 0 ? O_WINS + (size_t)l * DB * 512 * 256 : (kind == 1 ? O_WINP + (size_t)l * 4 * 512 * 256 : (kind == 2 ? O_GCS + (size_t)l * DB * 3 * GQKV : O_GCP + (size_t)l * 4 * 3 * GQKV)));
    const float* sw = (const float*)AIN(I_SWIN) + (size_t)l * DB * 512 * 256; const float* sgc = (const float*)AIN(I_SGCONV) + (size_t)l * DB * 3 * GQKV;
    f32x4 v[8];
#pragma unroll 1
    for (int h8 = 0; h8 < 4; ++h8) {
#pragma unroll
        for (int i = 0; i < 8; ++i) { const int u = chunk * 32 + h8 * 8 + i; v[i] = (f32x4){0.f, 0.f, 0.f, 0.f};
            if (u < nun) {
                const float* fs = nullptr; const bf16* bs = nullptr;
                if (kind == 0) { const int r = u & 511, b = u >> 9; if (r < 511) fs = sw + (size_t)(u + 1) * 256; else bs = H + (size_t)(MPR + b) * HW + HWIN; }
                else if (kind == 1) { const int r = u & 511, b = u >> 9; bs = H + (size_t)(b * SEQ + SEQ - 512 + r) * HW + HWIN; }
                else if (kind == 2) { const int seg = u % 6, row = u / 6, r = row % 3, b = row / 3; if (r < 2) fs = sgc + ((size_t)b * 3 + r + 1) * GQKV + seg * 256; else bs = H + (size_t)(MPR + b) * HW + HGQKV + seg * 256; }
                else { const int seg = u % 6, row = u / 6, r = row % 3, b = row / 3; bs = H + (size_t)(b * SEQ + SEQ - 3 + r) * HW + HGQKV + seg * 256; }
                if (fs) v[i] = *(const f32x4*)(fs + lane * 4);
                else { const u32x2 w = *(const u32x2*)(bs + lane * 4); v[i] = (f32x4){__uint_as_float(w.x << 16), __uint_as_float(w.x & 0xffff0000u), __uint_as_float(w.y << 16), __uint_as_float(w.y & 0xffff0000u)}; } } }
#pragma unroll
        for (int i = 0; i < 8; ++i) { const int u = chunk * 32 + h8 * 8 + i; if (u < nun) *(f32x4*)(dstb + (size_t)u * 256 + lane * 4) = v[i]; }
    }
}
constexpr int P3L_KC = 0, P3L_VC = 64 * 2 * 65 * 4, P3L_PHI = 2 * P3L_VC, P3L_MEAN = P3L_PHI + 32768, P3L_WV = P3L_MEAN + 8 * 1024, P3L_END = P3L_WV + 2 * 4096;
static_assert(P3L_END <= RING_BYTES, "p3 LDS");
__device__ __forceinline__ void p3_sample_seq(const Ctx& c, int l, int b) {
    LAS unsigned char* lds = c.lds; const int lane = c.lane, wid = c.wave;
    LAS float* KCl = (LAS float*)(lds + P3L_KC); LAS float* VCl = (LAS float*)(lds + P3L_VC); LAS float* PHI = (LAS float*)(lds + P3L_PHI); LAS float* meanb = (LAS float*)(lds + P3L_MEAN + wid * 1024);
    const float* pe = (const float*)AIN(I_PE) + (size_t)l * 2 * 32 * 64; const float* phi = (const float*)AIN(I_PHI) + (size_t)l * 2 * 64 * 64;
    const int* ptab = (const int*)AIN(I_PTAB); const float* cache = (const float*)AIN(I_CACHE) + (size_t)l * NPOOL * 128 * 512;
    for (int i = c.tid; i < 2048; i += 512) *(LAS f32x4*)(PHI + 4 * i) = *(const f32x4*)(phi + 4 * i);
    const int type = lane >> 5, d0 = (lane & 15) * 4;
    f32x4 pes = (f32x4){0.f, 0.f, 0.f, 0.f};
#pragma unroll 8
    for (int i = 0; i < 32; ++i) pes += *(const f32x4*)(pe + (type * 32 + i) * 64 + d0);
    __syncthreads();
#pragma unroll 1
    for (int cb = wid; cb < 64; cb += 8) {
        const int page = ptab[b * NPG + (cb >> 2)]; const float* src = cache + ((size_t)page * 128 + (cb & 3) * 32) * 512 + lane * 4;
        f32x4 acc = pes;
#pragma unroll 1
        for (int h = 0; h < 2; ++h) { f32x4 xr[16];
#pragma unroll
            for (int i = 0; i < 16; ++i) xr[i] = *(const f32x4*)(src + (size_t)(h * 16 + i) * 512);
#pragma unroll
            for (int i = 0; i < 16; ++i) acc += xr[i]; }
        wave_lds_sync(); *(LAS f32x4*)(meanb + lane * 4) = acc * (1.f / 32.f); wave_lds_sync();
        float o[4];
#define PHIL(t_, d_) PHI[((t_) * 64 + (d_)) * 64 + lane]
        P3_MATVEC(o, meanb, PHIL);
#undef PHIL
        KCl[(cb * 2 + 0) * 65 + lane] = o[0]; KCl[(cb * 2 + 1) * 65 + lane] = o[1]; VCl[(cb * 2 + 0) * 65 + lane] = o[2]; VCl[(cb * 2 + 1) * 65 + lane] = o[3];
    }
    __syncthreads();
    if (wid < 2) {
        const int n = wid, row = MPR + b; LAS float* wl = (LAS float*)(lds + P3L_WV + wid * 4096); LAS float* qbuf = wl; LAS float* pbuf = wl + 256; LAS float* impbuf = wl + 512;
        const bf16* H = (const bf16*)(AWS + WS_H);
        { f32x4 qv;
#pragma unroll
          for (int g = 0; g < 4; ++g) qv[g] = bf2f(H[(size_t)row * HW + HQ + (n * 4 + g) * 64 + lane]);
          *(LAS f32x4*)(qbuf + lane * 4) = qv; wave_lds_sync(); }
        float dot[4] = {0.f, 0.f, 0.f, 0.f}; const LAS float* kr = KCl + (lane * 2 + n) * 65;
#pragma unroll 8
        for (int d = 0; d < 64; ++d) { const float kv = kr[d]; const f32x4 q4 = *(const LAS f32x4*)(qbuf + d * 4);
#pragma unroll
            for (int g = 0; g < 4; ++g) dot[g] += kv * q4[g]; }
        const float dist = (float)PASTL - (32.f * (float)lane + 15.5f);
        f32x4 p; float imp = 0.f;
        float c8 = 0.125f; asm volatile("" : "+v"(c8));
#pragma unroll
        for (int g = 0; g < 4; ++g) { const float sv = dot[g] * c8 - exp2f(-(float)(n * 4 + g + 1)) * dist; const float mx = wave_max(sv); const float e = __expf(sv - mx); const float sum = wave_sum(e); p[g] = e / sum; imp += p[g]; }
        impbuf[lane] = imp; impbuf[64 + lane] = 0.f; *(LAS f32x4*)(pbuf + lane * 4) = p; wave_lds_sync();
        const unsigned long long mask = select_blocks(impbuf, lane, PASTL >> 6);
        float o[4] = {0.f, 0.f, 0.f, 0.f};
#pragma unroll 8
        for (int cc = 0; cc < 64; ++cc) { const float vv = VCl[(cc * 2 + n) * 65 + lane]; const f32x4 pc = *(const LAS f32x4*)(pbuf + cc * 4);
#pragma unroll
            for (int g = 0; g < 4; ++g) o[g] += pc[g] * vv; }
        if (lane == 0) ((unsigned long long*)(AWS + WS_SMASK))[b * 2 + n] = mask;
        float* oc = (float*)(AWS + WS_OCMP) + (size_t)(b * 2 + n) * 256;
#pragma unroll
        for (int g = 0; g < 4; ++g) oc[g * 64 + lane] = o[g];
    }
    __syncthreads();
}
__device__ __forceinline__ void p3_prep(const Ctx& c0, int l, int rep = 0) {
    const Ctx c = relaunder(c0);
    const int lane = c.lane;
    for (int b = c.bid; b < DB; b += c.G) p3_sample_seq(c, l, b);
    constexpr int N_A = MPR / 8, N_B = DB * 8, N_C = 4 * 128, N_D0 = DB * 512 / 32, N_D1 = 4 * 512 / 32, N_D2 = (DB * 3 * 6 + 31) / 32, N_D3 = (4 * 3 * 6 + 31) / 32;
    constexpr int E_A = N_A, E_B = E_A + N_B, E_C = E_B + N_C, E_D0 = E_C + N_D0, E_D1 = E_D0 + N_D1, E_D2 = E_D1 + N_D2, E_D3 = E_D2 + N_D3;
    unsigned* head = c.ctl + (l ? CW_P1 : CW_P0) + rep * 1024;
    LAS float* meanb = (LAS float*)(c.lds + c.wave * 4096);
    for (;;) {
        unsigned base = 0;
        if (lane == 0) base = __hip_atomic_fetch_add(head, 2u, __ATOMIC_RELAXED, __HIP_MEMORY_SCOPE_AGENT);
        base = (unsigned)__builtin_amdgcn_readfirstlane((int)base);
        if (base >= (unsigned)E_D3) break;
#pragma unroll 1
        for (int k = 0; k < 2; ++k) { const int it = (int)base + k; if (it >= E_D3) break;
            if (it < E_A) p3_gdn_rows(c, l, it, lane);
            else if (it < E_B) p3_gdn_sample(c, l, it - E_A, lane);
            else if (it < E_C) p3_cmp_prompt(c, l, it - E_B, meanb, lane);
            else if (it < E_D0) p3_copy_chunk(c, l, 0, it - E_C, lane);
            else if (it < E_D1) p3_copy_chunk(c, l, 1, it - E_D0, lane);
            else if (it < E_D2) p3_copy_chunk(c, l, 2, it - E_D1, lane);
            else p3_copy_chunk(c, l, 3, it - E_D2, lane); }
    }
}
__device__ __forceinline__ void sample_part(const Ctx& c, int l, int it, LAS float* wl, int lane) {
    const int p = it % 25, bn = it / 25, n = bn & 1, b = bn >> 1, row = MPR + b;
    LAS float* qbuf = wl; LAS float* pbuf = wl + 256;
    const bf16* H = (const bf16*)(AWS + WS_H);
    float slope[4];
#pragma unroll
    for (int g = 0; g < 4; ++g) slope[g] = exp2f(-(float)(n * 4 + g + 1));
    { f32x4 qv;
#pragma unroll
      for (int g = 0; g < 4; ++g) qv[g] = bf2f(H[(size_t)row * HW + HQ + (n * 4 + g) * 64 + lane]);
      wave_lds_sync(); *(LAS f32x4*)(qbuf + lane * 4) = qv; wave_lds_sync(); }
    OSm st; os_init(st);
    bool active = true, isb = false, valid = true; float dist = 0.f; const float* kpf = nullptr; const bf16* kpb = nullptr;
    if (p < 16) {
        const unsigned long long* mp = (const unsigned long long*)(AWS + WS_SMASK) + bn; unsigned long long mask = *mp;
        mask = ((unsigned long long)(unsigned)__builtin_amdgcn_readfirstlane((int)(unsigned)(mask >> 32)) << 32) | (unsigned)__builtin_amdgcn_readfirstlane((int)(unsigned)mask);
        for (int k = 0; k < p; ++k) mask &= mask - 1;
        if (!mask) active = false;
        else { const int j = __builtin_ctzll(mask);
            if (j < 32) { const int page = ((const int*)AIN(I_PTAB))[b * NPG + (j >> 1)]; kpf = (const float*)AIN(I_CACHE) + (size_t)l * NPOOL * 128 * 512 + ((size_t)page * 128 + (j & 1) * 64 + lane) * 512 + 256 + n * 64; dist = (float)(PASTL - (j * 64 + lane)); }
            else { isb = true; kpb = H + (size_t)row * HW + HKV + 256 + n * 64; valid = (lane == 0); } }
    } else if (p < 24) {
        const int i = 1 + (p - 16) * 64 + lane; const int ic = i > 511 ? 511 : i;
        kpf = (const float*)AIN(I_SWIN) + ((size_t)l * DB + b) * 512 * 256 + (size_t)ic * 256 + n * 64; valid = (i <= 511); dist = (float)(512 - i);
    } else { isb = true; kpb = H + (size_t)row * HW + HWIN + n * 64; valid = (lane == 0); }
    if (active) { if (isb) attend_block<bf16>(st, kpb, kpb + 128, valid, dist, qbuf, pbuf, lane, slope); else attend_block<float>(st, kpf, kpf + 128, valid, dist, qbuf, pbuf, lane, slope); }
    float* pt = (float*)(AWS + WS_PART) + (size_t)it * 264;
    if (lane == 0) { *(f32x4*)pt = (f32x4){st.m[0], st.m[1], st.m[2], st.m[3]}; *(f32x4*)(pt + 4) = (f32x4){st.l[0], st.l[1], st.l[2], st.l[3]}; }
#pragma unroll
    for (int g = 0; g < 4; ++g) pt[8 + g * 64 + lane] = st.o[g];
}
__device__ __forceinline__ void sample_combine(const Ctx& c, int l, int bn, int lane) {
    const int n = bn & 1, b = bn >> 1, row = MPR + b;
    const float* pt = (const float*)(AWS + WS_PART) + (size_t)bn * 25 * 264; const float* HS = (const float*)(AWS + WS_HS); const float* oc = (const float*)(AWS + WS_OCMP) + (size_t)bn * 256;
    float res[2][4];
#pragma unroll
    for (int br = 0; br < 2; ++br) { const int p0 = br ? 16 : 0, np = br ? 9 : 16;
        float M[4] = {NEGV, NEGV, NEGV, NEGV};
#pragma unroll 4
        for (int k = 0; k < np; ++k) { const f32x4 mv = *(const f32x4*)(pt + (size_t)(p0 + k) * 264);
#pragma unroll
            for (int g = 0; g < 4; ++g) M[g] = fmaxf(M[g], mv[g]); }
        float L[4] = {0.f, 0.f, 0.f, 0.f}, O[4] = {0.f, 0.f, 0.f, 0.f};
#pragma unroll 4
        for (int k = 0; k < np; ++k) { const float* pp = pt + (size_t)(p0 + k) * 264; const f32x4 mv = *(const f32x4*)pp, lv = *(const f32x4*)(pp + 4);
#pragma unroll
            for (int g = 0; g < 4; ++g) { const float f = __expf(mv[g] - M[g]); L[g] += lv[g] * f; O[g] += pp[8 + g * 64 + lane] * f; } }
#pragma unroll
        for (int g = 0; g < 4; ++g) res[br][g] = L[g] > 0.f ? O[g] / L[g] : 0.f; }
    bf16* MIX = (bf16*)(AWS + WS_MIX);
#pragma unroll
    for (int g = 0; g < 4; ++g) { const int hq = n * 4 + g; const float* gp = HS + (size_t)row * 64 + hq * 3;
        MIX[(size_t)row * DM + hq * 64 + lane] = (bf16)f2bf(sigmoidf_(gp[0]) * oc[g * 64 + lane] + sigmoidf_(gp[1]) * res[0][g] + sigmoidf_(gp[2]) * res[1][g]); }
}
__device__ __forceinline__ void p4_mixers(const Ctx& c0, int l, int rep = 0) {
    const Ctx c = relaunder(c0);
    LAS float* wl = (LAS float*)(c.lds + c.wave * 4096);
    const int lane = c.lane;
    if (!(rep && (AIN_DBL & 32))) {
        if (c.bid < 64 && c.wave < 4) { const int ci = c.bid * 4 + c.wave; gdn_chain8(c, l, ci >> 6, (ci >> 3) & 7, ci & 7, (LAS float*)(c.lds + 32768 + c.wave * 20480), lane); }
        else if (c.bid >= 64) {
            unsigned* head = c.ctl + (l ? CW_Q1 : CW_Q0) + rep * 1024;
            constexpr int N_GS = DB * 8, N_NS = DB * 2 * 25, N_ALL = N_GS + N_NS;
            for (;;) {
                unsigned it = 0;
                if (lane == 0) it = __hip_atomic_fetch_add(head, 1u, __ATOMIC_RELAXED, __HIP_MEMORY_SCOPE_AGENT);
                it = (unsigned)__builtin_amdgcn_readfirstlane((int)it);
                if (it >= (unsigned)N_ALL) break;
                if (it < (unsigned)N_NS) sample_part(c, l, (int)it, wl, lane);
                else { const int k = (int)it - N_NS; gdn_item_sample(c, l, k >> 3, k & 7, wl, lane); }
            }
        }
        __syncthreads();
    }
    {
        volatile LAS unsigned* slot = (volatile LAS unsigned*)(c.lds - CTLB + MISC_OFF + 64);
        for (;;) {
            if (c.wave == 0 && hw_lane() == 0) { unsigned* head = c.ctl + (l ? CW_U1 : CW_U0) + rep * 1024; *slot = __hip_atomic_fetch_add(head, 1u, __ATOMIC_RELAXED, __HIP_MEMORY_SCOPE_AGENT); }
            __syncthreads();
            const unsigned u = *slot;
            __syncthreads();
            if (u >= 512u) break;
            nsa_unit(c, l, (int)(u >> 1) & 3, (int)u & 1, 63 - (int)(u >> 3));
        }
    }
}

__device__ __forceinline__ void p_ln(const Ctx& c0, int l, int which, bool final_out) {
    const Ctx c = relaunder(c0);
    const int gw = c.bid * 8 + c.wave, NGW = c.G * 8, lane = c.lane;
    const float* T1 = (const float*)(AWS + WS_T1); float* XF = (float*)(AWS + WS_XF); bf16* XB = (bf16*)(AWS + WS_XB);
    const float* g = (const float*)AIN(I_LNG) + (size_t)(l * 3 + which) * DM; const float* bb = (const float*)AIN(I_LNB) + (size_t)(l * 3 + which) * DM;
    f32x4 gv[4], bv[4];
#pragma unroll
    for (int j = 0; j < 4; ++j) { gv[j] = *(const f32x4*)(g + lane * 4 + 256 * j); bv[j] = *(const f32x4*)(bb + lane * 4 + 256 * j); }
    f32x4 nx[4];
    if (gw < MTOT) {
#pragma unroll
        for (int j = 0; j < 4; ++j) nx[j] = *(const f32x4*)(T1 + (size_t)gw * DM + lane * 4 + 256 * j); }
    for (int m = gw; m < MTOT; m += NGW) {
        f32x4 v[4]; float s = 0.f;
#pragma unroll
        for (int j = 0; j < 4; ++j) { v[j] = nx[j]; s += (v[j][0] + v[j][1]) + (v[j][2] + v[j][3]); }
        if (m + NGW < MTOT) {
#pragma unroll
            for (int j = 0; j < 4; ++j) nx[j] = *(const f32x4*)(T1 + (size_t)(m + NGW) * DM + lane * 4 + 256 * j); }
        const float mean = wave_sum_fast(s) * (1.f / DM); float s2 = 0.f;
#pragma unroll
        for (int j = 0; j < 4; ++j) { v[j] = v[j] - mean; s2 += (v[j][0] * v[j][0] + v[j][1] * v[j][1]) + (v[j][2] * v[j][2] + v[j][3] * v[j][3]); }
        const float rstd = rsqrtf(wave_sum_fast(s2) * (1.f / DM) + LN_EPS);
        float* of = final_out ? (m < MPR ? AOUT + O_YP + (size_t)m * DM : AOUT + O_YS + (size_t)(m - MPR) * DM) : XF + (size_t)m * DM;
#pragma unroll
        for (int j = 0; j < 4; ++j) { const f32x4 y = v[j] * rstd * gv[j] + bv[j]; *(f32x4*)(of + lane * 4 + 256 * j) = y;
            if (!final_out) { u32x2 w; w.x = pk2(y[0], y[1]); w.y = pk2(y[2], y[3]); *(u32x2*)(XB + (size_t)m * DM + lane * 4 + 256 * j) = w; } }
    }
}

__device__ __forceinline__ float gelu_as(float v) {
    const float av = fabsf(v), t = __builtin_amdgcn_rcpf(av * 0.2316418882f + 1.0f);
    float q = t * 0.5307027145f + (-0.7265760135f); q = q * t + 0.7107068705f; q = q * t + (-0.142248368f); q = q * t + 0.127414796f; q = q * t;
    const float e = __builtin_amdgcn_exp2f((v * v) * (-0.72134752044f));
    const float m = v * (q * e);
    return v < 0.f ? m : v - m;
}
__device__ __forceinline__ float gelu_erf(float x) { return 0.5f * x * (1.0f + erff(x * 0.70710678118654752f)); }
__device__ __forceinline__ void p8_act(const Ctx& c0, int l) {
    const Ctx c = relaunder(c0);
    const int lane = c.lane, gw = c.bid * 8 + c.wave, NGW = c.G * 8;
    const bf16* UP = (const bf16*)(AWS + WS_UP); bf16* ACT = (bf16*)(AWS + WS_ACT);
    const float* fw = (const float*)AIN(I_FCW) + (size_t)l * 3 * DFF; const float* sfc = (const float*)AIN(I_SFCONV) + (size_t)l * DB * 2 * DFF;
    constexpr int NCG = DFF / 8, NCW = (NCG + 63) / 64, NRB = MPR / 16;
    for (int it = gw; it < NRB * NCW; it += NGW) {
        const int rb = it / NCW, cgi = (it % NCW) * 64 + lane; const bool on = cgi < NCG; const int cc = (on ? cgi : 0) * 8;
        const int m0 = rb * 16; const bool first = (m0 & (SEQ - 1)) == 0;
        float w0[8], w1[8], w2[8];
#pragma unroll
        for (int h = 0; h < 2; ++h) { const f32x4 a = *(const f32x4*)(fw + cc + 4 * h), b = *(const f32x4*)(fw + DFF + cc + 4 * h), d = *(const f32x4*)(fw + 2 * DFF + cc + 4 * h);
#pragma unroll
            for (int q = 0; q < 4; ++q) { w0[4 * h + q] = a[q]; w1[4 * h + q] = b[q]; w2[4 * h + q] = d[q]; } }
        float x2[8], x1[8];
        { u32x4 h2 = (u32x4){0u, 0u, 0u, 0u}, h1 = (u32x4){0u, 0u, 0u, 0u};
          if (!first) { h2 = *(const u32x4*)(UP + (size_t)(m0 - 2) * UPW + cc); h1 = *(const u32x4*)(UP + (size_t)(m0 - 1) * UPW + cc); }
          unpack8(h2, x2); unpack8(h1, x1); }
#pragma unroll 1
        for (int r8 = 0; r8 < 2; ++r8) {
            u32x4 ur[8], mr[8];
#pragma unroll
            for (int r = 0; r < 8; ++r) { ur[r] = *(const u32x4*)(UP + (size_t)(m0 + r8 * 8 + r) * UPW + cc); mr[r] = *(const u32x4*)(UP + (size_t)(m0 + r8 * 8 + r) * UPW + DFF + cc); }
#pragma unroll
            for (int r = 0; r < 8; ++r) { float x0[8], mu[8]; unpack8(ur[r], x0); unpack8(mr[r], mu);
                float y[8];
#pragma unroll
                for (int q = 0; q < 8; ++q) y[q] = gelu_as(w0[q] * x2[q] + w1[q] * x1[q] + w2[q] * x0[q]) * mu[q];
                u32x4 o; o.x = pk2(y[0], y[1]); o.y = pk2(y[2], y[3]); o.z = pk2(y[4], y[5]); o.w = pk2(y[6], y[7]);
                if (on) *(u32x4*)(ACT + (size_t)(m0 + r8 * 8 + r) * DFF + cc) = o;
#pragma unroll
                for (int q = 0; q < 8; ++q) { x2[q] = x1[q]; x1[q] = x0[q]; } }
        }
    }
    const size_t gt = (size_t)c.bid * 512 + c.tid, GT = (size_t)c.G * 512;
    constexpr int CPR = DFF / 4;
    for (size_t i = gt; i < (size_t)DB * CPR; i += GT) { const int b = (int)(i / CPR), cc = (int)(i % CPR) * 4, m = MPR + b;
        const u32x2 u0 = *(const u32x2*)(UP + (size_t)m * UPW + cc); const u32x2 um = *(const u32x2*)(UP + (size_t)m * UPW + DFF + cc);
        const float x0[4] = {__uint_as_float(u0.x << 16), __uint_as_float(u0.x & 0xffff0000u), __uint_as_float(u0.y << 16), __uint_as_float(u0.y & 0xffff0000u)};
        const float mu[4] = {__uint_as_float(um.x << 16), __uint_as_float(um.x & 0xffff0000u), __uint_as_float(um.y << 16), __uint_as_float(um.y & 0xffff0000u)};
        const f32x4 s0 = *(const f32x4*)(sfc + ((size_t)b * 2 + 0) * DFF + cc), s1 = *(const f32x4*)(sfc + ((size_t)b * 2 + 1) * DFF + cc);
        const f32x4 w0 = *(const f32x4*)(fw + cc), w1 = *(const f32x4*)(fw + DFF + cc), w2 = *(const f32x4*)(fw + 2 * DFF + cc);
        float r[4];
#pragma unroll
        for (int j = 0; j < 4; ++j) r[j] = gelu_as(w0[j] * s0[j] + w1[j] * s1[j] + w2[j] * x0[j]) * mu[j];
        u32x2 w; w.x = pk2(r[0], r[1]); w.y = pk2(r[2], r[3]); *(u32x2*)(ACT + (size_t)m * DFF + cc) = w; }
    { float* o = AOUT + O_FCP + (size_t)l * 4 * 2 * DFF;
      for (size_t i = gt; i < (size_t)4 * 2 * DFF; i += GT) { const int cc = (int)(i % DFF), r = (int)(i / DFF) & 1, b = (int)(i / (2 * DFF)); o[i] = bf2f(UP[(size_t)(b * SEQ + SEQ - 2 + r) * UPW + cc]); } }
    { float* o = AOUT + O_FCS + (size_t)l * DB * 2 * DFF;
      for (size_t i = gt; i < (size_t)DB * 2 * DFF; i += GT) { const int cc = (int)(i % DFF), r = (int)(i / DFF) & 1, b = (int)(i / (2 * DFF)); o[i] = (r == 0) ? sfc[i + DFF] : bf2f(UP[(size_t)(MPR + b) * UPW + cc]); } }
}

constexpr int NPH = 2 + 2 * 12;
__global__ void __launch_bounds__(512, 2) fwd_kernel(Args a) {
    extern __shared__ __attribute__((aligned(16))) unsigned char lds_raw[];
    Ctx c; c.lds = (LAS unsigned char*)lds_raw + CTLB; LAS unsigned char* lctl = (LAS unsigned char*)lds_raw; c.tid = threadIdx.x; c.lane = c.tid & 63; c.wave = __builtin_amdgcn_readfirstlane(c.tid >> 6); c.bid = blockIdx.x; c.G = gridDim.x;
    volatile LAS unsigned* MISC = (volatile LAS unsigned*)(lctl + MISC_OFF);
    if (c.tid < CTLB / 4) ((LAS unsigned*)lctl)[c.tid] = 0u;
    __syncthreads();
    { const unsigned* ap = (const unsigned*)&a; LAS unsigned* la = (LAS unsigned*)(lctl + ARGS_OFF); if (c.tid < 58) la[c.tid] = ap[c.tid]; c.la = la; }
    __syncthreads();
    c.ctl = (unsigned*)(AWS + WS_CTL);
    XcdBarrier bar; bar.bar = c.ctl + CW_BAR; bar.x = 0; bar.st = nullptr; bar.w0 = (c.wave == 0);
    const int lo = a.ph_lo, hi = a.ph_hi, dbl = a.dbl;
    if (hi - lo > 1 || dbl) { bar = xcd_barrier_post(c.ctl + CW_BAR, MISC + 8); bar.w0 = (c.wave == 0); }
#define GEMM_CALL(...) do { for (int rp = 0; rp <= ((dbl >> 4) & 1); ++rp) { if (rp) xcd_barrier(bar); __VA_ARGS__; } } while (0)
#define IN(k) (lo <= (k) && (k) < hi)
#define SEAM(k) do { if (IN(k) && IN((k) + 1)) xcd_barrier(bar); } while (0)
    const Ctx cb = c;
    LAS unsigned char* ring = cb.lds;
    if (IN(0)) { p0_prologue(cb); } SEAM(0);
    if (IN(1)) {
        const Ctx c = relaunder(cb);
        for (int l = 0; l < 2; ++l) {
            pg8::Gemm g{(const pg8::bf16_t*)(AWS + WS_PB) + (size_t)l * MPAD * PLED, (const pg8::bf16_t*)(AWS + WS_WPJ) + (size_t)l * DM * PLED, MPAD, DM, PLED};
            pg8::StaticOrder S; S.init(MPAD, DM, c.G, c.bid); pg8::EpiF32 E{(float*)(AWS + WS_PP) + (size_t)l * MPAD * DM, DM};
            pg8::gemm_phase<pg8::EpiF32, pg8::StaticOrder, false, false>(ring, g, S, E, c.wave); }
    } SEAM(1);
    for (int l = 0; l < 2; ++l) {
        const int p = 2 + l * 12;
        const Ctx c = relaunder(cb);
        if (IN(p + 0)) {
            pg8::Gemm g{(const pg8::bf16_t*)(AWS + WS_XB), (const pg8::bf16_t*)(AWS + WS_WIN) + (size_t)l * HW * DM, MPAD, HW, DM};
            pg8::StaticOrder S; S.init(MPAD, HW, c.G, c.bid);
            pg8::EpiIn E{(pg8::bf16_t*)(AWS + WS_H), (float*)(AWS + WS_HS), AOUT + O_KVP + (size_t)l * MPR * 512, AOUT + O_KVS + (size_t)l * DB * 512};
            GEMM_CALL(pg8::gemm_phase<pg8::EpiIn, pg8::StaticOrder, false, false>(ring, g, S, E, c.wave));
        } SEAM(p + 0);
        if (IN(p + 1)) { for (int rp = 0; rp <= (dbl & 1); ++rp) { if (rp) xcd_barrier(bar); p3_prep(c, l, rp); } } SEAM(p + 1);
        if (IN(p + 2)) { for (int rp = 0; rp <= ((dbl >> 1) & 1); ++rp) { if (rp) xcd_barrier(bar); p4_mixers(c, l, rp); } } SEAM(p + 2);
        if (IN(p + 3)) { p4b_gdn_norm(c, l); } SEAM(p + 3);
        if (IN(p + 4)) {
            pg8::Gemm g{(const pg8::bf16_t*)(AWS + WS_MIX), (const pg8::bf16_t*)(AWS + WS_WOUT) + (size_t)l * DM * DM, MPAD, DM, DM};
            pg8::StaticOrder S; S.init(MPAD, DM, c.G, c.bid); pg8::EpiRes E{(const float*)(AWS + WS_XF), (float*)(AWS + WS_T1)};
            GEMM_CALL(pg8::gemm_phase<pg8::EpiRes, pg8::StaticOrder, false, false>(ring, g, S, E, c.wave));
        } SEAM(p + 4);
        if (IN(p + 5)) { for (int rp = 0; rp <= ((dbl >> 2) & 1); ++rp) { if (rp) xcd_barrier(bar); p_ln(c, l, 0, false); } } SEAM(p + 5);
        if (IN(p + 6)) {
            pg8::Gemm g{(const pg8::bf16_t*)(AWS + WS_XB), (const pg8::bf16_t*)(AWS + WS_WUP) + (size_t)l * UPW * DM, MPAD, UPW, DM};
            pg8::StaticOrder S; S.init(MPAD, UPW, c.G, c.bid); pg8::EpiBf16<0> E{(pg8::bf16_t*)(AWS + WS_UP), UPW, nullptr, 0, 0, 1.f};
            GEMM_CALL(pg8::gemm_phase<pg8::EpiBf16<0>, pg8::StaticOrder, false, false>(ring, g, S, E, c.wave));
        } SEAM(p + 6);
        if (IN(p + 7)) { for (int rp = 0; rp <= ((dbl >> 3) & 1); ++rp) { if (rp) xcd_barrier(bar); p8_act(c, l); } } SEAM(p + 7);
        if (IN(p + 8)) {
            pg8::Gemm g{(const pg8::bf16_t*)(AWS + WS_ACT), (const pg8::bf16_t*)(AWS + WS_WDN) + (size_t)l * DM * DFF, MPAD, DM, DFF};
            pg8::StaticOrder S; S.init(MPAD, DM, c.G, c.bid); pg8::EpiRes E{(const float*)(AWS + WS_XF), (float*)(AWS + WS_T1)};
            GEMM_CALL(pg8::gemm_phase<pg8::EpiRes, pg8::StaticOrder, false, false>(ring, g, S, E, c.wave));
        } SEAM(p + 8);
        if (IN(p + 9)) { p_ln(c, l, 1, false); } SEAM(p + 9);
        if (IN(p + 10)) {
            pg8::Gemm g{(const pg8::bf16_t*)(AWS + WS_XB), (const pg8::bf16_t*)(AWS + WS_WGT) + (size_t)l * DM * DM, MPAD, DM, DM};
            pg8::StaticOrder S; S.init(MPAD, DM, c.G, c.bid); pg8::EpiGate E{(const float*)(AWS + WS_XF), (const float*)(AWS + WS_PP) + (size_t)l * MPAD * DM, (float*)(AWS + WS_T1)};
            GEMM_CALL(pg8::gemm_phase<pg8::EpiGate, pg8::StaticOrder, false, false>(ring, g, S, E, c.wave));
        } SEAM(p + 10);
        if (IN(p + 11)) { p_ln(c, l, 2, l == 1); } SEAM(p + 11);
    }
#undef IN
#undef SEAM
}

extern "C" void kernel_launch(void* const* d_in, const int* in_sizes, int n_in, void* d_out, int out_size, void* d_ws, size_t ws_size, hipStream_t stream) {
    static int grid = 0;
    if (grid == 0) {
        if (n_in != 25 || (size_t)out_size != O_END || ws_size < WS_END) { fprintf(stderr, "kernel_launch: unexpected shapes (n_in %d out %d ws %zu)\n", n_in, out_size, ws_size); grid = -1; return; }
        int dev = 0, cus = 0;
        if (hipGetDevice(&dev) != hipSuccess || hipDeviceGetAttribute(&cus, hipDeviceAttributeMultiprocessorCount, dev) != hipSuccess) { grid = -1; return; }
        if (hipFuncSetAttribute((const void*)fwd_kernel, hipFuncAttributeMaxDynamicSharedMemorySize, LDS_BYTES) != hipSuccess) { fprintf(stderr, "kernel_launch: hipFuncSetAttribute failed\n"); grid = -1; return; }
        int per_cu = 0; (void)hipOccupancyMaxActiveBlocksPerMultiprocessor(&per_cu, (const void*)fwd_kernel, 512, LDS_BYTES); (void)hipGetLastError();
        grid = cus;
    }
    if (grid < 0) return;
    (void)hipMemsetAsync((char*)d_ws + WS_CTL, 0, CTL_BYTES, stream);
    Args a{};
    for (int i = 0; i < 25; ++i) a.in[i] = d_in[i];
    a.out = (float*)d_out; a.ws = (unsigned char*)d_ws;
#if MK_MULTI
    for (int p = 0; p < NPH; ++p) { a.ph_lo = p; a.ph_hi = p + 1; hipLaunchKernelGGL(fwd_kernel, dim3(grid), dim3(512), LDS_BYTES, stream, a); }
#else
    a.ph_lo = 0; a.ph_hi = NPH; a.dbl = PROBE_DBL; hipLaunchKernelGGL(fwd_kernel, dim3(grid), dim3(512), LDS_BYTES, stream, a);
#endif
}
```

```cpp
#define PROBE_DBL 0
#include <hip/hip_runtime.h>
#include <cstdio>
#include <cstdint>
namespace pg8 {
#define PG8_LAS __attribute__((address_space(3)))
typedef unsigned short bf16_t;
typedef short bf16x8 __attribute__((ext_vector_type(8)));
typedef float f32x4 __attribute__((ext_vector_type(4)));
typedef unsigned u32x4 __attribute__((ext_vector_type(4)));
constexpr int BM = 256, BK = 64, HALF = 128, HTB = HALF * BK * 2  , STAGE_BYTES = 8 * HTB, NXCD = 8, WGM = 8;

__host__ __device__ __forceinline__ int lds_byte(int r, int c) { const int st = (r >> 4) * 2 + (c >> 5), rr = r & 15, cc = c & 31, ob = rr * 64 + cc * 2; return st * 1024 + (ob ^ (((ob >> 9) & 1) << 5)); }
__host__ __device__ __forceinline__ void stage_rc(int b, int& R, int& C) { const int st = b / 1024, sb = b % 1024, swz = sb ^ (((sb >> 9) & 1) << 5); R = (st >> 1) * 16 + swz / 64; C = (st & 1) * 32 + (swz % 64) / 2; }
__host__ __device__ __forceinline__ int perm32(int rho) { const int n = rho >> 4, i = rho & 15; return 8 * (i >> 2) + 4 * n + (i & 3); }

struct Unit { int pm, pn; };
struct Gemm { const bf16_t* A; const bf16_t* Bt; int M, N, K; };

struct StaticOrder {
    int nM, nN, nwg, G, c;
    __host__ __device__ void init(int M, int N, int G_, int c_) { nM = M / BM; nN = N / BM; nwg = nM * nN; G = G_; c = c_; }
    __host__ __device__ bool next(int i, Unit& u) const {
        const long L = (long)i * G + c; if (L >= nwg) return false;
        int wgid = (int)L; { const int q = nwg / NXCD, r = nwg % NXCD, xcd = wgid % NXCD, off = wgid / NXCD; wgid = (xcd < r ? xcd * (q + 1) : r * (q + 1) + (xcd - r) * q) + off; }
        const int nig = WGM * nN, gid = wgid / nig, fm = gid * WGM, gsz = (nM - fm) < WGM ? (nM - fm) : WGM;
        u.pm = fm + ((wgid % nig) % gsz); u.pn = (wgid % nig) / gsz; return true;
    }
    __device__ __forceinline__ void a_ready(const Unit&) const {}
    __device__ __forceinline__ void done(const Unit&) const {}
};

__device__ __forceinline__ unsigned cvt_pk_bf16(float lo, float hi) { unsigned r; asm volatile("v_cvt_pk_bf16_f32 %0, %1, %2" : "=v"(r) : "v"(lo), "v"(hi)); return r; }
typedef float f32x2 __attribute__((ext_vector_type(2)));
__device__ __forceinline__ f32x2 gelu_pk(f32x2 v) {
    const f32x2 av = __builtin_elementwise_abs(v), d = av * 0.2316418882f + 1.0f;
    f32x2 t; t.x = __builtin_amdgcn_rcpf(d.x); t.y = __builtin_amdgcn_rcpf(d.y);
    f32x2 q = t * 0.5307027145f + (-0.7265760135f); q = q * t + 0.7107068705f; q = q * t + (-0.142248368f); q = q * t + 0.127414796f; q = q * t;
    const f32x2 s = (v * v) * (-0.72134752044f);
    f32x2 e; e.x = __builtin_amdgcn_exp2f(s.x); e.y = __builtin_amdgcn_exp2f(s.y);
    const f32x2 m = v * (q * e), r = v - m;
    f32x2 o; o.x = v.x < 0.f ? m.x : r.x; o.y = v.y < 0.f ? m.y : r.y; return o;
}

template <int ACT  > struct EpiBf16 {
    static constexpr bool PERM = true, AFTER_DRAIN = false; static_assert(ACT == 0 || ACT == 1, "EpiBf16: ACT is 0 (none) or 1 (gelu_pk)");
    bf16_t* O; int ldc; const float* bias; int split_cols; size_t split_stride; float scale0;
    __device__ __forceinline__ void operator()(const f32x4 (&acc)[2][2][4][2], const Unit& u, int wr, int wc, int fr, int fq) const {
        const int row0 = u.pm * BM + wr * 64 + fr; int colt = u.pn * BM; bf16_t* base = O;
        float sc = 1.f; if (split_cols) { const int t = colt / split_cols; base += (size_t)t * split_stride; colt -= t * split_cols; if (t == 0) sc = scale0; }
        const int col0 = colt + wc * 32 + 8 * fq, bcol0 = u.pn * BM + wc * 32 + 8 * fq;
        f32x4 bv[2][2];
#pragma unroll
        for (int bj = 0; bj < 2; ++bj)
#pragma unroll
            for (int n = 0; n < 2; ++n) bv[bj][n] = bias ? *(const f32x4*)(bias + bcol0 + bj * HALF + 4 * n) : (f32x4){0.f, 0.f, 0.f, 0.f};
#pragma unroll
        for (int ai = 0; ai < 2; ++ai)
#pragma unroll
            for (int m = 0; m < 4; ++m) { bf16_t* rowp = base + (size_t)(row0 + ai * HALF + m * 16) * ldc + col0;
#pragma unroll
                for (int bj = 0; bj < 2; ++bj) { f32x4 v0 = acc[ai][bj][m][0] + bv[bj][0], v1 = acc[ai][bj][m][1] + bv[bj][1];
                    if (ACT == 1) { f32x2 a = gelu_pk((f32x2){v0[0], v0[1]}), b = gelu_pk((f32x2){v0[2], v0[3]}), c = gelu_pk((f32x2){v1[0], v1[1]}), d = gelu_pk((f32x2){v1[2], v1[3]});
                        v0 = (f32x4){a.x, a.y, b.x, b.y}; v1 = (f32x4){c.x, c.y, d.x, d.y}; }
                    v0 = v0 * sc; v1 = v1 * sc; u32x4 w; w.x = cvt_pk_bf16(v0[0], v0[1]); w.y = cvt_pk_bf16(v0[2], v0[3]); w.z = cvt_pk_bf16(v1[0], v1[1]); w.w = cvt_pk_bf16(v1[2], v1[3]);
                    *(u32x4*)(rowp + bj * HALF) = w; } }
    }
};
template <class Epi, class Sched, bool ALIGN_EPI = false, bool SP2 = false>
__device__ __forceinline__ void gemm_phase(PG8_LAS unsigned char* lds, const Gemm g, const Sched& S, const Epi& E, int wave_idx  ) {
    int tid_; asm volatile("v_mbcnt_lo_u32_b32 %0, -1, 0\n\tv_mbcnt_hi_u32_b32 %0, -1, %0" : "=v"(tid_)); tid_ += 64 * wave_idx;
    const int tid = tid_, wid = wave_idx, lane = tid & 63, wr = wid >> 2, wc = wid & 3, fr = lane & 15, fq = lane >> 4;
    const int K = g.K, nt = K / BK;
    unsigned voffA[2], voffB[2];
#pragma unroll
    for (int i = 0; i < 2; ++i) { int R, C; stage_rc(tid * 16 + i * 8192, R, C); const int Rb = Epi::PERM ? ((R & ~31) + perm32(R & 31)) : R;
        voffA[i] = (unsigned)(R * K + C) * 2u; voffB[i] = (unsigned)(Rb * K + C) * 2u; }
    const size_t kstep = (size_t)(BK * 2);
    const size_t hstep = (size_t)HALF * K * 2;
    const size_t tstep = 2 * hstep;
    const unsigned ldsw = (unsigned)wid * 1024u;
    const int aoff = lds_byte(wr * 64 + fr, fq * 8), boff = lds_byte(wc * 32 + fr, fq * 8);
#define PG8_SA(b, h) (((b) * 2 + (h)) * HTB)
#define PG8_SB(b, h) ((4 + (b) * 2 + (h)) * HTB)
#define PG8_STAGE(bufoff, gbase, voff) do { _Pragma("unroll") for (int _i = 0; _i < 2; ++_i) \
        __builtin_amdgcn_global_load_lds((const unsigned*)((const char*)(gbase) + (voff)[_i]), (PG8_LAS unsigned*)(lds + (bufoff) + ldsw + _i * 8192), 16, 0, 0); } while (0)
#define PG8_LDA(dst, b, h) do { _Pragma("unroll") for (int m = 0; m < 4; ++m) _Pragma("unroll") for (int k = 0; k < 2; ++k) dst[m][k] = *(const PG8_LAS bf16x8*)(lds + PG8_SA(b, h) + aoff + m * 2048 + k * 1024); } while (0)
#define PG8_LDB(dst, b, h) do { _Pragma("unroll") for (int n = 0; n < 2; ++n) _Pragma("unroll") for (int k = 0; k < 2; ++k) dst[n][k] = *(const PG8_LAS bf16x8*)(lds + PG8_SB(b, h) + boff + n * 2048 + k * 1024); } while (0)
#define PG8_MMA(ai, bj, At, Bt) do { __builtin_amdgcn_s_setprio(1); _Pragma("unroll") for (int m = 0; m < 4; ++m) _Pragma("unroll") for (int n = 0; n < 2; ++n) _Pragma("unroll") for (int k = 0; k < 2; ++k) \
        acc[ai][bj][m][n] = __builtin_amdgcn_mfma_f32_16x16x32_bf16(Bt[n][k], At[m][k], acc[ai][bj][m][n], 0, 0, 0); __builtin_amdgcn_s_setprio(0); } while (0)
#define PG8_WAIT_V(n) asm volatile("s_waitcnt vmcnt(" #n ")" ::: "memory")
#define PG8_WAIT_L(n) asm volatile("s_waitcnt lgkmcnt(" #n ")" ::: "memory")
#define PG8_BAR __builtin_amdgcn_s_barrier()
#define PG8_SCHED __builtin_amdgcn_sched_barrier(0)
    Unit cur, nxt; int ui = 0;
    if (!S.next(0, cur)) return;
    f32x4 acc[2][2][4][2];
#pragma unroll
    for (int a = 0; a < 2; ++a)
#pragma unroll
        for (int b = 0; b < 2; ++b)
#pragma unroll
            for (int m = 0; m < 4; ++m)
#pragma unroll
                for (int n = 0; n < 2; ++n) acc[a][b][m][n] = (f32x4){0.f, 0.f, 0.f, 0.f};
    bf16x8 At[4][2], B0[2][2], B1[2][2];
    const char* cA = (const char*)g.A + (size_t)cur.pm * tstep; const char* cB = (const char*)g.Bt + (size_t)cur.pn * tstep;
    S.a_ready(cur);
    if constexpr (SP2) {
        PG8_STAGE(PG8_SB(0, 0), cB, voffB); PG8_STAGE(PG8_SB(0, 1), cB + hstep, voffB); PG8_STAGE(PG8_SA(0, 0), cA, voffA); PG8_STAGE(PG8_SA(0, 1), cA + hstep, voffA);
        if (wr == 1) PG8_BAR;
        PG8_WAIT_V(2); PG8_BAR;
        PG8_STAGE(PG8_SB(1, 0), cB + kstep, voffB); PG8_STAGE(PG8_SA(1, 0), cA + kstep, voffA); PG8_STAGE(PG8_SB(1, 1), cB + hstep + kstep, voffB);
        PG8_WAIT_V(6); PG8_BAR;
    } else {
        PG8_STAGE(PG8_SB(0, 0), cB, voffB); PG8_STAGE(PG8_SA(0, 0), cA, voffA); PG8_STAGE(PG8_SB(0, 1), cB + hstep, voffB); PG8_STAGE(PG8_SA(0, 1), cA + hstep, voffA);
        if (wr == 1) PG8_BAR;
        PG8_WAIT_V(4); PG8_BAR;
        PG8_STAGE(PG8_SB(1, 0), cB + kstep, voffB); PG8_STAGE(PG8_SA(1, 0), cA + kstep, voffA); PG8_STAGE(PG8_SB(1, 1), cB + hstep + kstep, voffB);
        PG8_WAIT_V(6); PG8_BAR;
    }
    for (;;) {
        const bool has_next = S.next(ui + 1, nxt);
        const char* nA = has_next ? (const char*)g.A + (size_t)nxt.pm * tstep : cA; const char* nB = has_next ? (const char*)g.Bt + (size_t)nxt.pn * tstep : cB;
        for (int t = 0; t < nt; t += 2) {
            const bool last = (t == nt - 2);
            const char* a1 = cA + (size_t)(t + 1) * kstep;
            const char* a2 = last ? nA : cA + (size_t)(t + 2) * kstep; const char* b2 = last ? nB : cB + (size_t)(t + 2) * kstep;
            const char* a3 = a2 + kstep; const char* b3 = b2 + kstep;
            if (last && has_next) S.a_ready(nxt);
            if constexpr (SP2) {
            PG8_LDB(B0, 0, 0); PG8_LDB(B1, 0, 1); PG8_SCHED; PG8_LDA(At, 0, 0); PG8_STAGE(PG8_SA(1, 1), a1 + hstep, voffA);
            PG8_WAIT_V(8); PG8_WAIT_L(0); PG8_BAR; PG8_MMA(0, 0, At, B0); PG8_MMA(0, 1, At, B1); PG8_BAR; PG8_SCHED;
            PG8_LDA(At, 0, 1); PG8_STAGE(PG8_SB(0, 0), b2, voffB); PG8_STAGE(PG8_SB(0, 1), b2 + hstep, voffB); PG8_STAGE(PG8_SA(0, 0), a2, voffA);
            PG8_WAIT_V(8); PG8_WAIT_L(0); PG8_BAR; PG8_MMA(1, 0, At, B0); PG8_MMA(1, 1, At, B1); PG8_BAR; PG8_SCHED;
            PG8_LDB(B0, 1, 0); PG8_LDB(B1, 1, 1); PG8_SCHED; PG8_LDA(At, 1, 0); PG8_STAGE(PG8_SA(0, 1), a2 + hstep, voffA);
            PG8_WAIT_V(8); PG8_WAIT_L(0); PG8_BAR; PG8_MMA(0, 0, At, B0); PG8_MMA(0, 1, At, B1); PG8_BAR; PG8_SCHED;
            PG8_LDA(At, 1, 1); PG8_STAGE(PG8_SB(1, 0), b3, voffB); PG8_STAGE(PG8_SB(1, 1), b3 + hstep, voffB); PG8_STAGE(PG8_SA(1, 0), a3, voffA);
            PG8_WAIT_V(8); PG8_WAIT_L(0); PG8_BAR; PG8_MMA(1, 0, At, B0); PG8_MMA(1, 1, At, B1); PG8_BAR; PG8_SCHED;
            } else {
            PG8_LDB(B0, 0, 0); PG8_SCHED; PG8_LDA(At, 0, 0); PG8_STAGE(PG8_SA(1, 1), a1 + hstep, voffA);
            PG8_WAIT_L(8); PG8_BAR; PG8_WAIT_L(0); PG8_MMA(0, 0, At, B0); PG8_BAR; PG8_SCHED;
            PG8_LDB(B1, 0, 1); PG8_STAGE(PG8_SB(0, 0), b2, voffB);
            PG8_BAR; PG8_WAIT_L(0); PG8_MMA(0, 1, At, B1); PG8_BAR;
            PG8_LDA(At, 0, 1); PG8_STAGE(PG8_SA(0, 0), a2, voffA);
            PG8_BAR; PG8_WAIT_L(0); PG8_MMA(1, 0, At, B0); PG8_BAR; PG8_SCHED;
            PG8_STAGE(PG8_SB(0, 1), b2 + hstep, voffB);
            PG8_WAIT_V(6); PG8_BAR; PG8_MMA(1, 1, At, B1); PG8_BAR;
            PG8_LDB(B0, 1, 0); PG8_SCHED; PG8_LDA(At, 1, 0); PG8_STAGE(PG8_SA(0, 1), a2 + hstep, voffA);
            PG8_WAIT_L(8); PG8_BAR; PG8_WAIT_L(0); PG8_MMA(0, 0, At, B0); PG8_BAR; PG8_SCHED;
            PG8_LDB(B1, 1, 1); PG8_STAGE(PG8_SB(1, 0), b3, voffB);
            PG8_BAR; PG8_WAIT_L(0); PG8_MMA(0, 1, At, B1); PG8_BAR;
            PG8_LDA(At, 1, 1); PG8_STAGE(PG8_SA(1, 0), a3, voffA);
            PG8_BAR; PG8_WAIT_L(0); PG8_MMA(1, 0, At, B0); PG8_BAR; PG8_SCHED;
            PG8_STAGE(PG8_SB(1, 1), b3 + hstep, voffB);
            PG8_WAIT_V(6); PG8_BAR; PG8_MMA(1, 1, At, B1); PG8_BAR;
            }
        }
        if constexpr (ALIGN_EPI) { if (wr == 0) PG8_BAR; }
        if constexpr (!Epi::AFTER_DRAIN) { E(acc, cur, wr, wc, fr, fq); S.done(cur); }
        if (!has_next) break;
#pragma unroll
        for (int a = 0; a < 2; ++a)
#pragma unroll
            for (int b = 0; b < 2; ++b)
#pragma unroll
                for (int m = 0; m < 4; ++m)
#pragma unroll
                    for (int n = 0; n < 2; ++n) acc[a][b][m][n] = (f32x4){0.f, 0.f, 0.f, 0.f};
        cur = nxt; cA = nA; cB = nB; ++ui;
        if constexpr (ALIGN_EPI) { if (wr == 1) PG8_BAR; }
    }
    PG8_WAIT_V(0);
    if constexpr (!ALIGN_EPI) { if (wr == 0) PG8_BAR; }
    PG8_BAR;
    if constexpr (Epi::AFTER_DRAIN) { E.fused(acc, cur, wr, wc, fr, fq, lds, wid, lane); S.done(cur); }
#undef PG8_SA
#undef PG8_SB
#undef PG8_STAGE
#undef PG8_LDA
#undef PG8_LDB
#undef PG8_MMA
#undef PG8_WAIT_V
#undef PG8_WAIT_L
#undef PG8_BAR
#undef PG8_SCHED
}
}

#ifndef MK_MULTI
#define MK_MULTI 0
#endif
#ifndef PROBE_DBL
#define PROBE_DBL 0
#endif
#define LAS __attribute__((address_space(3)))
typedef unsigned short bf16;
typedef float f32x4 __attribute__((ext_vector_type(4)));
typedef unsigned u32x4 __attribute__((ext_vector_type(4)));
typedef unsigned u32x2 __attribute__((ext_vector_type(2)));

constexpr int DM = 1024, NBATCH = 4, SEQ = 4096, MPR = NBATCH * SEQ, DB = 128, MTOT = MPR + DB, MPAD = 16640;
constexpr int PASTL = 2048, NPOOL = 2560, NPG = 16;
constexpr int INW = 3368, HW = 3584, DFF = 2816, UPW = 5632, PLED = 256;
constexpr int HQ = 0, HKV = 512, HWIN = 1024, HGQKV = 1280, HGZ = 2816, HSM = 3328;
constexpr int GQKV = 1536;
constexpr float LN_EPS = 1e-5f, RMS_EPS = 1e-6f, NEGV = -1e30f;
constexpr float DN_ALPHA = 1.41421356237309515f;

constexpr size_t O_YP = 0, O_YS = O_YP + (size_t)MPR * DM, O_KVP = O_YS + (size_t)DB * DM, O_KVS = O_KVP + (size_t)2 * MPR * 512,
                 O_WINP = O_KVS + (size_t)2 * DB * 512, O_WINS = O_WINP + (size_t)2 * 4 * 512 * 256, O_GSP = O_WINS + (size_t)2 * DB * 512 * 256,
                 O_GSS = O_GSP + (size_t)2 * 4 * 8 * 4096, O_GCP = O_GSS + (size_t)2 * DB * 8 * 4096, O_GCS = O_GCP + (size_t)2 * 4 * 3 * GQKV,
                 O_FCP = O_GCS + (size_t)2 * DB * 3 * GQKV, O_FCS = O_FCP + (size_t)2 * 4 * 2 * DFF, O_END = O_FCS + (size_t)2 * DB * 2 * DFF;

constexpr size_t MiB = 1u << 20;
constexpr size_t alup(size_t x) { return (x + MiB - 1) & ~(MiB - 1); }
constexpr size_t WS_CTL = 0, CTL_BYTES = 1 * MiB;
constexpr size_t WS_WIN = WS_CTL + CTL_BYTES;
constexpr size_t WS_WOUT = WS_WIN + alup((size_t)2 * HW * DM * 2);
constexpr size_t WS_WUP = WS_WOUT + alup((size_t)2 * DM * DM * 2);
constexpr size_t WS_WDN = WS_WUP + alup((size_t)2 * UPW * DM * 2);
constexpr size_t WS_WGT = WS_WDN + alup((size_t)2 * DM * DFF * 2);
constexpr size_t WS_WPJ = WS_WGT + alup((size_t)2 * DM * DM * 2);
constexpr size_t WS_XF = WS_WPJ + alup((size_t)2 * DM * PLED * 2);
constexpr size_t WS_XB = WS_XF + alup((size_t)MPAD * DM * 4);
constexpr size_t WS_T1 = WS_XB + alup((size_t)MPAD * DM * 2);
constexpr size_t WS_H = WS_T1 + alup((size_t)MPAD * DM * 4);
constexpr size_t WS_HS = WS_H + alup((size_t)MPAD * HW * 2);
constexpr size_t WS_PB = WS_HS + alup((size_t)MPAD * 64 * 4);
constexpr size_t WS_PP = WS_PB + alup((size_t)2 * MPAD * PLED * 2);
constexpr size_t WS_MIX = WS_PP + alup((size_t)2 * MPAD * DM * 4);
constexpr size_t WS_UP = WS_MIX + alup((size_t)MPAD * DM * 2);
constexpr size_t WS_ACT = WS_UP + alup((size_t)MPAD * UPW * 2);
constexpr size_t WS_GQ = WS_ACT + alup((size_t)MPAD * DFF * 2);
constexpr size_t WS_GK = WS_GQ + alup((size_t)MTOT * 512 * 4);
constexpr size_t WS_GV = WS_GK + alup((size_t)MTOT * 512 * 4);
constexpr size_t WS_GG = WS_GV + alup((size_t)MTOT * 512 * 4);
constexpr size_t WS_GB = WS_GG + alup((size_t)MTOT * 8 * 4);
constexpr size_t WS_KCP = WS_GB + alup((size_t)MTOT * 8 * 4);
constexpr size_t WS_VCP = WS_KCP + alup((size_t)4 * 128 * 128 * 4);
constexpr size_t WS_KCS = WS_VCP + alup((size_t)4 * 128 * 128 * 4);
constexpr size_t WS_VCS = WS_KCS + alup((size_t)DB * 64 * 128 * 4);
constexpr size_t WS_KCB = WS_VCS + alup((size_t)DB * 64 * 128 * 4);
constexpr size_t WS_VCB = WS_KCB + alup((size_t)4 * 128 * 128 * 2);
constexpr size_t WS_SC = WS_VCB + alup((size_t)4 * 128 * 128 * 2);
constexpr size_t WS_OG = WS_SC + alup((size_t)MTOT * 8 * 4 * 4);
constexpr size_t WS_SMASK = WS_OG + alup((size_t)MPR * 512 * 4);
constexpr size_t WS_OCMP = WS_SMASK + alup((size_t)DB * 2 * 8);
constexpr size_t WS_PART = WS_OCMP + alup((size_t)DB * 2 * 256 * 4);
constexpr size_t WS_END = WS_PART + alup((size_t)DB * 2 * 25 * 264 * 4);
constexpr int CW_Q0 = 64, CW_Q1 = 128, CW_U0 = 192, CW_U1 = 256, CW_P0 = 320, CW_P1 = 384;
constexpr int CW_BAR = 4096;

constexpr int CTLB = 1024, RING_BYTES = 131072, MISC_OFF = 0, ARGS_OFF = 256, LDS_BYTES = 147456;

__device__ __forceinline__ float bf2f(bf16 v) { return __uint_as_float(((unsigned)v) << 16); }
__device__ __forceinline__ unsigned f2bf(float f) { unsigned u = __float_as_uint(f); return (u + 0x7fffu + ((u >> 16) & 1u)) >> 16; }
__device__ __forceinline__ unsigned pk2(float lo, float hi) { return f2bf(lo) | (f2bf(hi) << 16); }
__device__ __forceinline__ float wave_sum(float v) {
#pragma unroll
    for (int o = 1; o < 64; o <<= 1) v += __shfl_xor(v, o);
    return v;
}
__device__ __forceinline__ float wave_max(float v) {
#pragma unroll
    for (int o = 1; o < 64; o <<= 1) v = fmaxf(v, __shfl_xor(v, o));
    return v;
}
__device__ __forceinline__ float wave_sum_fast(float v) {
    float t = v + __int_as_float(__builtin_amdgcn_mov_dpp(__float_as_int(v), 0xB1, 0xF, 0xF, true));
    t = t + __int_as_float(__builtin_amdgcn_mov_dpp(__float_as_int(t), 0x4E, 0xF, 0xF, true));
    t = t + __int_as_float(__builtin_amdgcn_mov_dpp(__float_as_int(t), 0x141, 0xF, 0xF, true));
    t = t + __int_as_float(__builtin_amdgcn_mov_dpp(__float_as_int(t), 0x140, 0xF, 0xF, true));
    const int ti = __float_as_int(t);
    return (__int_as_float(__builtin_amdgcn_readlane(ti, 0)) + __int_as_float(__builtin_amdgcn_readlane(ti, 16))) + (__int_as_float(__builtin_amdgcn_readlane(ti, 32)) + __int_as_float(__builtin_amdgcn_readlane(ti, 48)));
}
__device__ __forceinline__ void wave_lds_sync() { asm volatile("s_waitcnt lgkmcnt(0)" ::: "memory"); }
__device__ __forceinline__ float sigmoidf_(float x) { return 1.0f / (1.0f + __expf(-x)); }
__device__ __forceinline__ float siluf_(float x) { return x / (1.0f + __expf(-x)); }
__device__ __forceinline__ float softplusf_(float x) { return fmaxf(x, 0.f) + log1pf(__expf(-fabsf(x))); }

#define XB_TMO      128
#define XB_XCNT(j)  (256  + 64 * (j))
#define XB_XSUB(j)  (1280 + 64 * (j))
#define XB_XGEN(j)  (2304 + 64 * (j))
#define XB_TOP      3328
#define XB_TOPGEN   3392
#define XCD_BAR_WORDS 3456
#define XB_SPIN_CAP (1u << 18)
__device__ __forceinline__ unsigned xb_ld(unsigned* p)              { return __hip_atomic_load(p, __ATOMIC_RELAXED, __HIP_MEMORY_SCOPE_AGENT); }
__device__ __forceinline__ unsigned xb_add(unsigned* p, unsigned v) { return __hip_atomic_fetch_add(p, v, __ATOMIC_RELAXED, __HIP_MEMORY_SCOPE_AGENT); }
__device__ __forceinline__ unsigned xb_xcc_id() { return (unsigned)__builtin_amdgcn_s_getreg((3 << 11) | 20) & 0xFu; }
#define XB_SPIN(cond, bar) do { unsigned _sp = 0; while (cond) { __builtin_amdgcn_s_sleep(1); \
    if ((++_sp & 255u) == 0u) { if (xb_ld(&(bar)[XB_TMO])) break; if (_sp > XB_SPIN_CAP) { atomicAdd(&(bar)[XB_TMO], 1u); break; } } } } while (0)
__device__ __forceinline__ int xb_lane() { int ln; asm volatile("v_mbcnt_lo_u32_b32 %0, -1, 0\n\tv_mbcnt_hi_u32_b32 %0, -1, %0" : "=v"(ln)); return ln; }
struct XcdBarrier { unsigned* bar; unsigned x; volatile LAS unsigned* st; bool w0;   };
__device__ __forceinline__ XcdBarrier xcd_barrier_post(unsigned* bar, volatile LAS unsigned* st) {
    XcdBarrier b; b.bar = bar; b.x = xb_xcc_id(); b.st = st;
    if (threadIdx.x == 0) (void)xb_add(&bar[XB_XCNT(b.x)], 1u);
    return b;
}
__device__ __forceinline__ void xcd_barrier_complete(unsigned* bar, unsigned x, unsigned& nloc, unsigned& nx) {
    const unsigned G = gridDim.x * gridDim.y * gridDim.z;
    unsigned sum, cnt, mine, sp = 0u;
    for (;;) {
        sum = 0u; cnt = 0u; mine = 0u;
#pragma unroll
        for (unsigned j = 0; j < 16; ++j) { const unsigned c = xb_ld(&bar[XB_XCNT(j)]); sum += c; cnt += (c > 0u) ? 1u : 0u; mine = (j == x) ? c : mine; }
        if (sum == G) break;
        __builtin_amdgcn_s_sleep(1);
        if ((++sp & 255u) == 0u) { if (xb_ld(&bar[XB_TMO])) break; if (sp > XB_SPIN_CAP) { atomicAdd(&bar[XB_TMO], 1u); break; } }
    }
    nloc = mine > 0u ? mine : 1u; nx = cnt > 0u ? cnt : 1u;
}
__device__ __forceinline__ void xcd_barrier(const XcdBarrier& b) {
    asm volatile("s_waitcnt vmcnt(0)" ::: "memory");
    __syncthreads();
    if (b.w0 && xb_lane() == 0) {
        unsigned* bar = b.bar; asm volatile("" : "+s"(bar));
        __builtin_amdgcn_s_waitcnt(0);
        unsigned nloc = b.st[0], nx = b.st[1];
        if (nloc == 0u) { xcd_barrier_complete(bar, b.x, nloc, nx); b.st[0] = nloc; b.st[1] = nx; }
        const unsigned old = xb_add(&bar[XB_XSUB(b.x)], 1u);
        const unsigned gen = old / nloc;
        if (old + 1u == (gen + 1u) * nloc) {
            __builtin_amdgcn_fence(__ATOMIC_RELEASE, "agent");
            asm volatile("s_waitcnt vmcnt(0)" ::: "memory");
            const unsigned og = xb_add(&bar[XB_TOP], 1u);
            const unsigned tg = og / nx;
            if (og + 1u == (tg + 1u) * nx) xb_add(&bar[XB_TOPGEN], 1u);
            else XB_SPIN(xb_ld(&bar[XB_TOPGEN]) == tg, bar);
            __builtin_amdgcn_fence(__ATOMIC_ACQUIRE, "agent");
            xb_add(&bar[XB_XGEN(b.x)], 1u);
            asm volatile("s_waitcnt vmcnt(0)" ::: "memory");
        } else {
            XB_SPIN(xb_ld(&bar[XB_XGEN(b.x)]) == gen, bar);
            __builtin_amdgcn_fence(__ATOMIC_ACQUIRE, "agent");
            asm volatile("s_waitcnt vmcnt(0)" ::: "memory");
        }
    }
    __syncthreads();
}

struct Args { const void* in[25]; float* out; unsigned char* ws; int ph_lo, ph_hi, dbl, pad; };
enum { I_XP = 0, I_XS, I_CACHE, I_SWIN, I_SGDN, I_SGCONV, I_SFCONV, I_PTAB, I_PP, I_PS, I_WIN, I_PE, I_PHI, I_GCW, I_ALOG, I_DTB, I_GNW, I_WOUT, I_LNG, I_LNB, I_WUP, I_FCW, I_WDN, I_WPJ, I_WGT };

namespace pg8 {
struct EpiIn {
    static constexpr bool PERM = true, AFTER_DRAIN = false;
    bf16_t* H; float* HS; float* kvp; float* kvs;
    __device__ __forceinline__ void operator()(const f32x4 (&acc)[2][2][4][2], const Unit& u, int wr, int wc, int fr, int fq) const {
        const int row0 = u.pm * BM + wr * 64 + fr, col0 = u.pn * BM + wc * 32 + 8 * fq;
        const bool iskv = (u.pn == 2 || u.pn == 3), issm = (u.pn == 13);
#pragma unroll
        for (int ai = 0; ai < 2; ++ai)
#pragma unroll
            for (int m = 0; m < 4; ++m) { const int r = row0 + ai * HALF + m * 16;
#pragma unroll
                for (int bj = 0; bj < 2; ++bj) { const int c = col0 + bj * HALF; const f32x4 v0 = acc[ai][bj][m][0], v1 = acc[ai][bj][m][1];
                    u32x4 w; w.x = cvt_pk_bf16(v0[0], v0[1]); w.y = cvt_pk_bf16(v0[2], v0[3]); w.z = cvt_pk_bf16(v1[0], v1[1]); w.w = cvt_pk_bf16(v1[2], v1[3]);
                    *(u32x4*)(H + (size_t)r * HW + c) = w;
                    if (iskv) { float* dst = nullptr; if (r < MPR) dst = kvp + (size_t)r * 512 + (c - HKV); else if (r < MTOT) dst = kvs + (size_t)(r - MPR) * 512 + (c - HKV);
                        if (dst) { *(f32x4*)dst = v0; *(f32x4*)(dst + 4) = v1; } }
                    if (issm && (c - HSM) < 64) { float* dst = HS + (size_t)r * 64 + (c - HSM); *(f32x4*)dst = v0; *(f32x4*)(dst + 4) = v1; } } }
    }
};
struct EpiRes {
    static constexpr bool PERM = false, AFTER_DRAIN = false;
    const float* XF; float* T1;
    __device__ __forceinline__ void operator()(const f32x4 (&acc)[2][2][4][2], const Unit& u, int wr, int wc, int fr, int fq) const {
        const int row0 = u.pm * BM + wr * 64 + fr, col0 = u.pn * BM + wc * 32 + 4 * fq;
#pragma unroll
        for (int ai = 0; ai < 2; ++ai)
#pragma unroll
            for (int m = 0; m < 4; ++m) { const size_t off = (size_t)(row0 + ai * HALF + m * 16) * DM + col0;
#pragma unroll
                for (int bj = 0; bj < 2; ++bj)
#pragma unroll
                    for (int n = 0; n < 2; ++n) { const size_t o = off + bj * HALF + n * 16; const f32x4 xv = *(const f32x4*)(XF + o); *(f32x4*)(T1 + o) = xv * DN_ALPHA + acc[ai][bj][m][n]; } }
    }
};
struct EpiGate {
    static constexpr bool PERM = false, AFTER_DRAIN = false;
    const float* XF; const float* PP; float* T1;
    __device__ __forceinline__ void operator()(const f32x4 (&acc)[2][2][4][2], const Unit& u, int wr, int wc, int fr, int fq) const {
        const int row0 = u.pm * BM + wr * 64 + fr, col0 = u.pn * BM + wc * 32 + 4 * fq;
#pragma unroll
        for (int ai = 0; ai < 2; ++ai)
#pragma unroll
            for (int m = 0; m < 4; ++m) { const size_t off = (size_t)(row0 + ai * HALF + m * 16) * DM + col0;
#pragma unroll
                for (int bj = 0; bj < 2; ++bj)
#pragma unroll
                    for (int n = 0; n < 2; ++n) { const size_t o = off + bj * HALF + n * 16; const f32x4 xv = *(const f32x4*)(XF + o), pv = *(const f32x4*)(PP + o); const f32x4 a = acc[ai][bj][m][n]; f32x4 s;
#pragma unroll
                        for (int j = 0; j < 4; ++j) s[j] = 1.0f / (1.0f + __expf(-a[j]));
                        *(f32x4*)(T1 + o) = xv * DN_ALPHA + s * pv; } }
    }
};
struct EpiF32 {
    static constexpr bool PERM = false, AFTER_DRAIN = false;
    float* C; int ldc;
    __device__ __forceinline__ void operator()(const f32x4 (&acc)[2][2][4][2], const Unit& u, int wr, int wc, int fr, int fq) const {
        const int row0 = u.pm * BM + wr * 64 + fr, col0 = u.pn * BM + wc * 32 + 4 * fq;
#pragma unroll
        for (int ai = 0; ai < 2; ++ai)
#pragma unroll
            for (int m = 0; m < 4; ++m) { float* rowp = C + (size_t)(row0 + ai * HALF + m * 16) * ldc + col0;
#pragma unroll
                for (int bj = 0; bj < 2; ++bj)
#pragma unroll
                    for (int n = 0; n < 2; ++n) *(f32x4*)(rowp + bj * HALF + n * 16) = acc[ai][bj][m][n]; }
    }
};
}

struct Ctx { int tid, lane, wave, bid, G; LAS unsigned char* lds; unsigned* ctl; const LAS unsigned* la; };
#define GAS __attribute__((address_space(1)))
__device__ __forceinline__ const void* ld_ptr(const LAS unsigned* p0) { const volatile LAS unsigned* p = p0;
    const unsigned lo = (unsigned)__builtin_amdgcn_readfirstlane((int)p[0]), hi = (unsigned)__builtin_amdgcn_readfirstlane((int)p[1]);
    return (const void*)(const GAS void*)(uintptr_t)(((unsigned long long)hi << 32) | lo); }
__device__ __forceinline__ int hw_lane() { int ln; asm volatile("v_mbcnt_lo_u32_b32 %0, -1, 0\n\tv_mbcnt_hi_u32_b32 %0, -1, %0" : "=v"(ln)); return ln; }
__device__ __forceinline__ Ctx relaunder(const Ctx& c0) { Ctx c = c0; int w = c0.wave; asm volatile("" : "+s"(w) :: "memory"); int ln = hw_lane(); asm volatile("" : "+v"(ln) :: "memory"); c.wave = w; c.lane = ln; c.tid = w * 64 + ln; int b = c0.bid; asm volatile("" : "+s"(b) :: "memory"); c.bid = b; return c; }
#define AIN(i) ld_ptr(c.la + 2 * (i))
#define AOUT ((float*)ld_ptr(c.la + 50))
#define AWS ((unsigned char*)ld_ptr(c.la + 52))
#define AIN_DBL (__builtin_amdgcn_readfirstlane((int)((const volatile LAS unsigned*)c.la)[56]))

__device__ __forceinline__ int in_colmap(int n) {
    if (n < HGQKV) return n;
    if (n < HGZ) return 1304 + (n - HGQKV);
    if (n < HSM) return 2856 + (n - HGZ);
    if (n < HSM + 24) return 1280 + (n - HSM);
    if (n < HSM + 32) return 2840 + (n - HSM - 24);
    if (n < HSM + 40) return 2848 + (n - HSM - 32);
    return -1;
}
__device__ __forceinline__ void p0_prologue(const Ctx& c0) {
    const Ctx c = relaunder(c0);
    LAS float* tile = (LAS float*)c.lds;
    constexpr int T_IN = (HW / 64) * (DM / 64), T_OUT = 16 * 16, T_UP = (UPW / 64) * 16, T_DN = 16 * (DFF / 64), T_GT = 256, T_PJ = 16 * (PLED / 64);
    constexpr int T_L = T_IN + T_OUT + T_UP + T_DN + T_GT + T_PJ;
    for (int it = c.bid; it < 2 * T_L; it += c.G) {
        const int l = it / T_L; int r = it % T_L;
        const float* W; bf16* WT; int K, Ns, mode = 0;
        if (r < T_IN) { W = (const float*)AIN(I_WIN) + (size_t)l * DM * INW; K = DM; Ns = INW; WT = (bf16*)(AWS + WS_WIN) + (size_t)l * HW * DM; mode = 1; }
        else if ((r -= T_IN) < T_OUT) { W = (const float*)AIN(I_WOUT) + (size_t)l * DM * DM; K = DM; Ns = DM; WT = (bf16*)(AWS + WS_WOUT) + (size_t)l * DM * DM; }
        else if ((r -= T_OUT) < T_UP) { W = (const float*)AIN(I_WUP) + (size_t)l * DM * UPW; K = DM; Ns = UPW; WT = (bf16*)(AWS + WS_WUP) + (size_t)l * UPW * DM; }
        else if ((r -= T_UP) < T_DN) { W = (const float*)AIN(I_WDN) + (size_t)l * DFF * DM; K = DFF; Ns = DM; WT = (bf16*)(AWS + WS_WDN) + (size_t)l * DM * DFF; }
        else if ((r -= T_DN) < T_GT) { W = (const float*)AIN(I_WGT) + (size_t)l * DM * DM; K = DM; Ns = DM; WT = (bf16*)(AWS + WS_WGT) + (size_t)l * DM * DM; }
        else { r -= T_GT; W = (const float*)AIN(I_WPJ) + (size_t)l * PLED * DM; K = PLED; Ns = DM; WT = (bf16*)(AWS + WS_WPJ) + (size_t)l * DM * PLED; }
        const int nk = K / 64, tn = r / nk, tk = r % nk, n0 = tn * 64, k0 = tk * 64;
        { const int nn = c.tid & 63; const int nd = n0 + nn; const int sc = mode ? in_colmap(nd) : nd;
#pragma unroll
          for (int q = 0; q < 8; ++q) { const int kk = q * 8 + (c.tid >> 6); tile[kk * 65 + nn] = (sc >= 0) ? W[(size_t)(k0 + kk) * Ns + sc] : 0.f; } }
        __syncthreads();
        { const int n = c.tid >> 3, kc = (c.tid & 7) * 8; const LAS float* s = tile + kc * 65 + n;
          u32x4 o; o.x = pk2(s[0], s[65]); o.y = pk2(s[2 * 65], s[3 * 65]); o.z = pk2(s[4 * 65], s[5 * 65]); o.w = pk2(s[6 * 65], s[7 * 65]);
          *(u32x4*)(WT + (size_t)(n0 + n) * K + k0 + kc) = o; }
        __syncthreads();
    }
    const size_t gt = (size_t)c.bid * 512 + c.tid, GT = (size_t)c.G * 512;
    { float* XF = (float*)(AWS + WS_XF); bf16* XB = (bf16*)(AWS + WS_XB); const float* xp = (const float*)AIN(I_XP); const float* xs = (const float*)AIN(I_XS);
      for (size_t i = gt; i < (size_t)MPAD * DM / 4; i += GT) { const size_t e = i * 4; const size_t row = e / DM;
          f32x4 v = (f32x4){0.f, 0.f, 0.f, 0.f};
          if (row < (size_t)MPR) v = *(const f32x4*)(xp + e); else if (row < (size_t)MTOT) v = *(const f32x4*)(xs + (e - (size_t)MPR * DM));
          *(f32x4*)(XF + e) = v; u32x2 w; w.x = pk2(v[0], v[1]); w.y = pk2(v[2], v[3]); *(u32x2*)(XB + e) = w; } }
    for (int l = 0; l < 2; ++l) { bf16* PB = (bf16*)(AWS + WS_PB) + (size_t)l * MPAD * PLED; const float* pp = (const float*)AIN(I_PP) + (size_t)l * MPR * PLED; const float* ps = (const float*)AIN(I_PS) + (size_t)l * DB * PLED;
      for (size_t i = gt; i < (size_t)MPAD * PLED / 4; i += GT) { const size_t e = i * 4; const size_t row = e / PLED;
          f32x4 v = (f32x4){0.f, 0.f, 0.f, 0.f};
          if (row < (size_t)MPR) v = *(const f32x4*)(pp + e); else if (row < (size_t)MTOT) v = *(const f32x4*)(ps + (e - (size_t)MPR * PLED));
          u32x2 w; w.x = pk2(v[0], v[1]); w.y = pk2(v[2], v[3]); *(u32x2*)(PB + e) = w; } }
}

__device__ __forceinline__ float ldT(const bf16* p) { return bf2f(*p); }
__device__ __forceinline__ float ldT(const float* p) { return *p; }
__device__ __forceinline__ void qk4(const bf16* kp, const LAS float* qbuf, float (&dot)[4]) {
    dot[0] = dot[1] = dot[2] = dot[3] = 0.f;
#pragma unroll 2
    for (int cch = 0; cch < 8; ++cch) { const u32x4 w = *(const u32x4*)(kp + cch * 8);
#pragma unroll
        for (int j = 0; j < 4; ++j) { const unsigned ww = w[j]; const float k0 = __uint_as_float(ww << 16), k1 = __uint_as_float(ww & 0xffff0000u);
            const f32x4 q0 = *(const LAS f32x4*)(qbuf + (cch * 8 + j * 2) * 4), q1 = *(const LAS f32x4*)(qbuf + (cch * 8 + j * 2 + 1) * 4);
#pragma unroll
            for (int g = 0; g < 4; ++g) dot[g] += k0 * q0[g] + k1 * q1[g]; } }
}
__device__ __forceinline__ void qk4(const float* kp, const LAS float* qbuf, float (&dot)[4]) {
    dot[0] = dot[1] = dot[2] = dot[3] = 0.f;
#pragma unroll 4
    for (int cch = 0; cch < 16; ++cch) { const f32x4 w = *(const f32x4*)(kp + cch * 4);
#pragma unroll
        for (int j = 0; j < 4; ++j) { const f32x4 q0 = *(const LAS f32x4*)(qbuf + (cch * 4 + j) * 4);
#pragma unroll
            for (int g = 0; g < 4; ++g) dot[g] += w[j] * q0[g]; } }
}
template <typename T>
__device__ __forceinline__ void pv4(const T* vp_lane, const LAS float* pbuf, int lane, float (&o)[4]) {
    const unsigned long long pv = (unsigned long long)(uintptr_t)vp_lane; const int lo = (int)(unsigned)pv, hi = (int)(unsigned)(pv >> 32);
#pragma unroll 16
    for (int j = 0; j < 64; ++j) {
        const unsigned l2 = (unsigned)__builtin_amdgcn_readlane(lo, j), h2 = (unsigned)__builtin_amdgcn_readlane(hi, j);
        const T* vp = (const T*)(uintptr_t)(((unsigned long long)h2 << 32) | l2);
        const float v = ldT(vp + lane); const f32x4 p = *(const LAS f32x4*)(pbuf + j * 4);
#pragma unroll
        for (int g = 0; g < 4; ++g) o[g] += p[g] * v;
    }
}
struct OSm { float m[4], l[4], o[4]; };
__device__ __forceinline__ void os_init(OSm& s) {
#pragma unroll
    for (int g = 0; g < 4; ++g) { s.m[g] = NEGV; s.l[g] = 0.f; s.o[g] = 0.f; } }
template <typename T>
__device__ __forceinline__ void attend_block(OSm& st, const T* kp, const T* vp, bool valid, float dist, const LAS float* qbuf, LAS float* pbuf, int lane, const float (&slope)[4]) {
    float dot[4]; qk4(kp, qbuf, dot);
    f32x4 p; float c8 = 0.125f; asm volatile("" : "+v"(c8));
#pragma unroll
    for (int g = 0; g < 4; ++g) { const float s = valid ? (dot[g] * c8 - slope[g] * dist) : NEGV;
        const float mn = fmaxf(st.m[g], wave_max(s)); const float pg = valid ? __expf(s - mn) : 0.f; const float corr = __expf(st.m[g] - mn);
        st.l[g] = st.l[g] * corr + wave_sum(pg); st.o[g] *= corr; st.m[g] = mn; p[g] = pg; }
    *(LAS f32x4*)(pbuf + lane * 4) = p; wave_lds_sync();
    pv4(vp, pbuf, lane, st.o);
    wave_lds_sync();
}
__device__ __forceinline__ unsigned long long select_blocks(const LAS float* impbuf, int lane, int cur) {
    const bool excl = lane > cur; const bool forced = (lane == 0) || (lane == cur) || (lane + 1 == cur);
    const float imp = impbuf[2 * lane] + impbuf[2 * lane + 1];
    const float sc = excl ? -__builtin_inff() : (forced ? __builtin_inff() : imp);
    int cnt = 0; const int sci = __float_as_int(sc);
#pragma unroll 8
    for (int i = 0; i < 64; ++i) { const float si = __int_as_float(__builtin_amdgcn_readlane(sci, i)); cnt += ((si > sc) || (si == sc && i < lane)) ? 1 : 0; }
    return __ballot(!excl && cnt < 16);
}

__device__ __forceinline__ void nsa_item(const Ctx& c, int l, bool sample, int row  , int b, int t, int n, LAS float* wl, int lane) {
    LAS float* qbuf = wl; LAS float* pbuf = wl + 256; LAS float* impbuf = wl + 512;
    const bf16* H = (const bf16*)(AWS + WS_H); const float* HS = (const float*)(AWS + WS_HS);
    float slope[4];
#pragma unroll
    for (int g = 0; g < 4; ++g) slope[g] = exp2f(-(float)(n * 4 + g + 1));
    { f32x4 qv;
#pragma unroll
      for (int g = 0; g < 4; ++g) qv[g] = bf2f(H[(size_t)row * HW + HQ + (n * 4 + g) * 64 + lane]);
      wave_lds_sync(); *(LAS f32x4*)(qbuf + lane * 4) = qv; wave_lds_sync(); }
    const float tp = (float)t;
    const int ncb = sample ? 1 : 2;
    const float* KC = sample ? (const float*)(AWS + WS_KCS) + (size_t)b * 64 * 128 : (const float*)(AWS + WS_KCP) + (size_t)b * 128 * 128;
    const float* VC = sample ? (const float*)(AWS + WS_VCS) + (size_t)b * 64 * 128 : (const float*)(AWS + WS_VCP) + (size_t)b * 128 * 128;
    float sc[2][4]; bool cv[2];
#pragma unroll
    for (int blk = 0; blk < 2; ++blk) { const int cidx = blk * 64 + lane; cv[blk] = (blk < ncb) && (32 * cidx + 31 <= t);
        float dot[4] = {0.f, 0.f, 0.f, 0.f};
        if (blk < ncb) qk4(KC + ((size_t)cidx * 2 + n) * 64, qbuf, dot);
        const float dist = tp - (32.f * (float)cidx + 15.5f);
#pragma unroll
        for (int g = 0; g < 4; ++g) sc[blk][g] = cv[blk] ? (dot[g] * 0.125f - slope[g] * dist) : NEGV; }
    float ocmp[4] = {0.f, 0.f, 0.f, 0.f};
    { f32x4 p0, p1; float i0 = 0.f, i1 = 0.f;
#pragma unroll
      for (int g = 0; g < 4; ++g) { const float mx = wave_max(fmaxf(sc[0][g], sc[1][g]));
          const float e0 = cv[0] ? __expf(sc[0][g] - mx) : 0.f, e1 = cv[1] ? __expf(sc[1][g] - mx) : 0.f; const float sum = wave_sum(e0 + e1); const float inv = sum > 0.f ? 1.0f / sum : 0.f;
          p0[g] = e0 * inv; p1[g] = e1 * inv; i0 += p0[g]; i1 += p1[g]; }
      impbuf[lane] = i0; impbuf[64 + lane] = i1;
      *(LAS f32x4*)(pbuf + lane * 4) = p0; wave_lds_sync();
      pv4(VC + ((size_t)lane * 2 + n) * 64, pbuf, lane, ocmp); wave_lds_sync();
      if (ncb > 1) { *(LAS f32x4*)(pbuf + lane * 4) = p1; wave_lds_sync(); pv4(VC + ((size_t)(64 + lane) * 2 + n) * 64, pbuf, lane, ocmp); wave_lds_sync(); } }
    const int cur = t >> 6;
    unsigned long long mask = select_blocks(impbuf, lane, cur);
    OSm ss; os_init(ss);
    if (!sample) {
        while (mask) { const int j = __builtin_ctzll(mask); mask &= mask - 1;
            const int pos = j * 64 + lane; const bf16* kp = H + (size_t)(b * SEQ + pos) * HW + HKV + 256 + n * 64;
            attend_block<bf16>(ss, kp, kp + 128, pos <= t, (float)(t - pos), qbuf, pbuf, lane, slope); }
    } else {
        const int* ptab = (const int*)AIN(I_PTAB); const float* cache = (const float*)AIN(I_CACHE) + (size_t)l * NPOOL * 128 * 512;
        while (mask) { const int j = __builtin_ctzll(mask); mask &= mask - 1;
            if (j < 32) { const int page = ptab[b * NPG + (j >> 1)]; const float* kp = cache + ((size_t)page * 128 + (j & 1) * 64 + lane) * 512 + 256 + n * 64;
                attend_block<float>(ss, kp, kp + 128, true, (float)(t - (j * 64 + lane)), qbuf, pbuf, lane, slope); }
            else { const bf16* kp = H + (size_t)row * HW + HKV + 256 + n * 64; attend_block<bf16>(ss, kp, kp + 128, lane == 0, 0.f, qbuf, pbuf, lane, slope); } }
    }
    OSm sw; os_init(sw);
    if (!sample) {
        for (int blk = 0; blk < 8; ++blk) { const int p0 = t - 511 + blk * 64; if (p0 + 63 < 0) continue;
            const int pos = p0 + lane; const int pc = pos < 0 ? 0 : pos; const bf16* kp = H + (size_t)(b * SEQ + pc) * HW + HWIN + n * 64;
            attend_block<bf16>(sw, kp, kp + 128, pos >= 0, (float)(t - pos), qbuf, pbuf, lane, slope); }
    } else {
        const float* wst = (const float*)AIN(I_SWIN) + ((size_t)l * DB + b) * 512 * 256;
        for (int blk = 0; blk < 8; ++blk) { const int i = 1 + blk * 64 + lane; const int ic = i > 511 ? 511 : i; const float* kp = wst + (size_t)ic * 256 + n * 64;
            attend_block<float>(sw, kp, kp + 128, i <= 511, (float)(512 - i), qbuf, pbuf, lane, slope); }
        const bf16* kp = H + (size_t)row * HW + HWIN + n * 64; attend_block<bf16>(sw, kp, kp + 128, lane == 0, 0.f, qbuf, pbuf, lane, slope);
    }
    bf16* MIX = (bf16*)(AWS + WS_MIX);
#pragma unroll
    for (int g = 0; g < 4; ++g) { const int hq = n * 4 + g; const float* gp = HS + (size_t)row * 64 + hq * 3;
        const float g0 = sigmoidf_(gp[0]), g1 = sigmoidf_(gp[1]), g2 = sigmoidf_(gp[2]);
        const float osl = ss.l[g] > 0.f ? ss.o[g] / ss.l[g] : 0.f, owi = sw.l[g] > 0.f ? sw.o[g] / sw.l[g] : 0.f;
        MIX[(size_t)row * DM + hq * 64 + lane] = (bf16)f2bf(g0 * ocmp[g] + g1 * osl + g2 * owi); }
}

__device__ __forceinline__ void gdn_steps(const Ctx& c, int l, int row0, int nsteps, int hh, float (&S)[64], LAS float* wl, int lane) {
    const float* GQ = (const float*)(AWS + WS_GQ); const float* GK = (const float*)(AWS + WS_GK); const float* GV = (const float*)(AWS + WS_GV);
    const float* SC = (const float*)(AWS + WS_SC);
    const bf16* H = (const bf16*)(AWS + WS_H); bf16* MIX = (bf16*)(AWS + WS_MIX);
    const float nw = ((const float*)AIN(I_GNW))[l * 64 + lane];
    LAS float* kb = wl; LAS float* qb = wl + 64;
    size_t o = (size_t)row0 * 512 + hh * 64 + lane;
    float nk = GK[o], nq = GQ[o], nv = GV[o], ng = SC[((size_t)row0 * 8 + hh) * 4], nb = SC[((size_t)row0 * 8 + hh) * 4 + 1], nz = bf2f(H[(size_t)row0 * HW + HGZ + hh * 64 + lane]);
    for (int s = 0; s < nsteps; ++s) {
        const int m = row0 + s;
        const float kv = nk, qv = nq, vv = nv, gv = ng, bv = nb, zv = nz;
        if (s + 1 < nsteps) { const size_t o2 = (size_t)(m + 1) * 512 + hh * 64 + lane;
            nk = GK[o2]; nq = GQ[o2]; nv = GV[o2]; ng = SC[((size_t)(m + 1) * 8 + hh) * 4]; nb = SC[((size_t)(m + 1) * 8 + hh) * 4 + 1]; nz = bf2f(H[(size_t)(m + 1) * HW + HGZ + hh * 64 + lane]); }
        wave_lds_sync(); kb[lane] = kv; qb[lane] = qv; wave_lds_sync();
        const float al = gv;
        float u0 = 0.f, u1 = 0.f, u2 = 0.f, u3 = 0.f;
#pragma unroll
        for (int d = 0; d < 64; d += 4) { const f32x4 k4 = *(const LAS f32x4*)(kb + d); u0 += k4[0] * S[d]; u1 += k4[1] * S[d + 1]; u2 += k4[2] * S[d + 2]; u3 += k4[3] * S[d + 3]; }
        const float u = (u0 + u1) + (u2 + u3);
        const float w = bv * (vv - al * u);
        float o0 = 0.f, o1 = 0.f, o2 = 0.f, o3 = 0.f;
#pragma unroll
        for (int d = 0; d < 64; d += 4) { const f32x4 k4 = *(const LAS f32x4*)(kb + d); const f32x4 q4 = *(const LAS f32x4*)(qb + d);
            S[d] = al * S[d] + k4[0] * w; S[d + 1] = al * S[d + 1] + k4[1] * w; S[d + 2] = al * S[d + 2] + k4[2] * w; S[d + 3] = al * S[d + 3] + k4[3] * w;
            o0 += q4[0] * S[d]; o1 += q4[1] * S[d + 1]; o2 += q4[2] * S[d + 2]; o3 += q4[3] * S[d + 3]; }
        const float ov = (o0 + o1) + (o2 + o3);
        const float ms = wave_sum(ov * ov) * (1.f / 64.f);
        MIX[(size_t)m * DM + 512 + hh * 64 + lane] = (bf16)f2bf(ov * rsqrtf(ms + RMS_EPS) * nw * siluf_(zv));
    }
}

__device__ __forceinline__ float quad_sum(float v) {
    const float t = v + __int_as_float(__builtin_amdgcn_mov_dpp(__float_as_int(v), 0xB1, 0xF, 0xF, true));
    return t + __int_as_float(__builtin_amdgcn_mov_dpp(__float_as_int(t), 0x4E, 0xF, 0xF, true));
}
constexpr int GC_NS = 16, GC_KQ = 0, GC_SC = GC_NS * 128, GC_V = GC_SC + GC_NS * 4, GC_BUF = GC_V + GC_NS * 8;
typedef float f32x2 __attribute__((ext_vector_type(2)));
__device__ __forceinline__ float oct_sum_dpp(float v) {
    const float t = quad_sum(v);
    return t + __int_as_float(__builtin_amdgcn_mov_dpp(__float_as_int(t), 0x141, 0xF, 0xF, true));
}
__device__ __forceinline__ void gdn_chain8(const Ctx& c, int l, int b, int hh, int wq, LAS float* st, int lane) {
    const float* GQ = (const float*)(AWS + WS_GQ); const float* GK = (const float*)(AWS + WS_GK); const float* GV = (const float*)(AWS + WS_GV); const float* SC = (const float*)(AWS + WS_SC);
    float* OG = (float*)(AWS + WS_OG);
    const int j = lane & 7, ec = lane >> 3, e = wq * 8 + ec;
    const size_t row0 = (size_t)b * SEQ;
    f32x2 S2[4];
#pragma unroll
    for (int i = 0; i < 4; ++i) S2[i] = (f32x2){0.f, 0.f};
    f32x4 kq[8], scv, vv;
    const int w31 = lane & 31;
    const float* kqsrc = ((w31 < 16) ? GK : GQ) + hh * 64 + 4 * (w31 & 15);
    float* ogp = OG + (row0 + j) * 512 + hh * 64 + e;
#define GC_GLOAD(s0_) do { _Pragma("unroll") for (int x = 0; x < 8; ++x) kq[x] = *(const f32x4*)(kqsrc + (row0 + (s0_) + 2 * x + (lane >> 5)) * 512); \
        scv = *(const f32x4*)(SC + ((row0 + (s0_) + (lane & 15)) * 8 + hh) * 4); vv = *(const f32x4*)(GV + (row0 + (s0_) + (w31 >> 1)) * 512 + hh * 64 + wq * 8 + 4 * (lane & 1)); } while (0)
#define GC_LSTORE(buf_) do { LAS float* bb_ = st + (buf_) * GC_BUF; _Pragma("unroll") for (int x = 0; x < 8; ++x) *(LAS f32x4*)(bb_ + GC_KQ + (2 * x + (lane >> 5)) * 128 + 4 * w31) = kq[x]; \
        if (lane < 16) *(LAS f32x4*)(bb_ + GC_SC + lane * 4) = scv; if (lane < 32) *(LAS f32x4*)(bb_ + GC_V + (lane >> 1) * 8 + 4 * (lane & 1)) = vv; } while (0)
    GC_GLOAD(0); GC_LSTORE(0);
    for (int s0 = 0; s0 < SEQ; s0 += GC_NS) {
        const int buf = (s0 >> 4) & 1; const bool more = s0 + GC_NS < SEQ;
        if (more) GC_GLOAD(s0 + GC_NS);
        wave_lds_sync();
        const LAS float* bb = st + buf * GC_BUF;
        float osel = 0.f;
        f32x4 kA[2], qA[2], kB[2], qB[2], scA, scB; float vA, vB;
#define GC_RD(K_, Q_, SC_, V_, sp_) do { const LAS float* kr_ = bb + GC_KQ + (sp_) * 128 + 8 * j; _Pragma("unroll") for (int i = 0; i < 2; ++i) { K_[i] = *(const LAS f32x4*)(kr_ + 4 * i); Q_[i] = *(const LAS f32x4*)(kr_ + 64 + 4 * i); } \
            SC_ = *(const LAS f32x4*)(bb + GC_SC + (sp_) * 4); V_ = bb[GC_V + (sp_) * 8 + ec]; } while (0)
#define GC_STEP(K_, Q_, SC_, V_, sp_) do { \
            f32x2 k2[4], q2[4]; _Pragma("unroll") for (int i = 0; i < 2; ++i) { k2[2 * i] = (f32x2){K_[i][0], K_[i][1]}; k2[2 * i + 1] = (f32x2){K_[i][2], K_[i][3]}; q2[2 * i] = (f32x2){Q_[i][0], Q_[i][1]}; q2[2 * i + 1] = (f32x2){Q_[i][2], Q_[i][3]}; } \
            const float al = SC_[0]; const f32x2 al2 = (f32x2){al, al}; \
            f32x2 ua = k2[0] * S2[0], ub = k2[1] * S2[1]; ua = k2[2] * S2[2] + ua; ub = k2[3] * S2[3] + ub; \
            f32x2 ra = q2[0] * S2[0], rb = q2[1] * S2[1]; ra = q2[2] * S2[2] + ra; rb = q2[3] * S2[3] + rb; \
            f32x2 aS[4]; _Pragma("unroll") for (int i = 0; i < 4; ++i) aS[i] = al2 * S2[i]; \
            const f32x2 us = ua + ub; const float u = oct_sum_dpp(us[0] + us[1]); \
            const float w = SC_[1] * (V_ - al * u); const f32x2 w2 = (f32x2){w, w}; \
            _Pragma("unroll") for (int i = 0; i < 4; ++i) S2[i] = k2[i] * w2 + aS[i]; \
            const f32x2 rs = ra + rb; const float r = oct_sum_dpp(rs[0] + rs[1]); \
            const float o = fmaf(al, r, SC_[2] * w); \
            osel = (((sp_) & 7) == j) ? o : osel; \
            if (((sp_) & 7) == 7) ogp[(size_t)(s0 + ((sp_) & ~7)) * 512] = osel; asm volatile("" :: "v"(SC_[3]));   } while (0)
        GC_RD(kA, qA, scA, vA, 0);
#pragma unroll
        for (int sp = 0; sp < GC_NS; sp += 2) {
            GC_RD(kB, qB, scB, vB, sp + 1); __builtin_amdgcn_sched_barrier(0);
            GC_STEP(kA, qA, scA, vA, sp); __builtin_amdgcn_sched_barrier(0);
            if (sp + 2 < GC_NS) { GC_RD(kA, qA, scA, vA, sp + 2); } __builtin_amdgcn_sched_barrier(0);
            GC_STEP(kB, qB, scB, vB, sp + 1); __builtin_amdgcn_sched_barrier(0);
        }
#undef GC_RD
#undef GC_STEP
        if (more) GC_LSTORE(buf ^ 1);
    }
#undef GC_GLOAD
#undef GC_LSTORE
    float* o = AOUT + O_GSP + (((size_t)l * 4 + b) * 8 + hh) * 4096;
#pragma unroll
    for (int i = 0; i < 4; ++i) { o[(8 * j + 2 * i) * 64 + e] = S2[i][0]; o[(8 * j + 2 * i + 1) * 64 + e] = S2[i][1]; }
}
__device__ __forceinline__ void sample_combine(const Ctx& c, int l, int bn, int lane);
__device__ __forceinline__ void p4b_gdn_norm(const Ctx& c0, int l) {
    const Ctx c = relaunder(c0);
    const int gw = c.bid * 8 + c.wave, NGW = c.G * 8, lane = c.lane;
    const float* OG = (const float*)(AWS + WS_OG); const bf16* H = (const bf16*)(AWS + WS_H); bf16* MIX = (bf16*)(AWS + WS_MIX);
    const float nw = ((const float*)AIN(I_GNW))[l * 64 + lane];
    for (int bn = gw; bn < DB * 2; bn += NGW) sample_combine(c, l, bn, lane);
    for (int it = gw; it < MPR * 8; it += NGW) { const int hh = it & 7, m = it >> 3;
        const float ov = OG[(size_t)m * 512 + hh * 64 + lane]; const float zv = bf2f(H[(size_t)m * HW + HGZ + hh * 64 + lane]);
        const float ms = wave_sum_fast(ov * ov) * (1.f / 64.f);
        MIX[(size_t)m * DM + 512 + hh * 64 + lane] = (bf16)f2bf(ov * rsqrtf(ms + RMS_EPS) * nw * siluf_(zv)); }
}
__device__ __forceinline__ void gdn_item_prompt(const Ctx& c, int l, int b, int hh, LAS float* wl, int lane) {
    float S[64];
#pragma unroll
    for (int d = 0; d < 64; ++d) S[d] = 0.f;
    gdn_steps(c, l, b * SEQ, SEQ, hh, S, wl, lane);
    float* o = AOUT + O_GSP + (((size_t)l * 4 + b) * 8 + hh) * 4096;
#pragma unroll
    for (int d = 0; d < 64; ++d) o[d * 64 + lane] = S[d];
}
__device__ __forceinline__ void gdn_item_sample(const Ctx& c, int l, int b, int hh, LAS float* wl, int lane) {
    const float* s0 = (const float*)AIN(I_SGDN) + (((size_t)l * DB + b) * 8 + hh) * 4096;
    float S[64];
#pragma unroll
    for (int d = 0; d < 64; ++d) S[d] = s0[d * 64 + lane];
    gdn_steps(c, l, MPR + b, 1, hh, S, wl, lane);
    float* o = AOUT + O_GSS + (((size_t)l * DB + b) * 8 + hh) * 4096;
#pragma unroll
    for (int d = 0; d < 64; ++d) o[d * 64 + lane] = S[d];
}

typedef short bf16x8v __attribute__((ext_vector_type(8)));
typedef float f32x16 __attribute__((ext_vector_type(16)));
typedef short s16x4v __attribute__((ext_vector_type(4)));
typedef float f32x2v_ __attribute__((ext_vector_type(2))); typedef __bf16 bf16x2v_ __attribute__((ext_vector_type(2)));
__device__ __forceinline__ unsigned cvtpk(float lo, float hi) { f32x2v_ v = {lo, hi}; bf16x2v_ b = __builtin_convertvector(v, bf16x2v_); return __builtin_bit_cast(unsigned, b); }
__device__ __forceinline__ int crow(int r, int hi) { return (r & 3) + 8 * (r >> 2) + 4 * hi; }
constexpr int NL_KS = 0, NL_VS = 16384, NL_IMP = 32768, NL_IMPB = 4 * 64 * 65 * 4, NL_MASK = NL_IMP + NL_IMPB, NL_WSF = NL_MASK + 512, NL_END = NL_WSF + 8 * 256;
static_assert(NL_END <= RING_BYTES && CTLB + RING_BYTES <= LDS_BYTES, "nsa unit LDS");
constexpr float LOG2E = 1.4426950408889634f, C2S = 0.125f * 1.4426950408889634f, MCLAMP = -1.0e4f, SNEG = -1.0e30f;
struct NsaSm { float m, l; f32x16 o0, o1; };
__device__ __forceinline__ float rowmax32(const f32x16& p0, const f32x16& p1) {
    float a = fmaxf(fmaxf(p0[0], p0[1]), p1[0]), b = fmaxf(fmaxf(p0[2], p0[3]), p1[1]); a = fmaxf(fmaxf(a, p1[2]), p1[3]);
#pragma unroll
    for (int r = 4; r < 16; r += 4) { a = fmaxf(fmaxf(a, p0[r]), p0[r + 1]); b = fmaxf(fmaxf(b, p0[r + 2]), p0[r + 3]); a = fmaxf(fmaxf(a, p1[r]), p1[r + 1]); b = fmaxf(fmaxf(b, p1[r + 2]), p1[r + 3]); }
    const float m = fmaxf(a, b);
    auto rr = __builtin_amdgcn_permlane32_swap(__float_as_uint(m), __float_as_uint(m), false, false);
    return fmaxf(__uint_as_float(rr[0]), __uint_as_float(rr[1]));
}
__device__ __forceinline__ float halves_sum(float v) { auto rr = __builtin_amdgcn_permlane32_swap(__float_as_uint(v), __float_as_uint(v), false, false); return __uint_as_float(rr[0]) + __uint_as_float(rr[1]); }
__device__ __forceinline__ void nsa_qk(f32x16& p0, f32x16& p1, const LAS unsigned char* kslot, const bf16x8v (&qr)[4], int r32, int hi) {
    const LAS unsigned char* kb = kslot + hi * 1024 + r32 * 16;
    f32x16 z;
#pragma unroll
    for (int r = 0; r < 16; ++r) z[r] = 0.f;
    p0 = z; p1 = z;
#pragma unroll
    for (int d0 = 0; d0 < 4; ++d0) { const bf16x8v b0 = *(const LAS bf16x8v*)(kb + d0 * 2048), b1 = *(const LAS bf16x8v*)(kb + d0 * 2048 + 512);
        p0 = __builtin_amdgcn_mfma_f32_32x32x16_bf16(b0, qr[d0], p0, 0, 0, 0); p1 = __builtin_amdgcn_mfma_f32_32x32x16_bf16(b1, qr[d0], p1, 0, 0, 0); }
}
__device__ __forceinline__ void nsa_scores(f32x16& p0, f32x16& p1, float Ap, float slk, int thrp, bool flip) {
#pragma unroll
    for (int r = 0; r < 16; ++r) { const int cr = (r & 3) + 8 * (r >> 2);
        const bool v0 = (cr <= thrp) != flip, v1 = (cr + 32 <= thrp) != flip;
        p0[r] = v0 ? fmaf(p0[r], C2S, fmaf(slk, (float)cr, Ap)) : SNEG; p1[r] = v1 ? fmaf(p1[r], C2S, fmaf(slk, (float)(cr + 32), Ap)) : SNEG; }
}
__device__ __forceinline__ void nsa_pv(f32x16& o0, f32x16& o1, const f32x16& p0, const f32x16& p1, const LAS unsigned char* vslot, int lane, int hi) {
    u32x4 pw[4];
#pragma unroll
    for (int k = 0; k < 4; ++k) { pw[0][k] = cvtpk(p0[2 * k], p0[2 * k + 1]); pw[1][k] = cvtpk(p0[8 + 2 * k], p0[9 + 2 * k]); pw[2][k] = cvtpk(p1[2 * k], p1[2 * k + 1]); pw[3][k] = cvtpk(p1[8 + 2 * k], p1[9 + 2 * k]); }
    const LAS unsigned char* vp = vslot + ((lane >> 4) & 1) * 32 + (lane & 3) * 8 + (4 * hi + ((lane & 15) >> 2)) * 64;
#pragma unroll
    for (int ks = 0; ks < 4; ++ks) {
        const s16x4v a0 = __builtin_bit_cast(s16x4v, __builtin_amdgcn_ds_read_tr16_b64_v4i16((LAS s16x4v*)(vp + ks * 1024)));
        const s16x4v a1 = __builtin_bit_cast(s16x4v, __builtin_amdgcn_ds_read_tr16_b64_v4i16((LAS s16x4v*)(vp + ks * 1024 + 512)));
        const s16x4v b0 = __builtin_bit_cast(s16x4v, __builtin_amdgcn_ds_read_tr16_b64_v4i16((LAS s16x4v*)(vp + 4096 + ks * 1024)));
        const s16x4v b1 = __builtin_bit_cast(s16x4v, __builtin_amdgcn_ds_read_tr16_b64_v4i16((LAS s16x4v*)(vp + 4096 + ks * 1024 + 512)));
        const bf16x8v va = {a0[0], a0[1], a0[2], a0[3], a1[0], a1[1], a1[2], a1[3]}, vb = {b0[0], b0[1], b0[2], b0[3], b1[0], b1[1], b1[2], b1[3]};
        const bf16x8v pa = __builtin_bit_cast(bf16x8v, pw[ks]);
        o0 = __builtin_amdgcn_mfma_f32_32x32x16_bf16(pa, va, o0, 0, 0, 0); o1 = __builtin_amdgcn_mfma_f32_32x32x16_bf16(pa, vb, o1, 0, 0, 0); }
}
__device__ __forceinline__ void nsa_softmax_pv(NsaSm& st, f32x16& p0, f32x16& p1, const LAS unsigned char* vslot, LAS float* wsf, int lane, int r32, int hi) {
    const float rm = rowmax32(p0, p1); const float mn = fmaxf(st.m, rm); const float f = __builtin_amdgcn_exp2f(st.m - mn); st.m = mn;
    float s = 0.f;
#pragma unroll
    for (int r = 0; r < 16; ++r) { p0[r] = __builtin_amdgcn_exp2f(p0[r] - mn); p1[r] = __builtin_amdgcn_exp2f(p1[r] - mn); s += p0[r] + p1[r]; }
    st.l = st.l * f + s;
    if (__any(f != 1.0f)) { wave_lds_sync(); if (hi == 0) wsf[r32] = f; wave_lds_sync();
#pragma unroll
        for (int r = 0; r < 16; ++r) { const float fr = wsf[crow(r, hi)]; st.o0[r] *= fr; st.o1[r] *= fr; } }
    nsa_pv(st.o0, st.o1, p0, p1, vslot, lane, hi);
}
__device__ __forceinline__ void nsa_sm_init(NsaSm& st) { st.m = MCLAMP; st.l = 0.f;
#pragma unroll
    for (int r = 0; r < 16; ++r) { st.o0[r] = 0.f; st.o1[r] = 0.f; } }
__device__ __forceinline__ void nsa_fold(f32x16& f0, f32x16& f1, const f32x16& o0, const f32x16& o1, float fac, LAS float* wsf, int r32, int hi) {
    wave_lds_sync(); if (hi == 0) wsf[r32] = fac; wave_lds_sync();
#pragma unroll
    for (int r = 0; r < 16; ++r) { const float fr = wsf[crow(r, hi)]; f0[r] += o0[r] * fr; f1[r] += o1[r] * fr; }
}
#define NSA_LOADT(kb_, vb_, pitch_) do { int ln_ = lane; asm volatile("" : "+v"(ln_));   \
        kreg = *(const u32x4*)((kb_) + (unsigned)(ln_ * (pitch_) + wid * 8)); vreg = *(const u32x4*)((vb_) + (unsigned)((16 * (wid & 3) + (ln_ >> 2)) * (pitch_) + (wid >> 2) * 32 + (ln_ & 3) * 8)); } while (0)
#define NSA_STORET(slot_) do { *(LAS u32x4*)(lds + NL_KS + (slot_) * 8192 + wid * 1024 + lane * 16) = kreg; *(LAS u32x4*)(lds + NL_VS + (slot_) * 8192 + wid * 1024 + lane * 16) = vreg; } while (0)
__device__ __forceinline__ void nsa_unit(const Ctx& c, int l, int b, int n, int qt) {
    LAS unsigned char* lds = c.lds; const int lane = c.lane, wid = c.wave, r32 = lane & 31, hi = lane >> 5, g = wid >> 1, th = wid & 1;
    const int tq = th * 32 + r32, t0 = qt * 64, t = t0 + tq, hq = n * 4 + g;
    const float sl2 = exp2f(-(float)(hq + 1)) * LOG2E;
    LAS float* wsf = (LAS float*)(lds + NL_WSF + wid * 256); LAS float* imp = (LAS float*)(lds + NL_IMP); LAS unsigned long long* maskb = (LAS unsigned long long*)(lds + NL_MASK);
    const bf16* H = (const bf16*)(AWS + WS_H); const float* HS = (const float*)(AWS + WS_HS);
    const size_t rowbase = (size_t)b * SEQ;
    bf16x8v qr[4];
#pragma unroll
    for (int d0 = 0; d0 < 4; ++d0) qr[d0] = *(const bf16x8v*)(H + (rowbase + t) * HW + HQ + hq * 64 + d0 * 16 + hi * 8);
    const float* gp = HS + (rowbase + t) * 64 + hq * 3;
    const float gate0 = sigmoidf_(gp[0]), gate1 = sigmoidf_(gp[1]), gate2 = sigmoidf_(gp[2]);
    u32x4 kreg, vreg;
    f32x16 of0, of1;
    {
        const bf16* KCb = (const bf16*)(AWS + WS_KCB) + ((size_t)b * 128 * 2 + n) * 64; const bf16* VCb = (const bf16*)(AWS + WS_VCB) + ((size_t)b * 128 * 2 + n) * 64;
        const bool two = (t0 + 63 >= 64 * 32 + 31);
        NSA_LOADT(KCb, VCb, 128); NSA_STORET(0);
        if (two) { NSA_LOADT(KCb + 64 * 128, VCb + 64 * 128, 128); NSA_STORET(1); }
        __syncthreads();
        const int kq = (t >= 31) ? ((t - 31) >> 5) : -1; const float slk = 32.f * sl2;
        f32x16 a0, a1, b0, b1;
        nsa_qk(a0, a1, lds + NL_KS, qr, r32, hi);
        nsa_scores(a0, a1, -sl2 * ((float)t - 15.5f) + slk * (float)(4 * hi), slk, kq - 4 * hi, false);
        if (two) { nsa_qk(b0, b1, lds + NL_KS + 8192, qr, r32, hi); nsa_scores(b0, b1, -sl2 * ((float)t - 15.5f - 2048.f) + slk * (float)(4 * hi), slk, kq - 64 - 4 * hi, false); }
        else {
#pragma unroll
            for (int r = 0; r < 16; ++r) { b0[r] = SNEG; b1[r] = SNEG; } }
        const float mx = fmaxf(MCLAMP, fmaxf(rowmax32(a0, a1), rowmax32(b0, b1)));
        float s = 0.f;
#pragma unroll
        for (int r = 0; r < 16; ++r) { a0[r] = __builtin_amdgcn_exp2f(a0[r] - mx); a1[r] = __builtin_amdgcn_exp2f(a1[r] - mx); b0[r] = __builtin_amdgcn_exp2f(b0[r] - mx); b1[r] = __builtin_amdgcn_exp2f(b1[r] - mx); s += (a0[r] + a1[r]) + (b0[r] + b1[r]); }
        const float ltot = halves_sum(s); const float inv = ltot > 0.f ? 1.0f / ltot : 0.f;
        { LAS float* ip = imp + (size_t)(g * 64 + tq) * 65 + 2 * hi;
#pragma unroll
          for (int r = 0; r < 16; r += 2) { const int jb = ((r & 3) >> 1) + 4 * (r >> 2);
              ip[jb] = (a0[r] + a0[r + 1]) * inv; ip[16 + jb] = (a1[r] + a1[r + 1]) * inv; ip[32 + jb] = (b0[r] + b0[r + 1]) * inv; ip[48 + jb] = (b1[r] + b1[r + 1]) * inv; } }
        f32x16 o0, o1;
#pragma unroll
        for (int r = 0; r < 16; ++r) { o0[r] = 0.f; o1[r] = 0.f; of0[r] = 0.f; of1[r] = 0.f; }
        nsa_pv(o0, o1, a0, a1, lds + NL_VS, lane, hi);
        if (two) nsa_pv(o0, o1, b0, b1, lds + NL_VS + 8192, lane, hi);
        nsa_fold(of0, of1, o0, o1, gate0 * inv, wsf, r32, hi);
    }
    __syncthreads();
    {
#pragma unroll 1
        for (int i = 0; i < 8; ++i) { const int q = wid * 8 + i;
            const float iv = ((imp[(size_t)(0 * 64 + q) * 65 + lane] + imp[(size_t)(1 * 64 + q) * 65 + lane]) + imp[(size_t)(2 * 64 + q) * 65 + lane]) + imp[(size_t)(3 * 64 + q) * 65 + lane];
            const bool excl = lane > qt; const bool forced = (lane == 0) || (lane == qt) || (lane + 1 == qt);
            const float sc = excl ? -__builtin_inff() : (forced ? __builtin_inff() : iv);
            int cnt = 0; const int sci = __float_as_int(sc);
#pragma unroll 8
            for (int k = 0; k < 64; ++k) { const float si = __int_as_float(__builtin_amdgcn_readlane(sci, k)); cnt += ((si > sc) || (si == sc && k < lane)) ? 1 : 0; }
            const unsigned long long mk = __ballot(!excl && cnt < 16);
            if (lane == 0) maskb[q] = mk; }
    }
    __syncthreads();
    const unsigned long long mq = maskb[tq];
    unsigned long long uni;
    { unsigned lo = (unsigned)maskb[lane], hi32 = (unsigned)(maskb[lane] >> 32);
#pragma unroll
      for (int o = 1; o < 64; o <<= 1) { lo |= (unsigned)__shfl_xor((int)lo, o); hi32 |= (unsigned)__shfl_xor((int)hi32, o); }
      uni = ((unsigned long long)(unsigned)__builtin_amdgcn_readfirstlane((int)hi32) << 32) | (unsigned)__builtin_amdgcn_readfirstlane((int)lo); }
    {
        NsaSm st; nsa_sm_init(st);
        const bf16* Kb = H + rowbase * HW + HKV + 256 + n * 64; const bf16* Vb = Kb + 128;
        unsigned long long rem = uni; int j = __builtin_ctzll(rem); rem &= rem - 1;
        NSA_LOADT(Kb + (size_t)j * 64 * HW, Vb + (size_t)j * 64 * HW, HW); NSA_STORET(0); __syncthreads();
        int cur = 0;
        for (;;) {
            const bool more = rem != 0ull; int jn = 0;
            if (more) { jn = __builtin_ctzll(rem); rem &= rem - 1; NSA_LOADT(Kb + (size_t)jn * 64 * HW, Vb + (size_t)jn * 64 * HW, HW); }
            f32x16 p0, p1;
            nsa_qk(p0, p1, lds + NL_KS + cur * 8192, qr, r32, hi);
            const bool sel = (mq >> j) & 1ull; const int thr = sel ? (j < qt ? 64 : tq) : -1;
            nsa_scores(p0, p1, -sl2 * (float)(t - 64 * j) + sl2 * (float)(4 * hi), sl2, thr - 4 * hi, false);
            nsa_softmax_pv(st, p0, p1, lds + NL_VS + cur * 8192, wsf, lane, r32, hi);
            if (more) NSA_STORET(cur ^ 1);
            __syncthreads();
            if (!more) break;
            cur ^= 1; j = jn;
        }
        const float ltot = halves_sum(st.l); nsa_fold(of0, of1, st.o0, st.o1, ltot > 0.f ? gate1 / ltot : 0.f, wsf, r32, hi);
    }
    {
        NsaSm st; nsa_sm_init(st);
        const bf16* Kb = H + rowbase * HW + HWIN + n * 64; const bf16* Vb = Kb + 128;
        const int klast = qt - 8 < 0 ? 0 : qt - 8;
        int kt = qt;
        NSA_LOADT(Kb + (size_t)kt * 64 * HW, Vb + (size_t)kt * 64 * HW, HW); NSA_STORET(0); __syncthreads();
        int cur = 0;
        for (;;) {
            const bool more = kt > klast;
            if (more) NSA_LOADT(Kb + (size_t)(kt - 1) * 64 * HW, Vb + (size_t)(kt - 1) * 64 * HW, HW);
            f32x16 p0, p1;
            nsa_qk(p0, p1, lds + NL_KS + cur * 8192, qr, r32, hi);
            const int dl = qt - kt; const bool flip = (dl == 8); const int thr = (dl == 0 || dl == 8) ? tq : 64;
            nsa_scores(p0, p1, -sl2 * (float)(64 * dl + tq) + sl2 * (float)(4 * hi), sl2, thr - 4 * hi, flip);
            nsa_softmax_pv(st, p0, p1, lds + NL_VS + cur * 8192, wsf, lane, r32, hi);
            if (more) NSA_STORET(cur ^ 1);
            __syncthreads();
            if (!more) break;
            cur ^= 1; --kt;
        }
        const float ltot = halves_sum(st.l); nsa_fold(of0, of1, st.o0, st.o1, ltot > 0.f ? gate2 / ltot : 0.f, wsf, r32, hi);
    }
    {
        LAS bf16* stg = (LAS bf16*)(lds + NL_IMP + wid * 4096);
#pragma unroll
        for (int r = 0; r < 16; ++r) { const int orow = crow(r, hi); stg[orow * 64 + r32] = (bf16)f2bf(of0[r]); stg[orow * 64 + 32 + r32] = (bf16)f2bf(of1[r]); }
        wave_lds_sync();
        bf16* MIX = (bf16*)(AWS + WS_MIX) + (rowbase + t0 + th * 32) * DM + hq * 64;
#pragma unroll
        for (int i = 0; i < 4; ++i) { const int row = i * 8 + (lane >> 3), ch = lane & 7; const u32x4 v = *(const LAS u32x4*)(stg + row * 64 + ch * 8); *(u32x4*)(MIX + (size_t)row * DM + ch * 8) = v; }
    }
    __syncthreads();
}

__device__ __forceinline__ void unpack8(const u32x4 w, float (&x)[8]) {
#pragma unroll
    for (int j = 0; j < 4; ++j) { x[2 * j] = __uint_as_float(w[j] << 16); x[2 * j + 1] = __uint_as_float(w[j] & 0xffff0000u); } }
__device__ __forceinline__ float xor4_sum(float v) { return v + __shfl_xor(v, 4); }
__device__ __forceinline__ float oct_sum(float v) { return xor4_sum(quad_sum(v)); }
__device__ __forceinline__ void p3_gdn_rows(const Ctx& c, int l, int rg, int lane) {
    const int m0 = rg * 8; const bool first = (m0 & (SEQ - 1)) == 0;
    const bf16* H = (const bf16*)(AWS + WS_H); const float* HS = (const float*)(AWS + WS_HS);
    const float* cw = (const float*)AIN(I_GCW) + (size_t)l * 4 * GQKV;
    float gq[8][8]; float qk[8];
#pragma unroll
    for (int j = 0; j < 3; ++j) {
        const int col0 = j * 512 + lane * 8;
        u32x4 xr[11];
#pragma unroll
        for (int r = 0; r < 11; ++r) { if (r < 3 && first) xr[r] = (u32x4){0u, 0u, 0u, 0u}; else xr[r] = *(const u32x4*)(H + (size_t)(m0 + r - 3) * HW + HGQKV + col0); }
        float w[4][8];
#pragma unroll
        for (int i = 0; i < 4; ++i) { const f32x4 a = *(const f32x4*)(cw + i * GQKV + col0), b = *(const f32x4*)(cw + i * GQKV + col0 + 4);
#pragma unroll
            for (int q = 0; q < 4; ++q) { w[i][q] = a[q]; w[i][4 + q] = b[q]; } }
        float* dst = (float*)(AWS + (j == 0 ? WS_GQ : (j == 1 ? WS_GK : WS_GV)));
#pragma unroll
        for (int r = 0; r < 8; ++r) {
            float x0[8], x1[8], x2[8], x3[8]; unpack8(xr[r], x0); unpack8(xr[r + 1], x1); unpack8(xr[r + 2], x2); unpack8(xr[r + 3], x3);
            float y[8]; float ss = 0.f;
#pragma unroll
            for (int q = 0; q < 8; ++q) { const float a = w[0][q] * x0[q] + w[1][q] * x1[q] + w[2][q] * x2[q] + w[3][q] * x3[q]; y[q] = siluf_(a); ss += y[q] * y[q]; }
            if (j < 2) { const float sc = rsqrtf(oct_sum(ss) + RMS_EPS) * (j == 0 ? 0.125f : 1.0f);
#pragma unroll
                for (int q = 0; q < 8; ++q) y[q] *= sc; }
            if (j == 0) {
#pragma unroll
                for (int q = 0; q < 8; ++q) gq[r][q] = y[q]; }
            if (j == 1) { float d = 0.f;
#pragma unroll
                for (int q = 0; q < 8; ++q) d += gq[r][q] * y[q];
                qk[r] = oct_sum(d); }
            float* o = dst + (size_t)(m0 + r) * 512 + lane * 8;
            *(f32x4*)o = (f32x4){y[0], y[1], y[2], y[3]}; *(f32x4*)(o + 4) = (f32x4){y[4], y[5], y[6], y[7]};
        }
    }
    { const int hh = lane >> 3; const float al = -__expf(((const float*)AIN(I_ALOG))[l * 8 + hh]), dt = ((const float*)AIN(I_DTB))[l * 8 + hh];
      float* SC = (float*)(AWS + WS_SC);
#pragma unroll
      for (int r = 0; r < 8; ++r) { const float ai = HS[(size_t)(m0 + r) * 64 + 24 + hh], bi = HS[(size_t)(m0 + r) * 64 + 32 + hh];
          if ((lane & 7) == 0) *(f32x4*)(SC + ((size_t)(m0 + r) * 8 + hh) * 4) = (f32x4){__expf(al * softplusf_(ai + dt)), sigmoidf_(bi), qk[r], 0.f}; } }
}
__device__ __forceinline__ void p3_gdn_sample(const Ctx& c, int l, int it, int lane) {
    const int hh = it & 7, b = it >> 3, m = MPR + b;
    const bf16* H = (const bf16*)(AWS + WS_H); const float* HS = (const float*)(AWS + WS_HS);
    const float* cw = (const float*)AIN(I_GCW) + (size_t)l * 4 * GQKV; const float* sgc = (const float*)AIN(I_SGCONV) + (size_t)l * DB * 3 * GQKV;
    float y[3];
#pragma unroll
    for (int j = 0; j < 3; ++j) { const int cc = j * 512 + hh * 64 + lane;
        float acc = cw[3 * GQKV + cc] * bf2f(H[(size_t)m * HW + HGQKV + cc]);
#pragma unroll
        for (int i = 0; i < 3; ++i) acc += cw[i * GQKV + cc] * sgc[((size_t)b * 3 + i) * GQKV + cc];
        y[j] = siluf_(acc); }
    const float sq = wave_sum(y[0] * y[0]), sk = wave_sum(y[1] * y[1]);
    const size_t o = (size_t)m * 512 + hh * 64 + lane;
    const float gq = y[0] * rsqrtf(sq + RMS_EPS) * 0.125f, gk = y[1] * rsqrtf(sk + RMS_EPS);
    ((float*)(AWS + WS_GQ))[o] = gq; ((float*)(AWS + WS_GK))[o] = gk; ((float*)(AWS + WS_GV))[o] = y[2];
    const float qk = wave_sum(gq * gk);
    if (lane == 0) { const float ai = HS[(size_t)m * 64 + 24 + hh], bi = HS[(size_t)m * 64 + 32 + hh];
        const float gg = -__expf(((const float*)AIN(I_ALOG))[l * 8 + hh]) * softplusf_(ai + ((const float*)AIN(I_DTB))[l * 8 + hh]);
        *(f32x4*)((float*)(AWS + WS_SC) + ((size_t)m * 8 + hh) * 4) = (f32x4){__expf(gg), sigmoidf_(bi), qk, 0.f}; }
}
#define P3_MATVEC(o_, mean_, PHIEXPR_) do { _Pragma("unroll") for (int g_ = 0; g_ < 4; ++g_) o_[g_] = 0.f; \
        _Pragma("unroll 4") for (int d4 = 0; d4 < 16; ++d4) { f32x4 mv[4]; _Pragma("unroll") for (int g_ = 0; g_ < 4; ++g_) mv[g_] = *(const LAS f32x4*)((mean_) + g_ * 64 + 4 * d4); \
            _Pragma("unroll") for (int q_ = 0; q_ < 4; ++q_) { const int d = 4 * d4 + q_; const float p0 = PHIEXPR_(0, d), p1 = PHIEXPR_(1, d); \
                o_[0] += mv[0][q_] * p0; o_[1] += mv[1][q_] * p0; o_[2] += mv[2][q_] * p1; o_[3] += mv[3][q_] * p1; } } } while (0)
__device__ __forceinline__ void p3_cmp_prompt(const Ctx& c, int l, int it, LAS float* meanb, int lane) {
    const int cb = it & 127, b = it >> 7;
    const bf16* H = (const bf16*)(AWS + WS_H);
    const float* pe = (const float*)AIN(I_PE) + (size_t)l * 2 * 32 * 64; const float* phi = (const float*)AIN(I_PHI) + (size_t)l * 2 * 64 * 64;
    const int type = lane >> 5, d0 = (lane & 15) * 4;
    f32x4 acc = (f32x4){0.f, 0.f, 0.f, 0.f};
    u32x2 xr[32];
#pragma unroll
    for (int i = 0; i < 32; ++i) xr[i] = *(const u32x2*)(H + (size_t)(b * SEQ + cb * 32 + i) * HW + HKV + lane * 4);
#pragma unroll
    for (int i = 0; i < 32; ++i) { const f32x4 pv = *(const f32x4*)(pe + (type * 32 + i) * 64 + d0);
        acc[0] += __uint_as_float(xr[i].x << 16) + pv[0]; acc[1] += __uint_as_float(xr[i].x & 0xffff0000u) + pv[1]; acc[2] += __uint_as_float(xr[i].y << 16) + pv[2]; acc[3] += __uint_as_float(xr[i].y & 0xffff0000u) + pv[3]; }
    wave_lds_sync(); *(LAS f32x4*)(meanb + lane * 4) = acc * (1.f / 32.f); wave_lds_sync();
    float o[4];
#define PHIG(t_, d_) phi[((t_) * 64 + (d_)) * 64 + lane]
    P3_MATVEC(o, meanb, PHIG);
#undef PHIG
    bf16* KCB = (bf16*)(AWS + WS_KCB); bf16* VCB = (bf16*)(AWS + WS_VCB); const size_t ob = ((size_t)(b * 128 + cb) * 2) * 64 + lane;
    KCB[ob] = (bf16)f2bf(o[0]); KCB[ob + 64] = (bf16)f2bf(o[1]); VCB[ob] = (bf16)f2bf(o[2]); VCB[ob + 64] = (bf16)f2bf(o[3]);
}
__device__ __forceinline__ void p3_copy_chunk(const Ctx& c, int l, int kind, int chunk, int lane) {
    const bf16* H = (const bf16*)(AWS + WS_H);
    const int nun = kind == 0 ? DB * 512 : (kind == 1 ? 4 * 512 : (kind == 2 ? DB * 3 * 6 : 4 * 3 * 6));
    float* dstb = AOUT + (kind == 0 ? O_WINS + (size_t)l * DB * 512 * 256 : (kind == 1 ? O_WINP + (size_t)l * 4 * 512 * 256 : (kind == 2 ? O_GCS + (size_t)l * DB * 3 * GQKV : O_GCP + (size_t)l * 4 * 3 * GQKV)));
    const float* sw = (const float*)AIN(I_SWIN) + (size_t)l * DB * 512 * 256; const float* sgc = (const float*)AIN(I_SGCONV) + (size_t)l * DB * 3 * GQKV;
    f32x4 v[8];
#pragma unroll 1
    for (int h8 = 0; h8 < 4; ++h8) {
#pragma unroll
        for (int i = 0; i < 8; ++i) { const int u = chunk * 32 + h8 * 8 + i; v[i] = (f32x4){0.f, 0.f, 0.f, 0.f};
            if (u < nun) {
                const float* fs = nullptr; const bf16* bs = nullptr;
                if (kind == 0) { const int r = u & 511, b = u >> 9; if (r < 511) fs = sw + (size_t)(u + 1) * 256; else bs = H + (size_t)(MPR + b) * HW + HWIN; }
                else if (kind == 1) { const int r = u & 511, b = u >> 9; bs = H + (size_t)(b * SEQ + SEQ - 512 + r) * HW + HWIN; }
                else if (kind == 2) { const int seg = u % 6, row = u / 6, r = row % 3, b = row / 3; if (r < 2) fs = sgc + ((size_t)b * 3 + r + 1) * GQKV + seg * 256; else bs = H + (size_t)(MPR + b) * HW + HGQKV + seg * 256; }
                else { const int seg = u % 6, row = u / 6, r = row % 3, b = row / 3; bs = H + (size_t)(b * SEQ + SEQ - 3 + r) * HW + HGQKV + seg * 256; }
                if (fs) v[i] = *(const f32x4*)(fs + lane * 4);
                else { const u32x2 w = *(const u32x2*)(bs + lane * 4); v[i] = (f32x4){__uint_as_float(w.x << 16), __uint_as_float(w.x & 0xffff0000u), __uint_as_float(w.y << 16), __uint_as_float(w.y & 0xffff0000u)}; } } }
#pragma unroll
        for (int i = 0; i < 8; ++i) { const int u = chunk * 32 + h8 * 8 + i; if (u < nun) *(f32x4*)(dstb + (size_t)u * 256 + lane * 4) = v[i]; }
    }
}
constexpr int P3L_KC = 0, P3L_VC = 64 * 2 * 65 * 4, P3L_PHI = 2 * P3L_VC, P3L_MEAN = P3L_PHI + 32768, P3L_WV = P3L_MEAN + 8 * 1024, P3L_END = P3L_WV + 2 * 4096;
static_assert(P3L_END <= RING_BYTES, "p3 LDS");
__device__ __forceinline__ void p3_sample_seq(const Ctx& c, int l, int b) {
    LAS unsigned char* lds = c.lds; const int lane = c.lane, wid = c.wave;
    LAS float* KCl = (LAS float*)(lds + P3L_KC); LAS float* VCl = (LAS float*)(lds + P3L_VC); LAS float* PHI = (LAS float*)(lds + P3L_PHI); LAS float* meanb = (LAS float*)(lds + P3L_MEAN + wid * 1024);
    const float* pe = (const float*)AIN(I_PE) + (size_t)l * 2 * 32 * 64; const float* phi = (const float*)AIN(I_PHI) + (size_t)l * 2 * 64 * 64;
    const int* ptab = (const int*)AIN(I_PTAB); const float* cache = (const float*)AIN(I_CACHE) + (size_t)l * NPOOL * 128 * 512;
    for (int i = c.tid; i < 2048; i += 512) *(LAS f32x4*)(PHI + 4 * i) = *(const f32x4*)(phi + 4 * i);
    const int type = lane >> 5, d0 = (lane & 15) * 4;
    f32x4 pes = (f32x4){0.f, 0.f, 0.f, 0.f};
#pragma unroll 8
    for (int i = 0; i < 32; ++i) pes += *(const f32x4*)(pe + (type * 32 + i) * 64 + d0);
    __syncthreads();
#pragma unroll 1
    for (int cb = wid; cb < 64; cb += 8) {
        const int page = ptab[b * NPG + (cb >> 2)]; const float* src = cache + ((size_t)page * 128 + (cb & 3) * 32) * 512 + lane * 4;
        f32x4 acc = pes;
#pragma unroll 1
        for (int h = 0; h < 2; ++h) { f32x4 xr[16];
#pragma unroll
            for (int i = 0; i < 16; ++i) xr[i] = *(const f32x4*)(src + (size_t)(h * 16 + i) * 512);
#pragma unroll
            for (int i = 0; i < 16; ++i) acc += xr[i]; }
        wave_lds_sync(); *(LAS f32x4*)(meanb + lane * 4) = acc * (1.f / 32.f); wave_lds_sync();
        float o[4];
#define PHIL(t_, d_) PHI[((t_) * 64 + (d_)) * 64 + lane]
        P3_MATVEC(o, meanb, PHIL);
#undef PHIL
        KCl[(cb * 2 + 0) * 65 + lane] = o[0]; KCl[(cb * 2 + 1) * 65 + lane] = o[1]; VCl[(cb * 2 + 0) * 65 + lane] = o[2]; VCl[(cb * 2 + 1) * 65 + lane] = o[3];
    }
    __syncthreads();
    if (wid < 2) {
        const int n = wid, row = MPR + b; LAS float* wl = (LAS float*)(lds + P3L_WV + wid * 4096); LAS float* qbuf = wl; LAS float* pbuf = wl + 256; LAS float* impbuf = wl + 512;
        const bf16* H = (const bf16*)(AWS + WS_H);
        { f32x4 qv;
#pragma unroll
          for (int g = 0; g < 4; ++g) qv[g] = bf2f(H[(size_t)row * HW + HQ + (n * 4 + g) * 64 + lane]);
          *(LAS f32x4*)(qbuf + lane * 4) = qv; wave_lds_sync(); }
        float dot[4] = {0.f, 0.f, 0.f, 0.f}; const LAS float* kr = KCl + (lane * 2 + n) * 65;
#pragma unroll 8
        for (int d = 0; d < 64; ++d) { const float kv = kr[d]; const f32x4 q4 = *(const LAS f32x4*)(qbuf + d * 4);
#pragma unroll
            for (int g = 0; g < 4; ++g) dot[g] += kv * q4[g]; }
        const float dist = (float)PASTL - (32.f * (float)lane + 15.5f);
        f32x4 p; float imp = 0.f;
        float c8 = 0.125f; asm volatile("" : "+v"(c8));
#pragma unroll
        for (int g = 0; g < 4; ++g) { const float sv = dot[g] * c8 - exp2f(-(float)(n * 4 + g + 1)) * dist; const float mx = wave_max(sv); const float e = __expf(sv - mx); const float sum = wave_sum(e); p[g] = e / sum; imp += p[g]; }
        impbuf[lane] = imp; impbuf[64 + lane] = 0.f; *(LAS f32x4*)(pbuf + lane * 4) = p; wave_lds_sync();
        const unsigned long long mask = select_blocks(impbuf, lane, PASTL >> 6);
        float o[4] = {0.f, 0.f, 0.f, 0.f};
#pragma unroll 8
        for (int cc = 0; cc < 64; ++cc) { const float vv = VCl[(cc * 2 + n) * 65 + lane]; const f32x4 pc = *(const LAS f32x4*)(pbuf + cc * 4);
#pragma unroll
            for (int g = 0; g < 4; ++g) o[g] += pc[g] * vv; }
        if (lane == 0) ((unsigned long long*)(AWS + WS_SMASK))[b * 2 + n] = mask;
        float* oc = (float*)(AWS + WS_OCMP) + (size_t)(b * 2 + n) * 256;
#pragma unroll
        for (int g = 0; g < 4; ++g) oc[g * 64 + lane] = o[g];
    }
    __syncthreads();
}
__device__ __forceinline__ void p3_prep(const Ctx& c0, int l, int rep = 0) {
    const Ctx c = relaunder(c0);
    const int lane = c.lane;
    for (int b = c.bid; b < DB; b += c.G) p3_sample_seq(c, l, b);
    constexpr int N_A = MPR / 8, N_B = DB * 8, N_C = 4 * 128, N_D0 = DB * 512 / 32, N_D1 = 4 * 512 / 32, N_D2 = (DB * 3 * 6 + 31) / 32, N_D3 = (4 * 3 * 6 + 31) / 32;
    constexpr int E_A = N_A, E_B = E_A + N_B, E_C = E_B + N_C, E_D0 = E_C + N_D0, E_D1 = E_D0 + N_D1, E_D2 = E_D1 + N_D2, E_D3 = E_D2 + N_D3;
    unsigned* head = c.ctl + (l ? CW_P1 : CW_P0) + rep * 1024;
    LAS float* meanb = (LAS float*)(c.lds + c.wave * 4096);
    for (;;) {
        unsigned base = 0;
        if (lane == 0) base = __hip_atomic_fetch_add(head, 2u, __ATOMIC_RELAXED, __HIP_MEMORY_SCOPE_AGENT);
        base = (unsigned)__builtin_amdgcn_readfirstlane((int)base);
        if (base >= (unsigned)E_D3) break;
#pragma unroll 1
        for (int k = 0; k < 2; ++k) { const int it = (int)base + k; if (it >= E_D3) break;
            if (it < E_A) p3_gdn_rows(c, l, it, lane);
            else if (it < E_B) p3_gdn_sample(c, l, it - E_A, lane);
            else if (it < E_C) p3_cmp_prompt(c, l, it - E_B, meanb, lane);
            else if (it < E_D0) p3_copy_chunk(c, l, 0, it - E_C, lane);
            else if (it < E_D1) p3_copy_chunk(c, l, 1, it - E_D0, lane);
            else if (it < E_D2) p3_copy_chunk(c, l, 2, it - E_D1, lane);
            else p3_copy_chunk(c, l, 3, it - E_D2, lane); }
    }
}
__device__ __forceinline__ void sample_part(const Ctx& c, int l, int it, LAS float* wl, int lane) {
    const int p = it % 25, bn = it / 25, n = bn & 1, b = bn >> 1, row = MPR + b;
    LAS float* qbuf = wl; LAS float* pbuf = wl + 256;
    const bf16* H = (const bf16*)(AWS + WS_H);
    float slope[4];
#pragma unroll
    for (int g = 0; g < 4; ++g) slope[g] = exp2f(-(float)(n * 4 + g + 1));
    { f32x4 qv;
#pragma unroll
      for (int g = 0; g < 4; ++g) qv[g] = bf2f(H[(size_t)row * HW + HQ + (n * 4 + g) * 64 + lane]);
      wave_lds_sync(); *(LAS f32x4*)(qbuf + lane * 4) = qv; wave_lds_sync(); }
    OSm st; os_init(st);
    bool active = true, isb = false, valid = true; float dist = 0.f; const float* kpf = nullptr; const bf16* kpb = nullptr;
    if (p < 16) {
        const unsigned long long* mp = (const unsigned long long*)(AWS + WS_SMASK) + bn; unsigned long long mask = *mp;
        mask = ((unsigned long long)(unsigned)__builtin_amdgcn_readfirstlane((int)(unsigned)(mask >> 32)) << 32) | (unsigned)__builtin_amdgcn_readfirstlane((int)(unsigned)mask);
        for (int k = 0; k < p; ++k) mask &= mask - 1;
        if (!mask) active = false;
        else { const int j = __builtin_ctzll(mask);
            if (j < 32) { const int page = ((const int*)AIN(I_PTAB))[b * NPG + (j >> 1)]; kpf = (const float*)AIN(I_CACHE) + (size_t)l * NPOOL * 128 * 512 + ((size_t)page * 128 + (j & 1) * 64 + lane) * 512 + 256 + n * 64; dist = (float)(PASTL - (j * 64 + lane)); }
            else { isb = true; kpb = H + (size_t)row * HW + HKV + 256 + n * 64; valid = (lane == 0); } }
    } else if (p < 24) {
        const int i = 1 + (p - 16) * 64 + lane; const int ic = i > 511 ? 511 : i;
        kpf = (const float*)AIN(I_SWIN) + ((size_t)l * DB + b) * 512 * 256 + (size_t)ic * 256 + n * 64; valid = (i <= 511); dist = (float)(512 - i);
    } else { isb = true; kpb = H + (size_t)row * HW + HWIN + n * 64; valid = (lane == 0); }
    if (active) { if (isb) attend_block<bf16>(st, kpb, kpb + 128, valid, dist, qbuf, pbuf, lane, slope); else attend_block<float>(st, kpf, kpf + 128, valid, dist, qbuf, pbuf, lane, slope); }
    float* pt = (float*)(AWS + WS_PART) + (size_t)it * 264;
    if (lane == 0) { *(f32x4*)pt = (f32x4){st.m[0], st.m[1], st.m[2], st.m[3]}; *(f32x4*)(pt + 4) = (f32x4){st.l[0], st.l[1], st.l[2], st.l[3]}; }
#pragma unroll
    for (int g = 0; g < 4; ++g) pt[8 + g * 64 + lane] = st.o[g];
}
__device__ __forceinline__ void sample_combine(const Ctx& c, int l, int bn, int lane) {
    const int n = bn & 1, b = bn >> 1, row = MPR + b;
    const float* pt = (const float*)(AWS + WS_PART) + (size_t)bn * 25 * 264; const float* HS = (const float*)(AWS + WS_HS); const float* oc = (const float*)(AWS + WS_OCMP) + (size_t)bn * 256;
    float res[2][4];
#pragma unroll
    for (int br = 0; br < 2; ++br) { const int p0 = br ? 16 : 0, np = br ? 9 : 16;
        float M[4] = {NEGV, NEGV, NEGV, NEGV};
#pragma unroll 4
        for (int k = 0; k < np; ++k) { const f32x4 mv = *(const f32x4*)(pt + (size_t)(p0 + k) * 264);
#pragma unroll
            for (int g = 0; g < 4; ++g) M[g] = fmaxf(M[g], mv[g]); }
        float L[4] = {0.f, 0.f, 0.f, 0.f}, O[4] = {0.f, 0.f, 0.f, 0.f};
#pragma unroll 4
        for (int k = 0; k < np; ++k) { const float* pp = pt + (size_t)(p0 + k) * 264; const f32x4 mv = *(const f32x4*)pp, lv = *(const f32x4*)(pp + 4);
#pragma unroll
            for (int g = 0; g < 4; ++g) { const float f = __expf(mv[g] - M[g]); L[g] += lv[g] * f; O[g] += pp[8 + g * 64 + lane] * f; } }
#pragma unroll
        for (int g = 0; g < 4; ++g) res[br][g] = L[g] > 0.f ? O[g] / L[g] : 0.f; }
    bf16* MIX = (bf16*)(AWS + WS_MIX);
#pragma unroll
    for (int g = 0; g < 4; ++g) { const int hq = n * 4 + g; const float* gp = HS + (size_t)row * 64 + hq * 3;
        MIX[(size_t)row * DM + hq * 64 + lane] = (bf16)f2bf(sigmoidf_(gp[0]) * oc[g * 64 + lane] + sigmoidf_(gp[1]) * res[0][g] + sigmoidf_(gp[2]) * res[1][g]); }
}
__device__ __forceinline__ void p4_mixers(const Ctx& c0, int l, int rep = 0) {
    const Ctx c = relaunder(c0);
    LAS float* wl = (LAS float*)(c.lds + c.wave * 4096);
    const int lane = c.lane;
    if (!(rep && (AIN_DBL & 32))) {
        if (c.bid < 64 && c.wave < 4) { const int ci = c.bid * 4 + c.wave; gdn_chain8(c, l, ci >> 6, (ci >> 3) & 7, ci & 7, (LAS float*)(c.lds + 32768 + c.wave * 20480), lane); }
        else if (c.bid >= 64) {
            unsigned* head = c.ctl + (l ? CW_Q1 : CW_Q0) + rep * 1024;
            constexpr int N_GS = DB * 8, N_NS = DB * 2 * 25, N_ALL = N_GS + N_NS;
            for (;;) {
                unsigned it = 0;
                if (lane == 0) it = __hip_atomic_fetch_add(head, 1u, __ATOMIC_RELAXED, __HIP_MEMORY_SCOPE_AGENT);
                it = (unsigned)__builtin_amdgcn_readfirstlane((int)it);
                if (it >= (unsigned)N_ALL) break;
                if (it < (unsigned)N_NS) sample_part(c, l, (int)it, wl, lane);
                else { const int k = (int)it - N_NS; gdn_item_sample(c, l, k >> 3, k & 7, wl, lane); }
            }
        }
        __syncthreads();
    }
    {
        volatile LAS unsigned* slot = (volatile LAS unsigned*)(c.lds - CTLB + MISC_OFF + 64);
        for (;;) {
            if (c.wave == 0 && hw_lane() == 0) { unsigned* head = c.ctl + (l ? CW_U1 : CW_U0) + rep * 1024; *slot = __hip_atomic_fetch_add(head, 1u, __ATOMIC_RELAXED, __HIP_MEMORY_SCOPE_AGENT); }
            __syncthreads();
            const unsigned u = *slot;
            __syncthreads();
            if (u >= 512u) break;
            nsa_unit(c, l, (int)(u >> 1) & 3, (int)u & 1, 63 - (int)(u >> 3));
        }
    }
}

__device__ __forceinline__ void p_ln(const Ctx& c0, int l, int which, bool final_out) {
    const Ctx c = relaunder(c0);
    const int gw = c.bid * 8 + c.wave, NGW = c.G * 8, lane = c.lane;
    const float* T1 = (const float*)(AWS + WS_T1); float* XF = (float*)(AWS + WS_XF); bf16* XB = (bf16*)(AWS + WS_XB);
    const float* g = (const float*)AIN(I_LNG) + (size_t)(l * 3 + which) * DM; const float* bb = (const float*)AIN(I_LNB) + (size_t)(l * 3 + which) * DM;
    f32x4 gv[4], bv[4];
#pragma unroll
    for (int j = 0; j < 4; ++j) { gv[j] = *(const f32x4*)(g + lane * 4 + 256 * j); bv[j] = *(const f32x4*)(bb + lane * 4 + 256 * j); }
    f32x4 nx[4];
    if (gw < MTOT) {
#pragma unroll
        for (int j = 0; j < 4; ++j) nx[j] = *(const f32x4*)(T1 + (size_t)gw * DM + lane * 4 + 256 * j); }
    for (int m = gw; m < MTOT; m += NGW) {
        f32x4 v[4]; float s = 0.f;
#pragma unroll
        for (int j = 0; j < 4; ++j) { v[j] = nx[j]; s += (v[j][0] + v[j][1]) + (v[j][2] + v[j][3]); }
        if (m + NGW < MTOT) {
#pragma unroll
            for (int j = 0; j < 4; ++j) nx[j] = *(const f32x4*)(T1 + (size_t)(m + NGW) * DM + lane * 4 + 256 * j); }
        const float mean = wave_sum_fast(s) * (1.f / DM); float s2 = 0.f;
#pragma unroll
        for (int j = 0; j < 4; ++j) { v[j] = v[j] - mean; s2 += (v[j][0] * v[j][0] + v[j][1] * v[j][1]) + (v[j][2] * v[j][2] + v[j][3] * v[j][3]); }
        const float rstd = rsqrtf(wave_sum_fast(s2) * (1.f / DM) + LN_EPS);
        float* of = final_out ? (m < MPR ? AOUT + O_YP + (size_t)m * DM : AOUT + O_YS + (size_t)(m - MPR) * DM) : XF + (size_t)m * DM;
#pragma unroll
        for (int j = 0; j < 4; ++j) { const f32x4 y = v[j] * rstd * gv[j] + bv[j]; *(f32x4*)(of + lane * 4 + 256 * j) = y;
            if (!final_out) { u32x2 w; w.x = pk2(y[0], y[1]); w.y = pk2(y[2], y[3]); *(u32x2*)(XB + (size_t)m * DM + lane * 4 + 256 * j) = w; } }
    }
}

__device__ __forceinline__ float gelu_as(float v) {
    const float av = fabsf(v), t = __builtin_amdgcn_rcpf(av * 0.2316418882f + 1.0f);
    float q = t * 0.5307027145f + (-0.7265760135f); q = q * t + 0.7107068705f; q = q * t + (-0.142248368f); q = q * t + 0.127414796f; q = q * t;
    const float e = __builtin_amdgcn_exp2f((v * v) * (-0.72134752044f));
    const float m = v * (q * e);
    return v < 0.f ? m : v - m;
}
__device__ __forceinline__ float gelu_erf(float x) { return 0.5f * x * (1.0f + erff(x * 0.70710678118654752f)); }
__device__ __forceinline__ void p8_act(const Ctx& c0, int l) {
    const Ctx c = relaunder(c0);
    const int lane = c.lane, gw = c.bid * 8 + c.wave, NGW = c.G * 8;
    const bf16* UP = (const bf16*)(AWS + WS_UP); bf16* ACT = (bf16*)(AWS + WS_ACT);
    const float* fw = (const float*)AIN(I_FCW) + (size_t)l * 3 * DFF; const float* sfc = (const float*)AIN(I_SFCONV) + (size_t)l * DB * 2 * DFF;
    constexpr int NCG = DFF / 8, NCW = (NCG + 63) / 64, NRB = MPR / 16;
    for (int it = gw; it < NRB * NCW; it += NGW) {
        const int rb = it / NCW, cgi = (it % NCW) * 64 + lane; const bool on = cgi < NCG; const int cc = (on ? cgi : 0) * 8;
        const int m0 = rb * 16; const bool first = (m0 & (SEQ - 1)) == 0;
        float w0[8], w1[8], w2[8];
#pragma unroll
        for (int h = 0; h < 2; ++h) { const f32x4 a = *(const f32x4*)(fw + cc + 4 * h), b = *(const f32x4*)(fw + DFF + cc + 4 * h), d = *(const f32x4*)(fw + 2 * DFF + cc + 4 * h);
#pragma unroll
            for (int q = 0; q < 4; ++q) { w0[4 * h + q] = a[q]; w1[4 * h + q] = b[q]; w2[4 * h + q] = d[q]; } }
        float x2[8], x1[8];
        { u32x4 h2 = (u32x4){0u, 0u, 0u, 0u}, h1 = (u32x4){0u, 0u, 0u, 0u};
          if (!first) { h2 = *(const u32x4*)(UP + (size_t)(m0 - 2) * UPW + cc); h1 = *(const u32x4*)(UP + (size_t)(m0 - 1) * UPW + cc); }
          unpack8(h2, x2); unpack8(h1, x1); }
#pragma unroll 1
        for (int r8 = 0; r8 < 2; ++r8) {
            u32x4 ur[8], mr[8];
#pragma unroll
            for (int r = 0; r < 8; ++r) { ur[r] = *(const u32x4*)(UP + (size_t)(m0 + r8 * 8 + r) * UPW + cc); mr[r] = *(const u32x4*)(UP + (size_t)(m0 + r8 * 8 + r) * UPW + DFF + cc); }
#pragma unroll
            for (int r = 0; r < 8; ++r) { float x0[8], mu[8]; unpack8(ur[r], x0); unpack8(mr[r], mu);
                float y[8];
#pragma unroll
                for (int q = 0; q < 8; ++q) y[q] = gelu_as(w0[q] * x2[q] + w1[q] * x1[q] + w2[q] * x0[q]) * mu[q];
                u32x4 o; o.x = pk2(y[0], y[1]); o.y = pk2(y[2], y[3]); o.z = pk2(y[4], y[5]); o.w = pk2(y[6], y[7]);
                if (on) *(u32x4*)(ACT + (size_t)(m0 + r8 * 8 + r) * DFF + cc) = o;
#pragma unroll
                for (int q = 0; q < 8; ++q) { x2[q] = x1[q]; x1[q] = x0[q]; } }
        }
    }
    const size_t gt = (size_t)c.bid * 512 + c.tid, GT = (size_t)c.G * 512;
    constexpr int CPR = DFF / 4;
    for (size_t i = gt; i < (size_t)DB * CPR; i += GT) { const int b = (int)(i / CPR), cc = (int)(i % CPR) * 4, m = MPR + b;
        const u32x2 u0 = *(const u32x2*)(UP + (size_t)m * UPW + cc); const u32x2 um = *(const u32x2*)(UP + (size_t)m * UPW + DFF + cc);
        const float x0[4] = {__uint_as_float(u0.x << 16), __uint_as_float(u0.x & 0xffff0000u), __uint_as_float(u0.y << 16), __uint_as_float(u0.y & 0xffff0000u)};
        const float mu[4] = {__uint_as_float(um.x << 16), __uint_as_float(um.x & 0xffff0000u), __uint_as_float(um.y << 16), __uint_as_float(um.y & 0xffff0000u)};
        const f32x4 s0 = *(const f32x4*)(sfc + ((size_t)b * 2 + 0) * DFF + cc), s1 = *(const f32x4*)(sfc + ((size_t)b * 2 + 1) * DFF + cc);
        const f32x4 w0 = *(const f32x4*)(fw + cc), w1 = *(const f32x4*)(fw + DFF + cc), w2 = *(const f32x4*)(fw + 2 * DFF + cc);
        float r[4];
#pragma unroll
        for (int j = 0; j < 4; ++j) r[j] = gelu_as(w0[j] * s0[j] + w1[j] * s1[j] + w2[j] * x0[j]) * mu[j];
        u32x2 w; w.x = pk2(r[0], r[1]); w.y = pk2(r[2], r[3]); *(u32x2*)(ACT + (size_t)m * DFF + cc) = w; }
    { float* o = AOUT + O_FCP + (size_t)l * 4 * 2 * DFF;
      for (size_t i = gt; i < (size_t)4 * 2 * DFF; i += GT) { const int cc = (int)(i % DFF), r = (int)(i / DFF) & 1, b = (int)(i / (2 * DFF)); o[i] = bf2f(UP[(size_t)(b * SEQ + SEQ - 2 + r) * UPW + cc]); } }
    { float* o = AOUT + O_FCS + (size_t)l * DB * 2 * DFF;
      for (size_t i = gt; i < (size_t)DB * 2 * DFF; i += GT) { const int cc = (int)(i % DFF), r = (int)(i / DFF) & 1, b = (int)(i / (2 * DFF)); o[i] = (r == 0) ? sfc[i + DFF] : bf2f(UP[(size_t)(MPR + b) * UPW + cc]); } }
}


typedef short bf16x8s __attribute__((ext_vector_type(8)));
typedef float f32x16s __attribute__((ext_vector_type(16)));
template <class Epi>
__device__ __forceinline__ void gemm_small(const Ctx& c, const bf16* A, const bf16* Bt, int K, int nitems, const Epi& E) {
    LAS float* red = (LAS float*)c.lds; const int lane = hw_lane()  , wid = c.wave, r32 = lane & 31, hi = lane >> 5;
    const int kw = K >> 3, nst = kw >> 4;
    for (int it = c.G - 1 - c.bid; it < nitems; it += c.G) {
        const int n0 = it * 32;
        f32x16s acc[4];
#pragma unroll
        for (int rb = 0; rb < 4; ++rb)
#pragma unroll
            for (int r = 0; r < 16; ++r) acc[rb][r] = 0.f;
        const bf16* ap = A + (size_t)r32 * K + wid * kw + 8 * hi; const bf16* bp = Bt + (size_t)(n0 + r32) * K + wid * kw + 8 * hi;
#pragma unroll 1
        for (int ks = 0; ks < nst; ks += 2) {
            bf16x8s af[2][4], bf[2];
#pragma unroll
            for (int u = 0; u < 2; ++u) { bf[u] = *(const bf16x8s*)(bp + (ks + u) * 16);
#pragma unroll
                for (int rb = 0; rb < 4; ++rb) af[u][rb] = *(const bf16x8s*)(ap + (size_t)rb * 32 * K + (ks + u) * 16); }
#pragma unroll
            for (int u = 0; u < 2; ++u)
#pragma unroll
                for (int rb = 0; rb < 4; ++rb) acc[rb] = __builtin_amdgcn_mfma_f32_32x32x16_bf16(af[u][rb], bf[u], acc[rb], 0, 0, 0);
        }
#pragma unroll
        for (int rb = 0; rb < 4; ++rb)
#pragma unroll
            for (int r = 0; r < 16; ++r) red[(size_t)(wid * 64 + rb * 16 + r) * 64 + lane] = acc[rb][r];
        __syncthreads();
#pragma unroll
        for (int q = 0; q < 8; ++q) { const int rr = wid * 8 + q, rb = rr >> 4, r = rr & 15; float v = 0.f;
#pragma unroll
            for (int w = 0; w < 8; ++w) v += red[(size_t)(w * 64 + rr) * 64 + lane];
            E(rb * 32 + (r & 3) + 8 * (r >> 2) + 4 * hi, n0 + r32, v); }
        __syncthreads();
    }
}
struct SEpiIn { bf16* H; float* HS; float* kvs;
    __device__ __forceinline__ void operator()(int r, int col, float v) const { const int row = MPR + r;
        H[(size_t)row * HW + col] = (bf16)f2bf(v);
        if (col >= HKV && col < HWIN) kvs[(size_t)r * 512 + (col - HKV)] = v;
        if (col >= HSM && col < HSM + 64) HS[(size_t)row * 64 + (col - HSM)] = v; } };
struct SEpiRes { const float* XF; float* T1;
    __device__ __forceinline__ void operator()(int r, int col, float v) const { const size_t o = (size_t)(MPR + r) * DM + col; T1[o] = XF[o] * DN_ALPHA + v; } };
struct SEpiGate { const float* XF; const float* PP; float* T1;
    __device__ __forceinline__ void operator()(int r, int col, float v) const { const size_t o = (size_t)(MPR + r) * DM + col; T1[o] = XF[o] * DN_ALPHA + PP[o] / (1.0f + __expf(-v)); } };
struct SEpiBf { bf16* O; int ldc;
    __device__ __forceinline__ void operator()(int r, int col, float v) const { O[(size_t)(MPR + r) * ldc + col] = (bf16)f2bf(v); } };
struct SEpiF { float* O; int ldc;
    __device__ __forceinline__ void operator()(int r, int col, float v) const { O[(size_t)(MPR + r) * ldc + col] = v; } };

constexpr int NPH = 2 + 2 * 12;
__global__ void __launch_bounds__(512, 2) fwd_kernel(Args a) {
    extern __shared__ __attribute__((aligned(16))) unsigned char lds_raw[];
    Ctx c; c.lds = (LAS unsigned char*)lds_raw + CTLB; LAS unsigned char* lctl = (LAS unsigned char*)lds_raw; c.tid = threadIdx.x; c.lane = c.tid & 63; c.wave = __builtin_amdgcn_readfirstlane(c.tid >> 6); c.bid = blockIdx.x; c.G = gridDim.x;
    volatile LAS unsigned* MISC = (volatile LAS unsigned*)(lctl + MISC_OFF);
    if (c.tid < CTLB / 4) ((LAS unsigned*)lctl)[c.tid] = 0u;
    __syncthreads();
    { const unsigned* ap = (const unsigned*)&a; LAS unsigned* la = (LAS unsigned*)(lctl + ARGS_OFF); if (c.tid < 58) la[c.tid] = ap[c.tid]; c.la = la; }
    __syncthreads();
    c.ctl = (unsigned*)(AWS + WS_CTL);
    XcdBarrier bar; bar.bar = c.ctl + CW_BAR; bar.x = 0; bar.st = nullptr; bar.w0 = (c.wave == 0);
    const int lo = a.ph_lo, hi = a.ph_hi, dbl = a.dbl;
    if (hi - lo > 1 || dbl) { bar = xcd_barrier_post(c.ctl + CW_BAR, MISC + 8); bar.w0 = (c.wave == 0); }
#define GEMM_CALL(...) do { for (int rp = 0; rp <= ((dbl >> 4) & 1); ++rp) { if (rp) xcd_barrier(bar); __VA_ARGS__; } } while (0)
#define IN(k) (lo <= (k) && (k) < hi)
#define SEAM(k) do { if (IN(k) && IN((k) + 1)) xcd_barrier(bar); } while (0)
    const Ctx cb = c;
    LAS unsigned char* ring = cb.lds;
    if (IN(0)) { p0_prologue(cb); } SEAM(0);
    if (IN(1)) {
        const Ctx c = relaunder(cb);
        for (int l = 0; l < 2; ++l) {
            pg8::Gemm g{(const pg8::bf16_t*)(AWS + WS_PB) + (size_t)l * MPAD * PLED, (const pg8::bf16_t*)(AWS + WS_WPJ) + (size_t)l * DM * PLED, MPR, DM, PLED};
            pg8::StaticOrder S; S.init(MPR, DM, c.G, c.bid); pg8::EpiF32 E{(float*)(AWS + WS_PP) + (size_t)l * MPAD * DM, DM};
            pg8::gemm_phase<pg8::EpiF32, pg8::StaticOrder, false, false>(ring, g, S, E, c.wave);
            gemm_small(c, (const bf16*)(AWS + WS_PB) + ((size_t)l * MPAD + MPR) * PLED, (const bf16*)(AWS + WS_WPJ) + (size_t)l * DM * PLED, PLED, DM / 32, SEpiF{(float*)(AWS + WS_PP) + (size_t)l * MPAD * DM, DM}); }
    } SEAM(1);
    for (int l = 0; l < 2; ++l) {
        const int p = 2 + l * 12;
        const Ctx c = relaunder(cb);
        if (IN(p + 0)) {
            pg8::Gemm g{(const pg8::bf16_t*)(AWS + WS_XB), (const pg8::bf16_t*)(AWS + WS_WIN) + (size_t)l * HW * DM, MPR, HW, DM};
            pg8::StaticOrder S; S.init(MPR, HW, c.G, c.bid);
            pg8::EpiIn E{(pg8::bf16_t*)(AWS + WS_H), (float*)(AWS + WS_HS), AOUT + O_KVP + (size_t)l * MPR * 512, AOUT + O_KVS + (size_t)l * DB * 512};
            GEMM_CALL(pg8::gemm_phase<pg8::EpiIn, pg8::StaticOrder, false, false>(ring, g, S, E, c.wave));
            gemm_small(c, (const bf16*)(AWS + WS_XB) + (size_t)MPR * DM, (const bf16*)(AWS + WS_WIN) + (size_t)l * HW * DM, DM, HW / 32, SEpiIn{(bf16*)(AWS + WS_H), (float*)(AWS + WS_HS), AOUT + O_KVS + (size_t)l * DB * 512});
        } SEAM(p + 0);
        if (IN(p + 1)) { for (int rp = 0; rp <= (dbl & 1); ++rp) { if (rp) xcd_barrier(bar); p3_prep(c, l, rp); } } SEAM(p + 1);
        if (IN(p + 2)) { for (int rp = 0; rp <= ((dbl >> 1) & 1); ++rp) { if (rp) xcd_barrier(bar); p4_mixers(c, l, rp); } } SEAM(p + 2);
        if (IN(p + 3)) { p4b_gdn_norm(c, l); } SEAM(p + 3);
        if (IN(p + 4)) {
            pg8::Gemm g{(const pg8::bf16_t*)(AWS + WS_MIX), (const pg8::bf16_t*)(AWS + WS_WOUT) + (size_t)l * DM * DM, MPR, DM, DM};
            pg8::StaticOrder S; S.init(MPR, DM, c.G, c.bid); pg8::EpiRes E{(const float*)(AWS + WS_XF), (float*)(AWS + WS_T1)};
            GEMM_CALL(pg8::gemm_phase<pg8::EpiRes, pg8::StaticOrder, false, false>(ring, g, S, E, c.wave));
            gemm_small(c, (const bf16*)(AWS + WS_MIX) + (size_t)MPR * DM, (const bf16*)(AWS + WS_WOUT) + (size_t)l * DM * DM, DM, DM / 32, SEpiRes{(const float*)(AWS + WS_XF), (float*)(AWS + WS_T1)});
        } SEAM(p + 4);
        if (IN(p + 5)) { for (int rp = 0; rp <= ((dbl >> 2) & 1); ++rp) { if (rp) xcd_barrier(bar); p_ln(c, l, 0, false); } } SEAM(p + 5);
        if (IN(p + 6)) {
            pg8::Gemm g{(const pg8::bf16_t*)(AWS + WS_XB), (const pg8::bf16_t*)(AWS + WS_WUP) + (size_t)l * UPW * DM, MPR, UPW, DM};
            pg8::StaticOrder S; S.init(MPR, UPW, c.G, c.bid); pg8::EpiBf16<0> E{(pg8::bf16_t*)(AWS + WS_UP), UPW, nullptr, 0, 0, 1.f};
            GEMM_CALL(pg8::gemm_phase<pg8::EpiBf16<0>, pg8::StaticOrder, false, false>(ring, g, S, E, c.wave));
            gemm_small(c, (const bf16*)(AWS + WS_XB) + (size_t)MPR * DM, (const bf16*)(AWS + WS_WUP) + (size_t)l * UPW * DM, DM, UPW / 32, SEpiBf{(bf16*)(AWS + WS_UP), UPW});
        } SEAM(p + 6);
        if (IN(p + 7)) { for (int rp = 0; rp <= ((dbl >> 3) & 1); ++rp) { if (rp) xcd_barrier(bar); p8_act(c, l); } } SEAM(p + 7);
        if (IN(p + 8)) {
            pg8::Gemm g{(const pg8::bf16_t*)(AWS + WS_ACT), (const pg8::bf16_t*)(AWS + WS_WDN) + (size_t)l * DM * DFF, MPR, DM, DFF};
            pg8::StaticOrder S; S.init(MPR, DM, c.G, c.bid); pg8::EpiRes E{(const float*)(AWS + WS_XF), (float*)(AWS + WS_T1)};
            GEMM_CALL(pg8::gemm_phase<pg8::EpiRes, pg8::StaticOrder, false, false>(ring, g, S, E, c.wave));
            gemm_small(c, (const bf16*)(AWS + WS_ACT) + (size_t)MPR * DFF, (const bf16*)(AWS + WS_WDN) + (size_t)l * DM * DFF, DFF, DM / 32, SEpiRes{(const float*)(AWS + WS_XF), (float*)(AWS + WS_T1)});
        } SEAM(p + 8);
        if (IN(p + 9)) { p_ln(c, l, 1, false); } SEAM(p + 9);
        if (IN(p + 10)) {
            pg8::Gemm g{(const pg8::bf16_t*)(AWS + WS_XB), (const pg8::bf16_t*)(AWS + WS_WGT) + (size_t)l * DM * DM, MPR, DM, DM};
            pg8::StaticOrder S; S.init(MPR, DM, c.G, c.bid); pg8::EpiGate E{(const float*)(AWS + WS_XF), (const float*)(AWS + WS_PP) + (size_t)l * MPAD * DM, (float*)(AWS + WS_T1)};
            GEMM_CALL(pg8::gemm_phase<pg8::EpiGate, pg8::StaticOrder, false, false>(ring, g, S, E, c.wave));
            gemm_small(c, (const bf16*)(AWS + WS_XB) + (size_t)MPR * DM, (const bf16*)(AWS + WS_WGT) + (size_t)l * DM * DM, DM, DM / 32, SEpiGate{(const float*)(AWS + WS_XF), (const float*)(AWS + WS_PP) + (size_t)l * MPAD * DM, (float*)(AWS + WS_T1)});
        } SEAM(p + 10);
        if (IN(p + 11)) { p_ln(c, l, 2, l == 1); } SEAM(p + 11);
    }
#undef IN
#undef SEAM
}

extern "C" void kernel_launch(void* const* d_in, const int* in_sizes, int n_in, void* d_out, int out_size, void* d_ws, size_t ws_size, hipStream_t stream) {
    static int grid = 0;
    if (grid == 0) {
        if (n_in != 25 || (size_t)out_size != O_END || ws_size < WS_END) { fprintf(stderr, "kernel_launch: unexpected shapes (n_in %d out %d ws %zu)\n", n_in, out_size, ws_size); grid = -1; return; }
        int dev = 0, cus = 0;
        if (hipGetDevice(&dev) != hipSuccess || hipDeviceGetAttribute(&cus, hipDeviceAttributeMultiprocessorCount, dev) != hipSuccess) { grid = -1; return; }
        if (hipFuncSetAttribute((const void*)fwd_kernel, hipFuncAttributeMaxDynamicSharedMemorySize, LDS_BYTES) != hipSuccess) { fprintf(stderr, "kernel_launch: hipFuncSetAttribute failed\n"); grid = -1; return; }
        int per_cu = 0; (void)hipOccupancyMaxActiveBlocksPerMultiprocessor(&per_cu, (const void*)fwd_kernel, 512, LDS_BYTES); (void)hipGetLastError();
        grid = cus;
    }
    if (grid < 0) return;
    (void)hipMemsetAsync((char*)d_ws + WS_CTL, 0, CTL_BYTES, stream);
    Args a{};
    for (int i = 0; i < 25; ++i) a.in[i] = d_in[i];
    a.out = (float*)d_out; a.ws = (unsigned char*)d_ws;
#if MK_MULTI
    for (int p = 0; p < NPH; ++p) { a.ph_lo = p; a.ph_hi = p + 1; hipLaunchKernelGGL(fwd_kernel, dim3(grid), dim3(512), LDS_BYTES, stream, a); }
#else
    a.ph_lo = 0; a.ph_hi = NPH; a.dbl = PROBE_DBL; hipLaunchKernelGGL(fwd_kernel, dim3(grid), dim3(512), LDS_BYTES, stream, a);
#endif
}
```
